# Optimizing an MI355X kernel written in HIP

```python
import jax, jax.numpy as jnp
from jax import lax
import numpy as np

D_MODEL = 1024
BATCH = 16
SEQ = 2048
DEPTH = 2

GRID_W = 64
CTX_LEN = 256
N_MIXERS = 2
N_HEADS = 16
HEAD_DIM = D_MODEL // N_HEADS
WIN_ROWS = 8
WIN_COLS = 16
CONV_WIDTH = 3
MLP_MULT = 4
D_FF = MLP_MULT * D_MODEL
N_CONV_LAYERS = (DEPTH + 1) // 2
N_ATTN_LAYERS = DEPTH // 2
RMS_EPS = 1e-6
NEG_INF = -1e30
ATTN_SCALE = HEAD_DIM ** -0.5

kernel_name = "hybrid_conv_natten_dit_block"


def rmsnorm(x, g):
    xf = x.astype(jnp.float32)
    inv = lax.rsqrt(jnp.mean(xf * xf, axis=-1, keepdims=True) + RMS_EPS)
    return (xf * inv).astype(x.dtype) * g


def ada_terms(cond, w, b):
    m = jax.nn.silu(cond) @ w + b
    return jnp.split(m[..., None, :], 6, axis=-1)


def modulate(h, shift, scale):
    return h * (1.0 + scale) + shift


def squared_relu_mlp(h, w1, w2):
    return jnp.square(jax.nn.relu(h @ w1)) @ w2


def depthwise_conv_centred(u, w):
    pad = CONV_WIDTH // 2
    L = u.shape[1]
    up = jnp.pad(u, ((0, 0), (pad, pad), (0, 0)))
    out = up[:, 0:L] * w[0]
    for j in range(1, CONV_WIDTH):
        out = out + up[:, j:j + L] * w[j]
    return out


def short_conv_mixer(h, w_in, w_conv, w_out):
    b_gate, c_gate, v = jnp.split(h @ w_in, 3, axis=-1)
    return (b_gate * depthwise_conv_centred(c_gate * v, w_conv)) @ w_out


def split_heads(t):
    B, L, _ = t.shape
    return t.reshape(B, L, N_HEADS, HEAD_DIM).transpose(0, 2, 1, 3)


def merge_heads(t):
    B, H, L, dh = t.shape
    return t.transpose(0, 2, 1, 3).reshape(B, L, H * dh)


def dense_ctx_attention(qc, kc, vc):
    s = jnp.einsum('bhqd,bhkd->bhqk', qc, kc).astype(jnp.float32) * ATTN_SCALE
    p = jax.nn.softmax(s, axis=-1).astype(vc.dtype)
    return jnp.einsum('bhqk,bhkd->bhqd', p, vc)


def neighbourhood_latent_attention(q, k, v, kc, vc, rpb):
    B, H, S, dh = q.shape
    rows = S // GRID_W
    kh = min(WIN_ROWS, rows)
    q = q.reshape(B, H, rows, GRID_W, dh) * ATTN_SCALE
    k = k.reshape(B, H, rows, GRID_W, dh)
    v = v.reshape(B, H, rows, GRID_W, dh)

    cols = jnp.arange(GRID_W)
    col_start = jnp.clip(cols - WIN_COLS // 2, 0, GRID_W - WIN_COLS)
    col_mask = (cols[None, :] >= col_start[:, None]) & (cols[None, :] < col_start[:, None] + WIN_COLS)
    dc = jnp.clip(cols[None, :] - cols[:, None] + (WIN_COLS - 1), 0, 2 * WIN_COLS - 2)

    def one_row(r):
        rs = jnp.clip(r - kh // 2, 0, rows - kh)
        q_r = lax.dynamic_index_in_dim(q, r, axis=2, keepdims=False)
        k_rb = lax.dynamic_slice_in_dim(k, rs, kh, axis=2)
        v_rb = lax.dynamic_slice_in_dim(v, rs, kh, axis=2)
        dr = rs + jnp.arange(kh) - r + (WIN_ROWS - 1)
        bias = rpb[:, dr[:, None, None], dc[None, :, :]].transpose(0, 2, 1, 3)
        s_loc = jnp.einsum('bhqd,bhrkd->bhqrk', q_r, k_rb).astype(jnp.float32) + bias.astype(jnp.float32)
        s_loc = jnp.where(col_mask[None, None, :, None, :], s_loc, NEG_INF)
        s_ctx = jnp.einsum('bhqd,bhkd->bhqk', q_r, kc).astype(jnp.float32)
        s_all = jnp.concatenate([s_loc.reshape(B, H, GRID_W, kh * GRID_W), s_ctx], axis=-1)
        p = jax.nn.softmax(s_all, axis=-1).astype(v.dtype)
        p_loc = p[..., :kh * GRID_W].reshape(B, H, GRID_W, kh, GRID_W)
        p_ctx = p[..., kh * GRID_W:]
        return (jnp.einsum('bhqrk,bhrkd->bhqd', p_loc, v_rb)
                + jnp.einsum('bhqk,bhkd->bhqd', p_ctx, vc))

    out = lax.map(one_row, jnp.arange(rows))
    return out.transpose(1, 0, 3, 2, 4).reshape(B, S, H * dh)


def neighbourhood_attention_mixer(h, hc, w_qkv, rpb, w_out, with_ctx_queries):
    D = h.shape[-1]
    q, k, v = [split_heads(t) for t in jnp.split(h @ w_qkv, 3, axis=-1)]
    if with_ctx_queries:
        qc, kc, vc = [split_heads(t) for t in jnp.split(hc @ w_qkv, 3, axis=-1)]
    else:
        kc, vc = [split_heads(t) for t in jnp.split(hc @ w_qkv[:, D:], 2, axis=-1)]
    y = neighbourhood_latent_attention(q, k, v, kc, vc, rpb) @ w_out
    yc = merge_heads(dense_ctx_attention(qc, kc, vc)) @ w_out if with_ctx_queries else None
    return y, yc


def setup_inputs(seed: int = 0) -> dict:
    key = jax.random.key(seed)
    ks = jax.random.split(key, 17)
    D = D_MODEL

    def nrm(k, shape, s):
        return jax.random.normal(k, shape, jnp.float32) * s

    return {
        "x": nrm(ks[0], (BATCH, SEQ, D), 1.0),
        "c": nrm(ks[1], (BATCH, D), 1.0),
        "ctx": nrm(ks[2], (BATCH, CTX_LEN, D), 1.0),
        "c_ctx": nrm(ks[3], (D,), 1.0),
        "norm1_g": 1.0 + nrm(ks[4], (DEPTH, D), 0.02),
        "norm2_g": 1.0 + nrm(ks[5], (DEPTH, D), 0.02),
        "ada_w": nrm(ks[6], (DEPTH, D, 6 * D), D ** -0.5),
        "ada_b": nrm(ks[7], (DEPTH, 6 * D), 0.01),
        "conv_in_w": nrm(ks[8], (N_CONV_LAYERS, D, 3 * D), D ** -0.5),
        "conv_w": nrm(ks[9], (N_CONV_LAYERS, CONV_WIDTH, D), CONV_WIDTH ** -0.5),
        "conv_out_w": nrm(ks[10], (N_CONV_LAYERS, D, D), D ** -0.5),
        "attn_qkv_w": nrm(ks[11], (N_ATTN_LAYERS, D, 3 * D), D ** -0.5),
        "attn_rpb": nrm(ks[12], (N_ATTN_LAYERS, N_HEADS, 2 * WIN_ROWS - 1, 2 * WIN_COLS - 1), 0.1),
        "attn_out_w": nrm(ks[13], (N_ATTN_LAYERS, D, D), D ** -0.5),
        "mlp_w1": nrm(ks[14], (DEPTH, D, D_FF), D ** -0.5),
        "mlp_w2": nrm(ks[15], (DEPTH, D_FF, D), D_FF ** -0.5),
        "final_g": 1.0 + nrm(ks[16], (D,), 0.02),
    }


def reference(x, c, ctx, c_ctx, norm1_g, norm2_g, ada_w, ada_b, conv_in_w, conv_w, conv_out_w,
              attn_qkv_w, attn_rpb, attn_out_w, mlp_w1, mlp_w2, final_g):
    for i in range(DEPTH):
        last = i == DEPTH - 1
        j = i // N_MIXERS
        sh1, sc1, gt1, sh2, sc2, gt2 = ada_terms(c, ada_w[i], ada_b[i])
        csh1, csc1, cgt1, csh2, csc2, cgt2 = ada_terms(c_ctx, ada_w[i], ada_b[i])
        h = modulate(rmsnorm(x, norm1_g[i]), sh1, sc1)
        if i % N_MIXERS == 0:
            y = short_conv_mixer(h, conv_in_w[j], conv_w[j], conv_out_w[j])
            if not last:
                hc = modulate(rmsnorm(ctx, norm1_g[i]), csh1, csc1)
                yc = short_conv_mixer(hc, conv_in_w[j], conv_w[j], conv_out_w[j])
        else:
            hc = modulate(rmsnorm(ctx, norm1_g[i]), csh1, csc1)
            y, yc = neighbourhood_attention_mixer(h, hc, attn_qkv_w[j], attn_rpb[j], attn_out_w[j],
                                                  with_ctx_queries=not last)
        x = x + gt1 * y
        x = x + gt2 * squared_relu_mlp(modulate(rmsnorm(x, norm2_g[i]), sh2, sc2), mlp_w1[i], mlp_w2[i])
        if not last:
            ctx = ctx + cgt1 * yc
            ctx = ctx + cgt2 * squared_relu_mlp(modulate(rmsnorm(ctx, norm2_g[i]), csh2, csc2),
                                                mlp_w1[i], mlp_w2[i])
    return rmsnorm(x, final_g)
```

```cpp
#include <hip/hip_runtime.h>
#include <hip/hip_cooperative_groups.h>
#include <cstdio>
#include <cstdint>
namespace cg = cooperative_groups;

#ifndef MK_N_LAUNCHES
#define MK_N_LAUNCHES 1
#endif

#define LAS __attribute__((address_space(3)))
typedef unsigned short bf16_t;
typedef short bf16x8 __attribute__((ext_vector_type(8)));
typedef float f32x4 __attribute__((ext_vector_type(4)));
typedef unsigned u32x4 __attribute__((ext_vector_type(4)));
typedef unsigned u32x2 __attribute__((ext_vector_type(2)));

constexpr int DM = 1024, NB = 16, SEQ = 2048, CTXL = 256, NH = 16, HD = 64, FF = 4096;
constexpr int MLAT = NB * SEQ;
constexpr int MCTX = NB * CTXL;
constexpr int MALL = MLAT + MCTX;
constexpr float RMS_EPS = 1e-6f;
constexpr float LOG2E = 1.4426950408889634f;
constexpr float QSCALE = 0.125f * LOG2E;

constexpr size_t MiB = 1u << 20;
constexpr size_t WS_SHW = 0;
constexpr size_t WS_MOD = 1 * MiB;
constexpr size_t WS_WCIN = 2 * MiB;
constexpr size_t WS_WCOUT = 8 * MiB;
constexpr size_t WS_WQKV = 10 * MiB;
constexpr size_t WS_WAO = 16 * MiB;
constexpr size_t WS_W1 = 18 * MiB;
constexpr size_t WS_W2 = 34 * MiB;
constexpr size_t WS_H = 50 * MiB;
constexpr size_t WS_XCTX = 122 * MiB;
constexpr size_t WS_BIG = 138 * MiB;
constexpr size_t WS_H2 = 426 * MiB;
constexpr size_t WS_RSS = 498 * MiB;
constexpr size_t WS_CTL = 498 * MiB + 640 * 1024;
constexpr size_t CTL_BYTES = 16384;
constexpr size_t WS_SHA = 500 * MiB;
constexpr size_t WS_END = 502 * MiB;

constexpr int RING_BYTES = 131072;
constexpr int LDS_BYTES = 147456;
constexpr int MISC_OFF = RING_BYTES + 320;

namespace pg8 {
constexpr int BM = 256, BK = 64, HALF = 128, HTB = HALF * BK * 2, STAGE_BYTES = 8 * HTB, NXCD = 8, WGM = 8;
__host__ __device__ __forceinline__ int lds_byte(int r, int c) { const int st = (r >> 4) * 2 + (c >> 5), rr = r & 15, cc = c & 31, ob = rr * 64 + cc * 2; return st * 1024 + (ob ^ (((ob >> 9) & 1) << 5)); }
__host__ __device__ __forceinline__ void stage_rc(int b, int& R, int& C) { const int st = b / 1024, sb = b % 1024, swz = sb ^ (((sb >> 9) & 1) << 5); R = (st >> 1) * 16 + swz / 64; C = (st & 1) * 32 + (swz % 64) / 2; }
__host__ __device__ __forceinline__ int perm32(int rho) { const int n = rho >> 4, i = rho & 15; return 8 * (i >> 2) + 4 * n + (i & 3); }

struct Unit { int pm, pn; };
struct Gemm { const bf16_t* A; const bf16_t* Bt; int M, N, K; };

struct StaticOrder {
    int nM, nN, nwg, G, c, pm0, lbeg, lend;
    __host__ __device__ void init(int M, int N, int G_, int c_, int pm0_ = 0, int lbeg_ = 0, int lend_ = -1) { nM = M / BM; nN = N / BM; nwg = nM * nN; G = G_; c = c_; pm0 = pm0_; lbeg = lbeg_; lend = lend_ < 0 ? nwg : lend_; }
    __host__ __device__ bool next(int i, Unit& u) const {
        const long L = (long)lbeg + (long)i * G + c; if (L >= lend) return false;
        int wgid = (int)L; { const int q = nwg / NXCD, r = nwg % NXCD, xcd = wgid % NXCD, off = wgid / NXCD; wgid = (xcd < r ? xcd * (q + 1) : r * (q + 1) + (xcd - r) * q) + off; }
        const int nig = WGM * nN, gid = wgid / nig, fm = gid * WGM, gsz = (nM - fm) < WGM ? (nM - fm) : WGM;
        u.pm = pm0 + fm + ((wgid % nig) % gsz); u.pn = (wgid % nig) / gsz; return true;
    }
};

__device__ __forceinline__ unsigned cvt_pk_bf16(float lo, float hi) { unsigned r; asm volatile("v_cvt_pk_bf16_f32 %0, %1, %2" : "=v"(r) : "v"(lo), "v"(hi)); return r; }

__device__ __forceinline__ float xsum16(float x) {
    auto r = __builtin_amdgcn_permlane16_swap(__float_as_uint(x), __float_as_uint(x), false, false);
    x = __uint_as_float(r[0]) + __uint_as_float(r[1]);
    auto q = __builtin_amdgcn_permlane32_swap(__float_as_uint(x), __float_as_uint(x), false, false);
    return __uint_as_float(q[0]) + __uint_as_float(q[1]);
}
struct EpiU {
    int mode;
    bf16_t* O; bf16_t* O2; int ldc; int scale_tiles; float sc;
    const float* rss; const float* shw; int shw_ld;
    const float* inLat; const float* inCtx; const bf16_t* inbLat; const bf16_t* inbCtx; bf16_t* outLat; bf16_t* outCtx; const float* gate;
    float* outf5;
    bf16_t* An; const float* gn; const float* scn; float* rssn;
    __device__ __forceinline__ bool has_aux() const { return (mode <= 1 || mode == 4) && rss != nullptr; }
    __device__ __forceinline__ const float* aux_src(const Unit& u, int wid, int lane) const {
        const int i = (wid & 3) * 64 + lane;
        if (mode == 4) { const float* shp = shw + (size_t)(u.pn < (MLAT / BM) ? (u.pn >> 3) : 16) * shw_ld + 2048; return wid < 4 ? shp + u.pm * BM + i : rss + u.pn * BM + i; }
        return wid < 4 ? rss + u.pm * BM + i : shw + (size_t)(u.pm < (MLAT / BM) ? (u.pm >> 3) : 16) * shw_ld + u.pn * BM + i;
    }
    __device__ __forceinline__ void operator()(const f32x4 (&acc)[2][2][4][2], const Unit& u, int wr, int wc, int fr, int fq, const LAS float* aux) const {
        const int row0 = u.pm * BM + wr * 64 + fr;
        if (mode == 5) {
            if (wr == 0) {
#pragma unroll
                for (int m = 0; m < 2; ++m) { const int row = m * 16 + fr;
                    if (row < 17) {
#pragma unroll
                        for (int bj = 0; bj < 2; ++bj)
#pragma unroll
                            for (int n = 0; n < 2; ++n) *(f32x4*)(outf5 + (size_t)row * ldc + u.pn * BM + bj * HALF + wc * 32 + 8 * fq + 4 * n) = acc[0][bj][m][n]; } }
            }
            return;
        }
        if (mode <= 1) {
            const float s = (u.pn < scale_tiles) ? sc : 1.f;
            const int col0 = u.pn * BM + wc * 32 + 8 * fq;
            f32x4 bv[2][2];
#pragma unroll
            for (int bj = 0; bj < 2; ++bj)
#pragma unroll
                for (int n = 0; n < 2; ++n) bv[bj][n] = rss ? *(const LAS f32x4*)(aux + 256 + wc * 32 + 8 * fq + bj * HALF + 4 * n) : (f32x4){0.f, 0.f, 0.f, 0.f};
#pragma unroll
            for (int ai = 0; ai < 2; ++ai)
#pragma unroll
                for (int m = 0; m < 4; ++m) { const int row = row0 + ai * HALF + m * 16; bf16_t* rowp = O + (size_t)row * ldc + col0;
                    const float rinv = rss ? __builtin_amdgcn_rsqf(aux[wr * 64 + fr + ai * HALF + m * 16] * (1.f / DM) + RMS_EPS) : 1.f;
#pragma unroll
                    for (int bj = 0; bj < 2; ++bj) { f32x4 v0 = acc[ai][bj][m][0] * rinv + bv[bj][0], v1 = acc[ai][bj][m][1] * rinv + bv[bj][1];
                        if (mode == 1) { v0 = __builtin_elementwise_max(v0, (f32x4){0.f, 0.f, 0.f, 0.f}); v1 = __builtin_elementwise_max(v1, (f32x4){0.f, 0.f, 0.f, 0.f}); v0 = v0 * v0; v1 = v1 * v1; }
                        v0 = v0 * s; v1 = v1 * s;
                        u32x4 w; w.x = cvt_pk_bf16(v0[0], v0[1]); w.y = cvt_pk_bf16(v0[2], v0[3]); w.z = cvt_pk_bf16(v1[0], v1[1]); w.w = cvt_pk_bf16(v1[2], v1[3]);
                        if (mode == 1) asm volatile("global_store_dwordx4 %0, %1, off sc1\n\ts_nop 2" :: "v"(rowp + bj * HALF), "v"(w) : "memory");
                        else *(u32x4*)(rowp + bj * HALF) = w; } }
        } else if (mode == 4) {
            const int col0 = u.pn * BM + wc * 32 + 8 * fq;
            f32x4 cinv[2][2];
#pragma unroll
            for (int bj = 0; bj < 2; ++bj)
#pragma unroll
                for (int n = 0; n < 2; ++n) { const f32x4 q = *(const LAS f32x4*)(aux + 256 + wc * 32 + 8 * fq + bj * HALF + 4 * n);
#pragma unroll
                    for (int e = 0; e < 4; ++e) cinv[bj][n][e] = __builtin_amdgcn_rsqf(q[e] * (1.f / DM) + RMS_EPS); }
#pragma unroll
            for (int ai = 0; ai < 2; ++ai)
#pragma unroll
                for (int m = 0; m < 4; ++m) { const int row = row0 + ai * HALF + m * 16; bf16_t* rowp = O + (size_t)row * ldc + col0; const float bias = aux[wr * 64 + fr + ai * HALF + m * 16];
#pragma unroll
                    for (int bj = 0; bj < 2; ++bj) { const f32x4 v0 = acc[ai][bj][m][0] * cinv[bj][0] + bias, v1 = acc[ai][bj][m][1] * cinv[bj][1] + bias;
                        u32x4 w; w.x = cvt_pk_bf16(v0[0], v0[1]); w.y = cvt_pk_bf16(v0[2], v0[3]); w.z = cvt_pk_bf16(v1[0], v1[1]); w.w = cvt_pk_bf16(v1[2], v1[3]);
                        *(u32x4*)(rowp + bj * HALF) = w; } }
        } else if (mode == 2) {
            if (u.pn < 8) {
                const int col0 = u.pn * HALF + wc * 32 + 8 * fq;
#pragma unroll
                for (int ai = 0; ai < 2; ++ai)
#pragma unroll
                    for (int m = 0; m < 4; ++m) { bf16_t* rowp = O + (size_t)(row0 + ai * HALF + m * 16) * 1024 + col0;
                        const f32x4 v0 = acc[ai][0][m][0] * acc[ai][1][m][0], v1 = acc[ai][0][m][1] * acc[ai][1][m][1];
                        u32x4 w; w.x = cvt_pk_bf16(v0[0], v0[1]); w.y = cvt_pk_bf16(v0[2], v0[3]); w.z = cvt_pk_bf16(v1[0], v1[1]); w.w = cvt_pk_bf16(v1[2], v1[3]);
                        *(u32x4*)rowp = w; }
            } else {
                const int col0 = (u.pn - 8) * BM + wc * 32 + 8 * fq;
#pragma unroll
                for (int ai = 0; ai < 2; ++ai)
#pragma unroll
                    for (int m = 0; m < 4; ++m) { bf16_t* rowp = O2 + (size_t)(row0 + ai * HALF + m * 16) * 1024 + col0;
#pragma unroll
                        for (int bj = 0; bj < 2; ++bj) { const f32x4 v0 = acc[ai][bj][m][0], v1 = acc[ai][bj][m][1];
                            u32x4 w; w.x = cvt_pk_bf16(v0[0], v0[1]); w.y = cvt_pk_bf16(v0[2], v0[3]); w.z = cvt_pk_bf16(v1[0], v1[1]); w.w = cvt_pk_bf16(v1[2], v1[3]);
                            *(u32x4*)(rowp + bj * HALF) = w; } }
            }
        } else {
            const bool lat = u.pm < (MLAT / BM);
            const int prow = (lat ? u.pm : u.pm - MLAT / BM) * BM + wr * 64 + fr;
            const float* in = lat ? inLat : inCtx; const bf16_t* inb = lat ? inbLat : inbCtx; bf16_t* out = lat ? outLat : outCtx;
            const int brow = lat ? (u.pm >> 3) : 16;
            const float* gp = gate + (size_t)brow * 6144;
            const int col0 = u.pn * BM + wc * 32 + 8 * fq;
            f32x4 gv[2][2], gm[2][2];
#pragma unroll
            for (int bj = 0; bj < 2; ++bj)
#pragma unroll
                for (int n = 0; n < 2; ++n) { gv[bj][n] = *(const f32x4*)(gp + col0 + bj * HALF + 4 * n);
                    gm[bj][n] = An ? *(const f32x4*)(gn + col0 + bj * HALF + 4 * n) * (*(const f32x4*)(scn + (size_t)brow * 6144 + col0 + bj * HALF + 4 * n) + 1.0f) : (f32x4){0.f, 0.f, 0.f, 0.f}; }
#pragma unroll
            for (int ai = 0; ai < 2; ++ai)
#pragma unroll
                for (int m = 0; m < 4; ++m) { const size_t off = (size_t)(prow + ai * HALF + m * 16) * 1024 + col0; float ss = 0.f;
#pragma unroll
                    for (int bj = 0; bj < 2; ++bj) { f32x4 xo[2];
                        if (in) { xo[0] = *(const f32x4*)(in + off + bj * HALF); xo[1] = *(const f32x4*)(in + off + bj * HALF + 4); }
                        else { const u32x4 xw = *(const u32x4*)(inb + off + bj * HALF);
                            xo[0] = (f32x4){__builtin_bit_cast(float, xw.x << 16), __builtin_bit_cast(float, xw.x & 0xffff0000u), __builtin_bit_cast(float, xw.y << 16), __builtin_bit_cast(float, xw.y & 0xffff0000u)};
                            xo[1] = (f32x4){__builtin_bit_cast(float, xw.z << 16), __builtin_bit_cast(float, xw.z & 0xffff0000u), __builtin_bit_cast(float, xw.w << 16), __builtin_bit_cast(float, xw.w & 0xffff0000u)}; }
#pragma unroll
                        for (int n = 0; n < 2; ++n) { xo[n] = xo[n] + gv[bj][n] * acc[ai][bj][m][n];
                            ss += (xo[n][0] * xo[n][0] + xo[n][1] * xo[n][1]) + (xo[n][2] * xo[n][2] + xo[n][3] * xo[n][3]); }
                        { u32x4 w; w.x = cvt_pk_bf16(xo[0][0], xo[0][1]); w.y = cvt_pk_bf16(xo[0][2], xo[0][3]); w.z = cvt_pk_bf16(xo[1][0], xo[1][1]); w.w = cvt_pk_bf16(xo[1][2], xo[1][3]);
                          *(u32x4*)(out + off + bj * HALF) = w; }
                        if (An) { const f32x4 a0 = xo[0] * gm[bj][0], a1 = xo[1] * gm[bj][1];
                            u32x4 w; w.x = cvt_pk_bf16(a0[0], a0[1]); w.y = cvt_pk_bf16(a0[2], a0[3]); w.z = cvt_pk_bf16(a1[0], a1[1]); w.w = cvt_pk_bf16(a1[2], a1[3]);
                            *(u32x4*)(An + (size_t)(row0 + ai * HALF + m * 16) * 1024 + col0 + bj * HALF) = w; } }
                    if (rssn) { ss = xsum16(ss); if (fq == 0) atomicAdd(rssn + row0 + ai * HALF + m * 16, ss); }
                    if (m == 3) asm volatile("" ::: "memory"); }
        }
    }
};

template <class Epi, class Sched, bool ALIGN_EPI = false, bool SP2 = false>
__device__ __forceinline__ void gemm_phase(LAS unsigned char* lds, const Gemm g, const Sched& S, const Epi& E) {
    int tid = threadIdx.x; asm volatile("" : "+v"(tid));
    const int wid = __builtin_amdgcn_readfirstlane(tid >> 6), lane = tid & 63, wr = wid >> 2, wc = wid & 3, fr = lane & 15, fq = lane >> 4;
    const int K = g.K, nt = K / BK;
    unsigned voffA[2], voffB[2];
#pragma unroll
    for (int i = 0; i < 2; ++i) { int R, C; stage_rc(tid * 16 + i * 8192, R, C); const int Rb = (R & ~31) + perm32(R & 31);
        voffA[i] = (unsigned)(R * K + C) * 2u; voffB[i] = (unsigned)(Rb * K + C) * 2u; }
    const size_t kstep = (size_t)(BK * 2);
    const size_t hstep = (size_t)HALF * K * 2;
    const size_t tstep = 2 * hstep;
    const unsigned ldsw = (unsigned)wid * 1024u;
    const int aoff = lds_byte(wr * 64 + fr, fq * 8), boff = lds_byte(wc * 32 + fr, fq * 8);
#define PG8_SA(b, h) (((b) * 2 + (h)) * HTB)
#define PG8_SB(b, h) ((4 + (b) * 2 + (h)) * HTB)
#define PG8_STAGE(bufoff, gbase, voff) do { _Pragma("unroll") for (int _i = 0; _i < 2; ++_i) \
        __builtin_amdgcn_global_load_lds((const unsigned*)((const char*)(gbase) + (voff)[_i]), (LAS unsigned*)(lds + (bufoff) + ldsw + _i * 8192), 16, 0, 0); } while (0)
#define PG8_LDA(dst, b, h) do { _Pragma("unroll") for (int m = 0; m < 4; ++m) _Pragma("unroll") for (int k = 0; k < 2; ++k) dst[m][k] = *(const LAS bf16x8*)(lds + PG8_SA(b, h) + aoff + m * 2048 + k * 1024); } while (0)
#define PG8_LDB(dst, b, h) do { _Pragma("unroll") for (int n = 0; n < 2; ++n) _Pragma("unroll") for (int k = 0; k < 2; ++k) dst[n][k] = *(const LAS bf16x8*)(lds + PG8_SB(b, h) + boff + n * 2048 + k * 1024); } while (0)
#define PG8_MMA(ai, bj, At, Bt) do { __builtin_amdgcn_s_setprio(1); _Pragma("unroll") for (int m = 0; m < 4; ++m) _Pragma("unroll") for (int n = 0; n < 2; ++n) _Pragma("unroll") for (int k = 0; k < 2; ++k) \
        acc[ai][bj][m][n] = __builtin_amdgcn_mfma_f32_16x16x32_bf16(Bt[n][k], At[m][k], acc[ai][bj][m][n], 0, 0, 0); __builtin_amdgcn_s_setprio(0); } while (0)
#define PG8_WAIT_V(n) asm volatile("s_waitcnt vmcnt(" #n ")" ::: "memory")
#define PG8_WAIT_L(n) asm volatile("s_waitcnt lgkmcnt(" #n ")" ::: "memory")
#define PG8_BAR __builtin_amdgcn_s_barrier()
#define PG8_SCHED __builtin_amdgcn_sched_barrier(0)
    Unit cur, nxt; int ui = 0;
    if (!S.next(0, cur)) return;
    constexpr int AUX_OFF = STAGE_BYTES + 1024;
    const bool use_aux = E.has_aux();
    if (use_aux) __builtin_amdgcn_global_load_lds((const unsigned*)E.aux_src(cur, wid, lane), (LAS unsigned*)(lds + AUX_OFF + wid * 256), 4, 0, 0);
    f32x4 acc[2][2][4][2];
#pragma unroll
    for (int a = 0; a < 2; ++a)
#pragma unroll
        for (int b = 0; b < 2; ++b)
#pragma unroll
            for (int m = 0; m < 4; ++m)
#pragma unroll
                for (int n = 0; n < 2; ++n) acc[a][b][m][n] = (f32x4){0.f, 0.f, 0.f, 0.f};
    bf16x8 At[4][2], B0[2][2], B1[2][2];
    const char* cA = (const char*)g.A + (size_t)cur.pm * tstep; const char* cB = (const char*)g.Bt + (size_t)cur.pn * tstep;
    if constexpr (SP2) {
        PG8_STAGE(PG8_SB(0, 0), cB, voffB); PG8_STAGE(PG8_SB(0, 1), cB + hstep, voffB); PG8_STAGE(PG8_SA(0, 0), cA, voffA); PG8_STAGE(PG8_SA(0, 1), cA + hstep, voffA);
        if (wr == 1) PG8_BAR;
        PG8_WAIT_V(2); PG8_BAR;
        PG8_STAGE(PG8_SB(1, 0), cB + kstep, voffB); PG8_STAGE(PG8_SA(1, 0), cA + kstep, voffA); PG8_STAGE(PG8_SB(1, 1), cB + hstep + kstep, voffB);
        PG8_WAIT_V(6); PG8_BAR;
    } else {
        PG8_STAGE(PG8_SB(0, 0), cB, voffB); PG8_STAGE(PG8_SA(0, 0), cA, voffA); PG8_STAGE(PG8_SB(0, 1), cB + hstep, voffB); PG8_STAGE(PG8_SA(0, 1), cA + hstep, voffA);
        if (wr == 1) PG8_BAR;
        PG8_WAIT_V(4); PG8_BAR;
        PG8_STAGE(PG8_SB(1, 0), cB + kstep, voffB); PG8_STAGE(PG8_SA(1, 0), cA + kstep, voffA); PG8_STAGE(PG8_SB(1, 1), cB + hstep + kstep, voffB);
        PG8_WAIT_V(6); PG8_BAR;
    }
    for (;;) {
        const bool has_next = S.next(ui + 1, nxt);
        const char* nA = has_next ? (const char*)g.A + (size_t)nxt.pm * tstep : cA; const char* nB = has_next ? (const char*)g.Bt + (size_t)nxt.pn * tstep : cB;
        for (int t = 0; t < nt; t += 2) {
            const bool last = (t == nt - 2);
            const char* a1 = cA + (size_t)(t + 1) * kstep;
            const char* a2 = last ? nA : cA + (size_t)(t + 2) * kstep; const char* b2 = last ? nB : cB + (size_t)(t + 2) * kstep;
            const char* a3 = a2 + kstep; const char* b3 = b2 + kstep;
            if constexpr (SP2) {
            PG8_LDB(B0, 0, 0); PG8_LDB(B1, 0, 1); PG8_SCHED; PG8_LDA(At, 0, 0); PG8_STAGE(PG8_SA(1, 1), a1 + hstep, voffA);
            PG8_WAIT_V(8); PG8_WAIT_L(0); PG8_BAR; PG8_MMA(0, 0, At, B0); PG8_MMA(0, 1, At, B1); PG8_BAR; PG8_SCHED;
            PG8_LDA(At, 0, 1); PG8_STAGE(PG8_SB(0, 0), b2, voffB); PG8_STAGE(PG8_SB(0, 1), b2 + hstep, voffB); PG8_STAGE(PG8_SA(0, 0), a2, voffA);
            PG8_WAIT_V(8); PG8_WAIT_L(0); PG8_BAR; PG8_MMA(1, 0, At, B0); PG8_MMA(1, 1, At, B1); PG8_BAR; PG8_SCHED;
            PG8_LDB(B0, 1, 0); PG8_LDB(B1, 1, 1); PG8_SCHED; PG8_LDA(At, 1, 0); PG8_STAGE(PG8_SA(0, 1), a2 + hstep, voffA);
            PG8_WAIT_V(8); PG8_WAIT_L(0); PG8_BAR; PG8_MMA(0, 0, At, B0); PG8_MMA(0, 1, At, B1); PG8_BAR; PG8_SCHED;
            PG8_LDA(At, 1, 1); PG8_STAGE(PG8_SB(1, 0), b3, voffB); PG8_STAGE(PG8_SB(1, 1), b3 + hstep, voffB); PG8_STAGE(PG8_SA(1, 0), a3, voffA);
            PG8_WAIT_V(8); PG8_WAIT_L(0); PG8_BAR; PG8_MMA(1, 0, At, B0); PG8_MMA(1, 1, At, B1); PG8_BAR; PG8_SCHED;
            } else {
            PG8_LDB(B0, 0, 0); PG8_SCHED; PG8_LDA(At, 0, 0); PG8_STAGE(PG8_SA(1, 1), a1 + hstep, voffA);
            PG8_WAIT_L(8); PG8_BAR; PG8_WAIT_L(0); PG8_MMA(0, 0, At, B0); PG8_BAR; PG8_SCHED;
            PG8_LDB(B1, 0, 1); PG8_STAGE(PG8_SB(0, 0), b2, voffB);
            PG8_BAR; PG8_WAIT_L(0); PG8_MMA(0, 1, At, B1); PG8_BAR;
            PG8_LDA(At, 0, 1); PG8_STAGE(PG8_SA(0, 0), a2, voffA);
            PG8_BAR; PG8_WAIT_L(0); PG8_MMA(1, 0, At, B0); PG8_BAR; PG8_SCHED;
            PG8_STAGE(PG8_SB(0, 1), b2 + hstep, voffB);
            PG8_WAIT_V(6); PG8_BAR; PG8_MMA(1, 1, At, B1); PG8_BAR;
            PG8_LDB(B0, 1, 0); PG8_SCHED; PG8_LDA(At, 1, 0); PG8_STAGE(PG8_SA(0, 1), a2 + hstep, voffA);
            PG8_WAIT_L(8); PG8_BAR; PG8_WAIT_L(0); PG8_MMA(0, 0, At, B0); PG8_BAR; PG8_SCHED;
            PG8_LDB(B1, 1, 1); PG8_STAGE(PG8_SB(1, 0), b3, voffB);
            PG8_BAR; PG8_WAIT_L(0); PG8_MMA(0, 1, At, B1); PG8_BAR;
            PG8_LDA(At, 1, 1); PG8_STAGE(PG8_SA(1, 0), a3, voffA);
            PG8_BAR; PG8_WAIT_L(0); PG8_MMA(1, 0, At, B0); PG8_BAR; PG8_SCHED;
            PG8_STAGE(PG8_SB(1, 1), b3 + hstep, voffB);
            PG8_WAIT_V(6); PG8_BAR; PG8_MMA(1, 1, At, B1); PG8_BAR;
            }
        }
        if constexpr (ALIGN_EPI) { if (wr == 0) PG8_BAR; }
        E(acc, cur, wr, wc, fr, fq, (const LAS float*)(lds + AUX_OFF + (ui & 1) * 2048));
        if (use_aux && has_next) __builtin_amdgcn_global_load_lds((const unsigned*)E.aux_src(nxt, wid, lane), (LAS unsigned*)(lds + AUX_OFF + ((ui + 1) & 1) * 2048 + wid * 256), 4, 0, 0);
        if (!has_next) break;
#pragma unroll
        for (int a = 0; a < 2; ++a)
#pragma unroll
            for (int b = 0; b < 2; ++b)
#pragma unroll
                for (int m = 0; m < 4; ++m)
#pragma unroll
                    for (int n = 0; n < 2; ++n) acc[a][b][m][n] = (f32x4){0.f, 0.f, 0.f, 0.f};
        cur = nxt; cA = nA; cB = nB; ++ui;
        if constexpr (ALIGN_EPI) { if (wr == 1) PG8_BAR; }
    }
    PG8_WAIT_V(0);
    if constexpr (!ALIGN_EPI) { if (wr == 0) PG8_BAR; }
    PG8_BAR;
#undef PG8_SA
#undef PG8_SB
#undef PG8_STAGE
#undef PG8_LDA
#undef PG8_LDB
#undef PG8_MMA
#undef PG8_WAIT_V
#undef PG8_WAIT_L
#undef PG8_BAR
#undef PG8_SCHED
}
}

__device__ __forceinline__ unsigned f2bf(float f) { unsigned u = __builtin_bit_cast(unsigned, f); return (u + 0x7fffu + ((u >> 16) & 1u)) >> 16; }
__device__ __forceinline__ unsigned pk2(float lo, float hi) { return pg8::cvt_pk_bf16(lo, hi); }
__device__ __forceinline__ float bf_lo(unsigned w) { return __builtin_bit_cast(float, w << 16); }
__device__ __forceinline__ float bf_hi(unsigned w) { return __builtin_bit_cast(float, w & 0xffff0000u); }
__device__ __forceinline__ float wave_sum(float v) {
#pragma unroll
    for (int o = 1; o < 64; o <<= 1) v += __shfl_xor(v, o);
    return v;
}
#define LDS_WAIT() asm volatile("s_waitcnt lgkmcnt(0)" ::: "memory")

struct Args {
    const float* in[17];
    float* out; unsigned char* ws;
    int ph_lo, ph_hi;
};

__device__ __forceinline__ void transpose_item(const float* W, int K, int N, bf16_t* WT, int cinmap, LAS float* scr, int item, int lane) {
    const int nblk = N / 32, kb = item / nblk, nb = item % nblk, k0 = 64 * kb, n0 = 32 * nb;
    float wv[32];
#pragma unroll
    for (int i = 0; i < 32; ++i) { const int kk = 2 * i + (lane >> 5); wv[i] = W[(size_t)(k0 + kk) * N + n0 + (lane & 31)]; }
#pragma unroll
    for (int i = 0; i < 32; ++i) { const int kk = 2 * i + (lane >> 5); scr[kk * 33 + (lane & 31)] = wv[i]; }
    LDS_WAIT(); asm volatile("" ::: "memory");
    int d0 = n0;
    if (cinmap) { if (n0 < 1024) d0 = 2048 + n0; else if (n0 < 2048) { const int ch = n0 - 1024; d0 = (ch >> 7) * 256 + (ch & 127); } else { const int ch = n0 - 2048; d0 = (ch >> 7) * 256 + 128 + (ch & 127); } }
    const int c = lane & 7;
#pragma unroll
    for (int j = 0; j < 4; ++j) { const int n = (lane >> 3) + 8 * j; const LAS float* s = scr + (8 * c) * 33 + n;
        u32x4 o; o.x = pk2(s[0 * 33], s[1 * 33]); o.y = pk2(s[2 * 33], s[3 * 33]); o.z = pk2(s[4 * 33], s[5 * 33]); o.w = pk2(s[6 * 33], s[7 * 33]);
        *(u32x4*)(WT + (size_t)(d0 + n) * K + k0 + 8 * c) = o; }
    LDS_WAIT(); asm volatile("" ::: "memory");
}

__device__ __forceinline__ void gemv17_unit(const LAS float* S, LAS float* red, const float* W, int ldw, int n0, const float* bias, float* out, int ldo, int tid, int lane, int wave) {
    const float* Wp = W + n0 + (lane & 31);
    const int kbase = wave * 128 + (lane >> 5);
    float acc[17];
#pragma unroll
    for (int r = 0; r < 17; ++r) acc[r] = 0.f;
#pragma unroll 1
    for (int ib = 0; ib < 64; ib += 32) {
        float wv[32];
#pragma unroll
        for (int i = 0; i < 32; ++i) wv[i] = Wp[(size_t)(kbase + 2 * (ib + i)) * ldw];
#pragma unroll
        for (int i = 0; i < 32; ++i) { const int k = kbase + 2 * (ib + i);
#pragma unroll
            for (int r = 0; r < 17; ++r) acc[r] += S[r * 1024 + k] * wv[i]; }
    }
#pragma unroll
    for (int r = 0; r < 17; ++r) acc[r] += __shfl_xor(acc[r], 32);
    if (lane < 32) {
#pragma unroll
        for (int r = 0; r < 17; ++r) red[(wave * 17 + r) * 32 + lane] = acc[r]; }
    __syncthreads();
    for (int o = tid; o < 17 * 32; o += 512) { const int r = o >> 5, c2 = o & 31; float s = bias ? bias[n0 + c2] : 0.f;
#pragma unroll
        for (int w = 0; w < 8; ++w) s += red[(w * 17 + r) * 32 + c2];
        out[(size_t)r * ldo + n0 + c2] = s; }
    __syncthreads();
}

__device__ __forceinline__ void p0_phase(const Args& a, LAS unsigned char* lds, int tid, int lane, int wave, int bid, int G) {
    { float* rss = (float*)(a.ws + WS_RSS); for (int i = bid * 512 + tid; i < 4 * MALL; i += G * 512) rss[i] = 0.f; }
    {
        LAS float* S = (LAS float*)lds;
        LAS float* red = (LAS float*)(lds + 17 * 1024 * 4);
        const float* c = a.in[1]; const float* cc = a.in[3]; const float* ada_w = a.in[6]; const float* ada_b = a.in[7];
        float* mod = (float*)(a.ws + WS_MOD);
        for (int i = tid; i < 17 * 1024; i += 512) { const float v = i < 16384 ? c[i] : cc[i - 16384]; S[i] = v / (1.f + __expf(-v)); }
        __syncthreads();
        for (int unit = bid; unit < 384; unit += G) {
            const int l = unit / 192, n0 = (unit % 192) * 32;
            gemv17_unit(S, red, ada_w + (size_t)l * 1024 * 6144, 6144, n0, ada_b + l * 6144, mod + (size_t)l * 17 * 6144, 6144, tid, lane, wave);
        }
    }
    {
        LAS float* scr = (LAS float*)(lds + wave * 16384);
        const int gw = bid * 8 + wave, NGW = G * 8;
        constexpr int I_CIN = 16 * 96, I_SQ = 16 * 32, I_UP = 16 * 128, I_DN = 64 * 32;
        constexpr int NITEMS = 2 * I_CIN + 2 * I_SQ + 2 * I_UP + 2 * I_DN;
        bf16_t* ws16 = (bf16_t*)a.ws;
        for (int it = gw; it < NITEMS; it += NGW) {
            int r = it;
            if (r < I_CIN) { transpose_item(a.in[8], 1024, 3072, (bf16_t*)(a.ws + WS_WCIN), 1, scr, r, lane); continue; } r -= I_CIN;
            if (r < I_CIN) { transpose_item(a.in[11], 1024, 3072, (bf16_t*)(a.ws + WS_WQKV), 0, scr, r, lane); continue; } r -= I_CIN;
            if (r < I_SQ) { transpose_item(a.in[10], 1024, 1024, (bf16_t*)(a.ws + WS_WCOUT), 0, scr, r, lane); continue; } r -= I_SQ;
            if (r < I_SQ) { transpose_item(a.in[13], 1024, 1024, (bf16_t*)(a.ws + WS_WAO), 0, scr, r, lane); continue; } r -= I_SQ;
            if (r < 2 * I_UP) { const int l = r / I_UP; transpose_item(a.in[14] + (size_t)l * 1024 * 4096, 1024, 4096, (bf16_t*)(a.ws + WS_W1) + (size_t)l * 4096 * 1024, 0, scr, r % I_UP, lane); continue; } r -= 2 * I_UP;
            { const int l = r / I_DN; transpose_item(a.in[15] + (size_t)l * 4096 * 1024, 4096, 1024, (bf16_t*)(a.ws + WS_W2) + (size_t)l * 1024 * 4096, 0, scr, r % I_DN, lane); }
        }
        (void)ws16;
    }
}

__device__ __forceinline__ void shw_jobs(const Args& a, LAS unsigned char* lds, int tid, int lane, int wave, int bid, int G) {
    LAS float* S = (LAS float*)lds; LAS float* red = (LAS float*)(lds + 17 * 1024 * 4);
    const float* mod = (const float*)(a.ws + WS_MOD); float* shw = (float*)(a.ws + WS_SHW);
    __syncthreads();
#pragma unroll 1
    for (int job = 0; job < 3; ++job) {
        const int N = (job == 1) ? 3072 : 4096, nunits = N / 32, off = (job == 0) ? 0 : (job == 1) ? 128 : 224;
        const float* W = (job == 0) ? a.in[14] : (job == 1) ? a.in[11] : a.in[14] + (size_t)1024 * 4096;
        const float* sh = mod + (job == 0 ? 3 * 1024 : job == 1 ? 17 * 6144 : 17 * 6144 + 3 * 1024);
        float* out = shw + (job == 0 ? 0 : job == 1 ? 17 * 4096 : 17 * 4096 + 17 * 3072);
        int unit = bid - off; if (unit < 0) unit += G;
        if (unit < nunits) {
            for (int i = tid; i < 17 * 1024; i += 512) S[i] = sh[(size_t)(i >> 10) * 6144 + (i & 1023)];
            __syncthreads();
            for (; unit < nunits; unit += G) gemv17_unit(S, red, W, N, unit * 32, nullptr, out, N, tid, lane, wave);
        }
    }
}

__device__ __forceinline__ void norm_phase(const float* xlat, const float* xctx, int nrows, const float* g, const float* modl, int sh_chunk, int sc_chunk,
                                           bf16_t* H, float* outf, const float* rssf, int gw, int NGW, int lane) {
    constexpr int R = 4;
    const int ngroups = nrows / R;
    for (int grp = gw; grp < ngroups; grp += NGW) {
        f32x4 v[R][4]; float inv[R];
#pragma unroll
        for (int q = 0; q < R; ++q) { const int row = grp * R + q; const bool lat = row < MLAT;
            const f32x4* xr = (const f32x4*)(lat ? xlat + (size_t)row * DM : xctx + (size_t)(row - MLAT) * DM) + lane;
#pragma unroll
            for (int jx = 0; jx < 4; ++jx) v[q][jx] = xr[64 * jx]; }
        if (rssf) {
#pragma unroll
            for (int q = 0; q < R; ++q) inv[q] = rsqrtf(rssf[grp * R + q] * (1.f / DM) + RMS_EPS);
        } else {
            float s[R];
#pragma unroll
            for (int q = 0; q < R; ++q) { s[q] = 0.f;
#pragma unroll
                for (int jx = 0; jx < 4; ++jx) s[q] += (v[q][jx].x * v[q][jx].x + v[q][jx].y * v[q][jx].y) + (v[q][jx].z * v[q][jx].z + v[q][jx].w * v[q][jx].w); }
#pragma unroll
            for (int o = 1; o < 64; o <<= 1) {
#pragma unroll
                for (int q = 0; q < R; ++q) s[q] += __shfl_xor(s[q], o); }
#pragma unroll
            for (int q = 0; q < R; ++q) inv[q] = rsqrtf(s[q] * (1.f / DM) + RMS_EPS);
        }
#pragma unroll
        for (int q = 0; q < R; ++q) { const int row = grp * R + q; const bool lat = row < MLAT;
            if (modl) {
                const float* mr = modl + (size_t)(lat ? (row >> 11) : 16) * 6144;
                unsigned long long* o8 = (unsigned long long*)(H + (size_t)row * DM) + lane;
#pragma unroll
                for (int jx = 0; jx < 4; ++jx) { const int c = 4 * lane + 256 * jx;
                    const f32x4 gg = *(const f32x4*)(g + c), sc = *(const f32x4*)(mr + sc_chunk * 1024 + c), sh = *(const f32x4*)(mr + sh_chunk * 1024 + c);
                    const f32x4 o = (v[q][jx] * inv[q] * gg) * (sc + 1.0f) + sh;
                    o8[64 * jx] = (unsigned long long)pk2(o.x, o.y) | ((unsigned long long)pk2(o.z, o.w) << 32); }
            } else {
                f32x4* orow = (f32x4*)(outf + (size_t)row * DM) + lane;
#pragma unroll
                for (int jx = 0; jx < 4; ++jx) { const int c = 4 * lane + 256 * jx; const f32x4 gg = *(const f32x4*)(g + c); orow[64 * jx] = v[q][jx] * inv[q] * gg; }
            }
        }
    }
}

__device__ __forceinline__ void final_phase(const bf16_t* xb, const float* rssf, const float* g, float* out, int gw, int NGW, int lane) {
    constexpr int R = 4;
    for (int grp = gw; grp < MLAT / R; grp += NGW) {
        u32x4 v[R][2];
#pragma unroll
        for (int q = 0; q < R; ++q)
#pragma unroll
            for (int jx = 0; jx < 2; ++jx) v[q][jx] = *(const u32x4*)(xb + (size_t)(grp * R + q) * DM + jx * 512 + lane * 8);
#pragma unroll
        for (int q = 0; q < R; ++q) { const int row = grp * R + q; const float inv = rsqrtf(rssf[row] * (1.f / DM) + RMS_EPS);
#pragma unroll
            for (int jx = 0; jx < 2; ++jx) { const int c = jx * 512 + lane * 8; const f32x4 g0 = *(const f32x4*)(g + c), g1 = *(const f32x4*)(g + c + 4); const u32x4 w = v[q][jx];
                const f32x4 x0 = (f32x4){bf_lo(w.x), bf_hi(w.x), bf_lo(w.y), bf_hi(w.y)}, x1 = (f32x4){bf_lo(w.z), bf_hi(w.z), bf_lo(w.w), bf_hi(w.w)};
                *(f32x4*)(out + (size_t)row * DM + c) = x0 * inv * g0; *(f32x4*)(out + (size_t)row * DM + c + 4) = x1 * inv * g1; } }
    }
}

__device__ __forceinline__ void unpack8(const u32x4 w, float (&f)[8]) { f[0] = bf_lo(w.x); f[1] = bf_hi(w.x); f[2] = bf_lo(w.y); f[3] = bf_hi(w.y); f[4] = bf_lo(w.z); f[5] = bf_hi(w.z); f[6] = bf_lo(w.w); f[7] = bf_hi(w.w); }
__device__ __forceinline__ void unpack4(const u32x2 w, float (&f)[4]) { f[0] = bf_lo(w.x); f[1] = bf_hi(w.x); f[2] = bf_lo(w.y); f[3] = bf_hi(w.y); }
__device__ __forceinline__ void convgate_phase(const bf16_t* U, const bf16_t* Bg, const float* cw, bf16_t* Gout, int gw, int NGW, int lane) {
    constexpr int RC = 8;
    for (int item = gw; item < (MALL / RC) * 4; item += NGW) {
        const int chunk = item >> 2, strip = item & 3, t0 = chunk * RC, ch = strip * 256 + lane * 4;
        const int tl = t0 < MLAT ? (t0 & (SEQ - 1)) : ((t0 - MLAT) & (CTXL - 1)); const int sl = t0 < MLAT ? SEQ : CTXL;
        const bool first = (tl == 0), lastc = (tl + RC == sl);
        const f32x4 w0 = *(const f32x4*)(cw + ch), w1 = *(const f32x4*)(cw + 1024 + ch), w2 = *(const f32x4*)(cw + 2048 + ch);
        const bf16_t* up = U + (size_t)t0 * DM + ch; const bf16_t* bp = Bg + (size_t)t0 * DM + ch; bf16_t* gp = Gout + (size_t)t0 * DM + ch;
        const u32x2 zero = (u32x2){0u, 0u};
        u32x2 uw[RC + 2], bw[RC];
        uw[0] = first ? zero : *(const u32x2*)(up - DM);
#pragma unroll
        for (int t = 0; t < RC; ++t) { uw[t + 1] = *(const u32x2*)(up + (size_t)t * DM); bw[t] = *(const u32x2*)(bp + (size_t)t * DM); }
        uw[RC + 1] = lastc ? zero : *(const u32x2*)(up + (size_t)RC * DM);
#pragma unroll
        for (int t = 0; t < RC; ++t) {
            float pf[4], cf[4], nf[4], bf[4];
            unpack4(uw[t], pf); unpack4(uw[t + 1], cf); unpack4(uw[t + 2], nf); unpack4(bw[t], bf);
            float o[4];
#pragma unroll
            for (int e = 0; e < 4; ++e) o[e] = bf[e] * (w0[e] * pf[e] + w1[e] * cf[e] + w2[e] * nf[e]);
            u32x2 ow; ow.x = pk2(o[0], o[1]); ow.y = pk2(o[2], o[3]);
            *(u32x2*)(gp + (size_t)t * DM) = ow;
        }
    }
}

struct KBuf { bf16x8 k[2][2]; };
struct VBuf { bf16x8 v[4]; };
constexpr int VT_LD = MALL;
struct KVOff { unsigned k0, v0; };
typedef __amdgpu_buffer_rsrc_t rsrc_t;
__device__ __forceinline__ bf16x8 bload(rsrc_t r, unsigned voff, unsigned soff) { return __builtin_bit_cast(bf16x8, __builtin_amdgcn_raw_buffer_load_b128(r, (int)voff, (int)soff, 0)); }
__device__ __forceinline__ void k_load(KBuf& B, rsrc_t rk, const KVOff& f, int kt) {
    const unsigned sk = (unsigned)kt * 4096u;
    B.k[0][0] = bload(rk, f.k0, sk); B.k[0][1] = bload(rk, f.k0 + 64u, sk);
    B.k[1][0] = bload(rk, f.k0, sk + 16384u); B.k[1][1] = bload(rk, f.k0 + 64u, sk + 16384u);
}
__device__ __forceinline__ void v_load(VBuf& B, rsrc_t rv, const KVOff& f, int kt) {
    const unsigned sv = (unsigned)kt * 2u;
#pragma unroll
    for (int d = 0; d < 4; ++d) B.v[d] = bload(rv, f.v0, sv + (unsigned)d * (16u * VT_LD * 2u));
}
__device__ __forceinline__ float red16_max(float x) {
#if __has_builtin(__builtin_amdgcn_permlane16_swap)
    auto r = __builtin_amdgcn_permlane16_swap(__float_as_uint(x), __float_as_uint(x), false, false);
    x = fmaxf(__uint_as_float(r[0]), __uint_as_float(r[1]));
#else
    x = fmaxf(x, __shfl_xor(x, 16));
#endif
    auto q = __builtin_amdgcn_permlane32_swap(__float_as_uint(x), __float_as_uint(x), false, false);
    return fmaxf(__uint_as_float(q[0]), __uint_as_float(q[1]));
}
__device__ __forceinline__ float red16_sum(float x) {
#if __has_builtin(__builtin_amdgcn_permlane16_swap)
    auto r = __builtin_amdgcn_permlane16_swap(__float_as_uint(x), __float_as_uint(x), false, false);
    x = __uint_as_float(r[0]) + __uint_as_float(r[1]);
#else
    x = x + __shfl_xor(x, 16);
#endif
    auto q = __builtin_amdgcn_permlane32_swap(__float_as_uint(x), __float_as_uint(x), false, false);
    return __uint_as_float(q[0]) + __uint_as_float(q[1]);
}
__device__ __forceinline__ void attn_step(const KBuf& B, const VBuf& V, const bf16x8 (&qf)[2], f32x4 c0, f32x4 c1, float& m, float& l, f32x4 (&o)[4]) {
    f32x4 s0 = __builtin_amdgcn_mfma_f32_16x16x32_bf16(B.k[0][0], qf[0], c0, 0, 0, 0);
    f32x4 s1 = __builtin_amdgcn_mfma_f32_16x16x32_bf16(B.k[1][0], qf[0], c1, 0, 0, 0);
    s0 = __builtin_amdgcn_mfma_f32_16x16x32_bf16(B.k[0][1], qf[1], s0, 0, 0, 0);
    s1 = __builtin_amdgcn_mfma_f32_16x16x32_bf16(B.k[1][1], qf[1], s1, 0, 0, 0);
    float mx = fmaxf(fmaxf(fmaxf(s0[0], s0[1]), fmaxf(s0[2], s0[3])), fmaxf(fmaxf(s1[0], s1[1]), fmaxf(s1[2], s1[3])));
    mx = red16_max(mx);
    const float mn = fmaxf(m, mx);
    const float alpha = __builtin_amdgcn_exp2f(m - mn);
    m = mn;
    f32x4 p0, p1;
#pragma unroll
    for (int e = 0; e < 4; ++e) { p0[e] = __builtin_amdgcn_exp2f(s0[e] - mn); p1[e] = __builtin_amdgcn_exp2f(s1[e] - mn); }
    l = l * alpha + ((p0[0] + p0[1]) + (p0[2] + p0[3])) + ((p1[0] + p1[1]) + (p1[2] + p1[3]));
    u32x4 pw; pw.x = pk2(p0[0], p0[1]); pw.y = pk2(p0[2], p0[3]); pw.z = pk2(p1[0], p1[1]); pw.w = pk2(p1[2], p1[3]);
    const bf16x8 pf = __builtin_bit_cast(bf16x8, pw);
#pragma unroll
    for (int d = 0; d < 4; ++d) { o[d] = o[d] * alpha; o[d] = __builtin_amdgcn_mfma_f32_16x16x32_bf16(V.v[d], pf, o[d], 0, 0, 0); }
}

__device__ __forceinline__ void attn_step2(const KBuf& KA, const VBuf& VA, const KBuf& KB, const VBuf& VB, const bf16x8 (&qf)[2], f32x4 c0, f32x4 c1, float& m, float& l, f32x4 (&o)[4]) {
    const f32x4 z4 = (f32x4){0.f, 0.f, 0.f, 0.f};
    f32x4 a0 = __builtin_amdgcn_mfma_f32_16x16x32_bf16(KA.k[0][0], qf[0], z4, 0, 0, 0);
    f32x4 a1 = __builtin_amdgcn_mfma_f32_16x16x32_bf16(KA.k[1][0], qf[0], z4, 0, 0, 0);
    f32x4 b0 = __builtin_amdgcn_mfma_f32_16x16x32_bf16(KB.k[0][0], qf[0], c0, 0, 0, 0);
    f32x4 b1 = __builtin_amdgcn_mfma_f32_16x16x32_bf16(KB.k[1][0], qf[0], c1, 0, 0, 0);
    a0 = __builtin_amdgcn_mfma_f32_16x16x32_bf16(KA.k[0][1], qf[1], a0, 0, 0, 0);
    a1 = __builtin_amdgcn_mfma_f32_16x16x32_bf16(KA.k[1][1], qf[1], a1, 0, 0, 0);
    b0 = __builtin_amdgcn_mfma_f32_16x16x32_bf16(KB.k[0][1], qf[1], b0, 0, 0, 0);
    b1 = __builtin_amdgcn_mfma_f32_16x16x32_bf16(KB.k[1][1], qf[1], b1, 0, 0, 0);
    float mxa = fmaxf(fmaxf(fmaxf(a0[0], a0[1]), fmaxf(a0[2], a0[3])), fmaxf(fmaxf(a1[0], a1[1]), fmaxf(a1[2], a1[3])));
    float mxb = fmaxf(fmaxf(fmaxf(b0[0], b0[1]), fmaxf(b0[2], b0[3])), fmaxf(fmaxf(b1[0], b1[1]), fmaxf(b1[2], b1[3])));
    const float mx = red16_max(fmaxf(mxa, mxb));
    const float mn = fmaxf(m, mx);
    const float alpha = __builtin_amdgcn_exp2f(m - mn);
    m = mn;
    f32x4 pa0, pa1, pb0, pb1;
#pragma unroll
    for (int e = 0; e < 4; ++e) { pa0[e] = __builtin_amdgcn_exp2f(a0[e] - mn); pa1[e] = __builtin_amdgcn_exp2f(a1[e] - mn); pb0[e] = __builtin_amdgcn_exp2f(b0[e] - mn); pb1[e] = __builtin_amdgcn_exp2f(b1[e] - mn); }
    const f32x4 ps = (pa0 + pa1) + (pb0 + pb1);
    l = l * alpha + ((ps[0] + ps[1]) + (ps[2] + ps[3]));
    u32x4 wa, wb; wa.x = pk2(pa0[0], pa0[1]); wa.y = pk2(pa0[2], pa0[3]); wa.z = pk2(pa1[0], pa1[1]); wa.w = pk2(pa1[2], pa1[3]);
    wb.x = pk2(pb0[0], pb0[1]); wb.y = pk2(pb0[2], pb0[3]); wb.z = pk2(pb1[0], pb1[1]); wb.w = pk2(pb1[2], pb1[3]);
    const bf16x8 pfa = __builtin_bit_cast(bf16x8, wa), pfb = __builtin_bit_cast(bf16x8, wb);
#pragma unroll
    for (int d = 0; d < 4; ++d) { o[d] = o[d] * alpha; o[d] = __builtin_amdgcn_mfma_f32_16x16x32_bf16(VA.v[d], pfa, o[d], 0, 0, 0); o[d] = __builtin_amdgcn_mfma_f32_16x16x32_bf16(VB.v[d], pfb, o[d], 0, 0, 0); }
}

constexpr int TAB_LD = 48, TAB_ROWS = 15;
constexpr int CK_STRIDE = 144, CV_STRIDE = 528, RW_STRIDE = 144;
constexpr int LDS_TAB = 0, LDS_CK = 3072, LDS_CV = LDS_CK + CTXL * CK_STRIDE, LDS_RING = LDS_CV + HD * CV_STRIDE;
constexpr int ROWK_BYTES = 64 * RW_STRIDE, SLOT_BYTES = 2 * ROWK_BYTES, LDS_ATT_END = LDS_RING + 3 * SLOT_BYTES;
static_assert(TAB_ROWS * TAB_LD * 4 <= LDS_CK && LDS_ATT_END <= RING_BYTES, "attention LDS map");
__device__ __forceinline__ int rs_of(int r) { int v = r - 4; return v < 0 ? 0 : (v > 24 ? 24 : v); }
__device__ __forceinline__ void attn_phase(const bf16_t* QK, const bf16_t* VT, bf16_t* O, const float* rpb, LAS unsigned char* lds, int tid, int lane, int wave, int bid, int G) {
    LAS float* tab = (LAS float*)(lds + LDS_TAB);
    const int fr = lane & 15, fq = lane >> 4;
    const int j = wave & 3, rw = wave >> 2;
    const int kc0 = (j == 0) ? 0 : (j == 1) ? 8 : (j == 2) ? 24 : 32;
    unsigned bpk0 = 0u, bpk1 = 0u;
    { const int cq = 16 * j + fr; int cs = cq - 8; cs = cs < 0 ? 0 : (cs > 48 ? 48 : cs);
#pragma unroll
      for (int jj = 0; jj < 8; ++jj) { const int ck = kc0 + 8 * fq + jj; const bool valid = (ck >= cs) && (ck < cs + 16); const unsigned col = valid ? (unsigned)(ck - cq + 15) : 31u;
          if (jj < 4) bpk0 |= col << (8 * jj); else bpk1 |= col << (8 * (jj - 4)); } }
    LAS unsigned char* ckl = lds + LDS_CK + fr * CK_STRIDE + fq * 16;
    LAS unsigned char* cvl = lds + LDS_CV + fr * CV_STRIDE + fq * 16;
    const int klo = LDS_RING + (kc0 + 8 * (fr >> 2) + (fr & 3)) * RW_STRIDE + fq * 16;
    const int vlo = LDS_RING + ROWK_BYTES + fr * RW_STRIDE + (kc0 + 8 * fq) * 2;
    const int st_t = tid >> 3, st_ch = tid & 7;
    const int st_off = st_t * RW_STRIDE + st_ch * 16;
    for (int bh = bid; bh < NB * NH; bh += G) {
        const int b = bh >> 4, h = bh & 15;
        const int ctx_kt0 = MLAT + b * CTXL;
        const bf16_t* ksrc = QK + (size_t)(b * SEQ + st_t) * 2048 + 1024 + h * 64 + st_ch * 8;
        const bf16_t* vsrc = VT + (size_t)(h * 64 + st_t) * VT_LD + b * SEQ + st_ch * 8;
        __syncthreads();
        for (int i = tid; i < TAB_ROWS * TAB_LD; i += 512) { const int col = i % TAB_LD, dr = i / TAB_LD; tab[i] = col < 31 ? rpb[(h * TAB_ROWS + dr) * 31 + col] * LOG2E : -1e30f; }
        for (int p = tid; p < CTXL * 8; p += 512) { const int key = p >> 3, ch = p & 7, c = key >> 5, w = key & 31; const int slot = c * 32 + ((w >> 2) & 1) * 16 + (w >> 3) * 4 + (w & 3);
            *(LAS u32x4*)(lds + LDS_CK + slot * CK_STRIDE + ch * 16) = *(const u32x4*)(QK + (size_t)(ctx_kt0 + key) * 2048 + 1024 + h * 64 + ch * 8); }
        for (int p = tid; p < HD * 32; p += 512) { const int d = p >> 5, ch = p & 31;
            *(LAS u32x4*)(lds + LDS_CV + d * CV_STRIDE + ch * 16) = *(const u32x4*)(VT + (size_t)(h * 64 + d) * VT_LD + ctx_kt0 + ch * 8); }
#pragma unroll
        for (int s0 = 0; s0 < 2; ++s0) {
            *(LAS u32x4*)(lds + LDS_RING + s0 * SLOT_BYTES + st_off) = *(const u32x4*)(ksrc + (size_t)s0 * 64 * 2048);
            *(LAS u32x4*)(lds + LDS_RING + s0 * SLOT_BYTES + ROWK_BYTES + st_off) = *(const u32x4*)(vsrc + s0 * 64); }
        u32x4 kr0, vr0, kr1, vr1, kr2, vr2;
        kr2 = *(const u32x4*)(ksrc + (size_t)2 * 64 * 2048); vr2 = *(const u32x4*)(vsrc + 2 * 64);
        kr0 = *(const u32x4*)(ksrc + (size_t)3 * 64 * 2048); vr0 = *(const u32x4*)(vsrc + 3 * 64);
        kr1 = kr0; vr1 = vr0;
        asm volatile("s_waitcnt lgkmcnt(0)" ::: "memory"); __builtin_amdgcn_s_barrier(); asm volatile("" ::: "memory");
        int gslot = 0;
        int it = 0, sc = 0, n_cur = 8, rs_lo = 0;
        int r_ = rw, rsw_ = 0, tq0_ = b * SEQ + rw * 64 + j * 16;
        int itp = 0, sp = 4, np = 8, prow = 4;
        bf16x8 qf[2], qn[2]; float m = -1e30f, l = 0.f; f32x4 o[4];
        qf[0] = qf[1] = (bf16x8){0, 0, 0, 0, 0, 0, 0, 0};
#pragma unroll
        for (int ks = 0; ks < 2; ++ks) qn[ks] = *(const bf16x8*)(QK + (size_t)(b * SEQ + rw * 64 + j * 16 + fr) * 2048 + h * 64 + ks * 32 + fq * 8);
#pragma unroll
        for (int d = 0; d < 4; ++d) o[d] = (f32x4){0.f, 0.f, 0.f, 0.f};
#define ATT_STEP(KI, VI, KW, VW) do { \
            { const int row_ = itp < 16 ? prow : 0; KI = *(const u32x4*)(ksrc + (size_t)row_ * 64 * 2048); VI = *(const u32x4*)(vsrc + row_ * 64); } \
            ++prow; if (++sp >= np) { sp = 0; ++itp; prow = rs_of(2 * itp); np = 8 + rs_of(2 * itp + 1) - prow; } \
            if (it < 16) { \
                if (sc == 0) { qf[0] = qn[0]; qf[1] = qn[1]; \
                    m = -1e30f; l = 0.f; _Pragma("unroll") for (int d = 0; d < 4; ++d) o[d] = (f32x4){0.f, 0.f, 0.f, 0.f}; } \
                if (sc == n_cur - 2) { const int tqn_ = tq0_ + (it < 15 ? 128 : 0);        \
                    _Pragma("unroll") for (int ks = 0; ks < 2; ++ks) qn[ks] = *(const bf16x8*)(QK + (size_t)(tqn_ + fr) * 2048 + h * 64 + ks * 32 + fq * 8); } \
                const int c_ = rs_lo + sc - rsw_; \
                if (c_ >= 0 && c_ < 8) { \
                    KBuf kc_, kl_; VBuf vc_, vl_; \
                    const LAS unsigned char* cks = ckl + c_ * 32 * CK_STRIDE; const LAS unsigned char* cvs = cvl + c_ * 64; \
                    const LAS unsigned char* lk = lds + klo + gslot * SLOT_BYTES; const LAS unsigned char* lv = lds + vlo + gslot * SLOT_BYTES; \
                    _Pragma("unroll") for (int T = 0; T < 2; ++T) _Pragma("unroll") for (int ks = 0; ks < 2; ++ks) { \
                        kc_.k[T][ks] = *(const LAS bf16x8*)(cks + T * 16 * CK_STRIDE + ks * 64); kl_.k[T][ks] = *(const LAS bf16x8*)(lk + T * 4 * RW_STRIDE + ks * 64); } \
                    _Pragma("unroll") for (int d = 0; d < 4; ++d) { vc_.v[d] = *(const LAS bf16x8*)(cvs + d * 16 * CV_STRIDE); vl_.v[d] = *(const LAS bf16x8*)(lv + d * 16 * RW_STRIDE); } \
                    const int tb_ = (rsw_ - r_ + 7 + c_) * TAB_LD; f32x4 c0_, c1_; \
                    _Pragma("unroll") for (int e = 0; e < 4; ++e) { c0_[e] = tab[tb_ + (int)((bpk0 >> (8 * e)) & 255u)]; c1_[e] = tab[tb_ + (int)((bpk1 >> (8 * e)) & 255u)]; } \
                    attn_step2(kc_, vc_, kl_, vl_, qf, c0_, c1_, m, l, o); } \
                if (sc == n_cur - 1) { \
                    const float lt = red16_sum(l); const float rl = 1.0f / lt; \
                    bf16_t* op = O + (size_t)(tq0_ + fr) * DM + h * 64 + 4 * fq; \
                    _Pragma("unroll") for (int d = 0; d < 4; ++d) { const f32x4 v = o[d] * rl; u32x2 w; w.x = pk2(v[0], v[1]); w.y = pk2(v[2], v[3]); *(u32x2*)(op + d * 16) = w; } } \
                if (++sc >= n_cur) { sc = 0; ++it; rs_lo = rs_of(2 * it); const int rs_hi_ = rs_of(2 * it + 1); n_cur = 8 + rs_hi_ - rs_lo; \
                    r_ = 2 * it + rw; rsw_ = rw ? rs_hi_ : rs_lo; tq0_ = b * SEQ + r_ * 64 + j * 16; } } \
            { int wslot = gslot + 2; wslot = wslot >= 3 ? wslot - 3 : wslot; \
              *(LAS u32x4*)(lds + LDS_RING + wslot * SLOT_BYTES + st_off) = KW; *(LAS u32x4*)(lds + LDS_RING + wslot * SLOT_BYTES + ROWK_BYTES + st_off) = VW; } \
            asm volatile("s_waitcnt lgkmcnt(0)" ::: "memory"); __builtin_amdgcn_s_barrier(); asm volatile("" ::: "memory"); \
            gslot = gslot == 2 ? 0 : gslot + 1; } while (0)
#pragma unroll 1
        for (int g = 0; g < 141; g += 3) {
            ATT_STEP(kr1, vr1, kr2, vr2);
            ATT_STEP(kr2, vr2, kr0, vr0);
            ATT_STEP(kr0, vr0, kr1, vr1);
        }
#undef ATT_STEP
    }
}

#define XB_TMO      128
#define XB_XCNT(j)  (256  + 64 * (j))
#define XB_XSUB(j)  (1280 + 64 * (j))
#define XB_XGEN(j)  (2304 + 64 * (j))
#define XB_TOP      3328
#define XB_TOPGEN   3392
#define XCD_BAR_WORDS 3456
#define XB_SPIN_CAP (1u << 18)

__device__ __forceinline__ unsigned xb_ld(unsigned* p)              { return __hip_atomic_load(p, __ATOMIC_RELAXED, __HIP_MEMORY_SCOPE_AGENT); }
__device__ __forceinline__ unsigned xb_add(unsigned* p, unsigned v) { return __hip_atomic_fetch_add(p, v, __ATOMIC_RELAXED, __HIP_MEMORY_SCOPE_AGENT); }
__device__ __forceinline__ unsigned xb_xcc_id() { return (unsigned)__builtin_amdgcn_s_getreg((3 << 11) | 20) & 0xFu; }
#define XB_SPIN(cond, bar) do { unsigned _sp = 0; while (cond) { __builtin_amdgcn_s_sleep(1); \
    if ((++_sp & 255u) == 0u) { if (xb_ld(&(bar)[XB_TMO])) break; if (_sp > XB_SPIN_CAP) { atomicAdd(&(bar)[XB_TMO], 1u); break; } } } } while (0)

struct XcdBarrier {
    unsigned* bar; unsigned x;
    volatile LAS unsigned* st;
};

__device__ __forceinline__ XcdBarrier xcd_barrier_post(unsigned* bar, volatile LAS unsigned* st) {
    XcdBarrier b; b.bar = bar; b.x = xb_xcc_id(); b.st = st;
    if (threadIdx.x == 0) (void)xb_add(&bar[XB_XCNT(b.x)], 1u);
    return b;
}
__device__ __forceinline__ void xcd_barrier_complete(unsigned* bar, unsigned x, unsigned& nloc, unsigned& nx) {
    const unsigned G = gridDim.x * gridDim.y * gridDim.z;
    unsigned sum, cnt, mine, sp = 0u;
    for (;;) {
        sum = 0u; cnt = 0u; mine = 0u;
#pragma unroll
        for (unsigned j = 0; j < 16; ++j) { const unsigned c = xb_ld(&bar[XB_XCNT(j)]); sum += c; cnt += (c > 0u) ? 1u : 0u; mine = (j == x) ? c : mine; }
        if (sum == G) break;
        __builtin_amdgcn_s_sleep(1);
        if ((++sp & 255u) == 0u) { if (xb_ld(&bar[XB_TMO])) break; if (sp > XB_SPIN_CAP) { atomicAdd(&bar[XB_TMO], 1u); break; } }
    }
    nloc = mine > 0u ? mine : 1u; nx = cnt > 0u ? cnt : 1u;
}

__device__ __forceinline__ void xcd_barrier(const XcdBarrier& b) {
    asm volatile("s_waitcnt vmcnt(0)" ::: "memory");
    __syncthreads();
    if (threadIdx.x == 0) {
        unsigned* bar = b.bar;
        __builtin_amdgcn_s_waitcnt(0);
        unsigned nloc = b.st[0], nx = b.st[1];
        if (nloc == 0u) { xcd_barrier_complete(bar, b.x, nloc, nx); b.st[0] = nloc; b.st[1] = nx; }
        const unsigned old = xb_add(&bar[XB_XSUB(b.x)], 1u);
        const unsigned gen = old / nloc;
        if (old + 1u == (gen + 1u) * nloc) {
            __builtin_amdgcn_fence(__ATOMIC_RELEASE, "agent");
            asm volatile("s_waitcnt vmcnt(0)" ::: "memory");
            const unsigned og = xb_add(&bar[XB_TOP], 1u);
            const unsigned tg = og / nx;
            if (og + 1u == (tg + 1u) * nx) xb_add(&bar[XB_TOPGEN], 1u);
            else XB_SPIN(xb_ld(&bar[XB_TOPGEN]) == tg, bar);
            __builtin_amdgcn_fence(__ATOMIC_ACQUIRE, "agent");
            xb_add(&bar[XB_XGEN(b.x)], 1u);
            asm volatile("s_waitcnt vmcnt(0)" ::: "memory");
        } else {
            XB_SPIN(xb_ld(&bar[XB_XGEN(b.x)]) == gen, bar);
            __builtin_amdgcn_fence(__ATOMIC_ACQUIRE, "agent");
            asm volatile("s_waitcnt vmcnt(0)" ::: "memory");
        }
    }
    __syncthreads();
}


constexpr int NPHASE = 14;
__global__ void __launch_bounds__(512, 2) fwd_mega(Args args) {
    extern __shared__ __attribute__((aligned(16))) unsigned char lds_raw[];
    LAS unsigned char* lds = (LAS unsigned char*)lds_raw;
    cg::grid_group grid = cg::this_grid();
    const int G = gridDim.x, bid = blockIdx.x, NGW = G * 8;
    unsigned char* ws = args.ws;
    const float* x = args.in[0]; const float* ctx = args.in[2];
    const float* norm1_g = args.in[4]; const float* norm2_g = args.in[5];
    const float* conv_w = args.in[9]; const float* rpb = args.in[12]; const float* final_g = args.in[16];
    float* mod = (float*)(ws + WS_MOD);
    bf16_t* SHA = (bf16_t*)(ws + WS_SHA);
    bf16_t* H = (bf16_t*)(ws + WS_H); bf16_t* H2 = (bf16_t*)(ws + WS_H2); float* rss = (float*)(ws + WS_RSS); float* shw = (float*)(ws + WS_SHW);
    bf16_t* Xctx = (bf16_t*)(ws + WS_XCTX);
    bf16_t* Xlat = (bf16_t*)args.out;
    bf16_t* BIG = (bf16_t*)(ws + WS_BIG);
    bf16_t* U = BIG; bf16_t* Bg = BIG + (size_t)MALL * 1024;
    bf16_t* HID = BIG;
    bf16_t* QK = BIG; bf16_t* VT = BIG + (size_t)MALL * 2048;
    bf16_t* Wcin = (bf16_t*)(ws + WS_WCIN); bf16_t* Wcout = (bf16_t*)(ws + WS_WCOUT); bf16_t* Wqkv = (bf16_t*)(ws + WS_WQKV); bf16_t* Wao = (bf16_t*)(ws + WS_WAO);
    bf16_t* W1 = (bf16_t*)(ws + WS_W1); bf16_t* W2 = (bf16_t*)(ws + WS_W2);

#ifndef PROBE_PH
#define PROBE_PH -1
#endif
#ifndef PROBE_PH2
#define PROBE_PH2 -1
#endif
    if (threadIdx.x < 32) ((volatile LAS unsigned*)(lds + MISC_OFF))[threadIdx.x] = 0u;
    __syncthreads();
    const XcdBarrier xbar = xcd_barrier_post((unsigned*)(ws + WS_CTL), (volatile LAS unsigned*)(lds + MISC_OFF) + 8);
    if (args.ph_lo < 0) grid.sync();
    for (int ph = args.ph_lo; ph < args.ph_hi; ++ph) {
      for (int rep = 0; rep < ((ph == PROBE_PH || ph == PROBE_PH2) ? 2 : 1); ++rep) {
        if (rep) xcd_barrier(xbar);
        int tid = threadIdx.x; asm volatile("" : "+v"(tid));
        const int lane = tid & 63, wave = __builtin_amdgcn_readfirstlane(tid >> 6), gw = bid * 8 + wave;
        int kind = 0;
        bool sync_after = true;
        pg8::Gemm g{nullptr, nullptr, 0, 0, 0}; int cidx = bid;
        pg8::EpiU E{}; E.mode = 0; E.O = nullptr; E.O2 = nullptr; E.ldc = 0; E.scale_tiles = 0; E.sc = 1.f; E.rss = nullptr; E.shw = nullptr; E.shw_ld = 0; E.inLat = nullptr; E.inCtx = nullptr; E.inbLat = nullptr; E.inbCtx = nullptr; E.outLat = nullptr; E.outCtx = nullptr; E.gate = nullptr;
        E.An = nullptr; E.gn = nullptr; E.scn = nullptr; E.rssn = nullptr; E.outf5 = nullptr;
        switch (ph) {
        case 0: p0_phase(args, lds, tid, lane, wave, bid, G); break;
        case 1: norm_phase(x, ctx, MALL, norm1_g, mod, 0, 1, H, nullptr, nullptr, gw, NGW, lane);
                for (int i = bid * 512 + tid; i < 3 * 17 * 1024; i += G * 512) { const int jb = i / (17 * 1024), rr = (i / 1024) % 17, k = i & 1023;
                    const float* shp = mod + (jb == 0 ? 3 * 1024 : jb == 1 ? 17 * 6144 : 17 * 6144 + 3 * 1024) + (size_t)rr * 6144;
                    SHA[(size_t)(jb * 256 + rr) * 1024 + k] = (bf16_t)f2bf(shp[k]); }
                break;
        case 2: kind = 1; g = pg8::Gemm{H, Wcin, MALL, 3072, 1024}; E.mode = 2; E.O = U; E.O2 = Bg; break;
        case 3: convgate_phase(U, Bg, conv_w, H, gw, NGW, lane); break;
        case 4: kind = 1; g = pg8::Gemm{H, Wcout, MALL, 1024, 1024}; E.mode = 3; E.inLat = x; E.inCtx = ctx; E.outLat = Xlat; E.outCtx = Xctx; E.gate = mod + 2 * 1024;
                E.An = H2; E.gn = norm2_g; E.scn = mod + 4 * 1024; E.rssn = rss; break;
        case 5: kind = 1; g = pg8::Gemm{H2, W1, MALL, 4096, 1024}; E.mode = 1; E.O = HID; E.ldc = 4096; E.rss = rss; E.shw = shw; E.shw_ld = 4096; break;
        case 6: case 7:
                kind = 1; g = pg8::Gemm{HID, W2, MLAT, 1024, 4096}; E.mode = 3; E.inbLat = Xlat; E.inbCtx = Xctx; E.outLat = Xlat; E.outCtx = Xctx; E.gate = mod + 5 * 1024;
                E.An = H; E.gn = norm1_g + 1024; E.scn = mod + 17 * 6144 + 1 * 1024; E.rssn = rss + MALL; break;
        case 8: kind = 1; break;
        case 9: attn_phase(QK, VT, H2, rpb, lds, tid, lane, wave, bid, G); break;
        case 10: kind = 1; g = pg8::Gemm{H2, Wao, MLAT, 1024, 1024}; E.mode = 3; E.inbLat = Xlat; E.inbCtx = Xctx; E.outLat = Xlat; E.outCtx = Xctx; E.gate = mod + 17 * 6144 + 2 * 1024;
                E.An = H; E.gn = norm2_g + 1024; E.scn = mod + 17 * 6144 + 4 * 1024; E.rssn = rss + 2 * MALL; break;
        case 11: kind = 1; g = pg8::Gemm{H, W1 + (size_t)4096 * 1024, MLAT, 4096, 1024}; E.mode = 1; E.O = HID; E.ldc = 4096; E.rss = rss + 2 * MALL; E.shw = shw + 17 * 4096 + 17 * 3072; E.shw_ld = 4096; break;
        case 12: kind = 1; g = pg8::Gemm{HID, W2 + (size_t)4096 * 1024, MLAT, 1024, 4096}; E.mode = 3; E.inbLat = Xlat; E.inbCtx = Xctx; E.outLat = H2; E.outCtx = Xctx; E.gate = mod + 17 * 6144 + 5 * 1024;
                E.rssn = rss + 3 * MALL; break;
        case 13: final_phase(H2, rss + 3 * MALL, final_g, args.out, gw, NGW, lane); break;
        default: break;
        }
#ifndef NO_GEMM
        if (kind == 1) {
            const int qk_done = (G > 64) ? ((4 * (G - 64) < 1024) ? 4 * (G - 64) : 1024) : 0;
            const int nsub = (ph == 4) ? 4 : (ph == 8) ? 3 : 1;
            for (int sub = 0; sub < nsub; ++sub) {
                int Gs = G, pm0 = 0, lbeg = 0, lend = -1;
                if (ph == 4 && sub > 0) {
                    const int jb = sub - 1;
                    const int N5 = (jb == 1) ? 3072 : 4096;
                    g = pg8::Gemm{SHA + (size_t)jb * 256 * 1024, jb == 0 ? W1 : jb == 1 ? Wqkv : W1 + (size_t)4096 * 1024, 256, N5, 1024};
                    E.mode = 5; E.ldc = N5; E.outf5 = shw + (jb == 0 ? 0 : jb == 1 ? 17 * 4096 : 17 * 4096 + 17 * 3072); E.rss = nullptr; E.shw = nullptr;
                    cidx = (bid + G - ((G > 112) ? 64 + 16 * jb : 0)) % G;
                }
                const bool qk_role = (ph == 7 && G > 64 && bid >= 64) || (ph == 8 && sub < 2);
                if (ph == 7 && !qk_role) { g.M = MCTX; pm0 = MLAT / 256; Gs = (G > 64) ? 64 : G; cidx = bid; }
                if (qk_role) {
                    g = pg8::Gemm{H, Wqkv, MLAT, 2048, 1024}; E.mode = 0; E.O = QK; E.ldc = 2048; E.scale_tiles = 4; E.sc = QSCALE; E.rss = rss + MALL; E.shw = shw + 17 * 4096; E.shw_ld = 3072;
                    E.An = nullptr; E.rssn = nullptr;
                    if (ph == 7) { Gs = G - 64; cidx = bid - 64; lend = qk_done; }
                    else if (sub == 0) { lbeg = qk_done; }
                    else { g.M = MCTX; pm0 = MLAT / 256; cidx = (bid + G - G / 2) % G; }
                }
                if (ph == 8 && sub == 2) { g = pg8::Gemm{Wqkv + (size_t)2048 * 1024, H, 1024, MALL, 1024}; E.mode = 4; E.O = VT; E.ldc = VT_LD; E.rss = rss + MALL; E.shw = shw + 17 * 4096; E.shw_ld = 3072; cidx = bid; }
                pg8::StaticOrder S; S.init(g.M, g.N, Gs, cidx, pm0, lbeg, lend);
                pg8::gemm_phase<pg8::EpiU, pg8::StaticOrder, true, true>(lds, g, S, E);
            }
        } else
#endif
        {}
      }
        if (ph + 1 < args.ph_hi) xcd_barrier(xbar);
    }
}

extern "C" void kernel_launch(void* const* d_in, const int* in_sizes, int n_in, void* d_out, int out_size, void* d_ws, size_t ws_size, hipStream_t stream) {
    static int grid = 0;
    if (grid == 0) {
        if (n_in != 17 || ws_size < WS_END) { fprintf(stderr, "kernel_launch: unexpected n_in %d / ws_size %zu\n", n_in, ws_size); grid = -1; return; }
        int dev = 0, cus = 0, per_cu = 0;
        hipGetDevice(&dev); hipDeviceGetAttribute(&cus, hipDeviceAttributeMultiprocessorCount, dev);
        if (hipFuncSetAttribute((const void*)fwd_mega, hipFuncAttributeMaxDynamicSharedMemorySize, LDS_BYTES) != hipSuccess) { fprintf(stderr, "kernel_launch: hipFuncSetAttribute failed\n"); grid = -1; return; }
        if (hipOccupancyMaxActiveBlocksPerMultiprocessor(&per_cu, (const void*)fwd_mega, 512, LDS_BYTES) != hipSuccess || per_cu < 1) { fprintf(stderr, "kernel_launch: occupancy query says %d\n", per_cu); per_cu = 1; }
        (void)hipGetLastError();
        grid = cus * (per_cu > 1 ? 1 : per_cu);
        if (grid <= 0) grid = 256;
    }
    if (grid < 0) return;
    if (hipMemsetAsync((char*)d_ws + WS_CTL, 0, CTL_BYTES, stream) != hipSuccess) { fprintf(stderr, "kernel_launch: memset failed\n"); return; }
    Args a{};
    for (int i = 0; i < 17; ++i) a.in[i] = (const float*)d_in[i];
    a.out = (float*)d_out; a.ws = (unsigned char*)d_ws;
#if MK_N_LAUNCHES == 1
    a.ph_lo = 0; a.ph_hi = NPHASE;
    void* kargs[] = {&a};
    hipError_t e = hipLaunchCooperativeKernel((const void*)fwd_mega, dim3(grid), dim3(512), kargs, LDS_BYTES, stream);
    if (e != hipSuccess) fprintf(stderr, "kernel_launch: cooperative launch failed: %s (grid %d)\n", hipGetErrorString(e), grid);
#else
    for (int ph = 0; ph < NPHASE; ++ph) {
        a.ph_lo = ph; a.ph_hi = ph + 1;
        hipLaunchKernelGGL(fwd_mega, dim3(grid), dim3(512), LDS_BYTES, stream, a);
    }
#endif
}
```

```cpp
#include <hip/hip_runtime.h>
#include <hip/hip_cooperative_groups.h>
#include <cstdio>
#include <cstdint>
namespace cg = cooperative_groups;

#ifndef MK_N_LAUNCHES
#define MK_N_LAUNCHES 1
#endif

#define LAS __attribute__((address_space(3)))
typedef unsigned short bf16_t;
typedef short bf16x8 __attribute__((ext_vector_type(8)));
typedef float f32x4 __attribute__((ext_vector_type(4)));
typedef unsigned u32x4 __attribute__((ext_vector_type(4)));
typedef unsigned u32x2 __attribute__((ext_vector_type(2)));

constexpr int DM = 1024, NB = 16, SEQ = 2048, CTXL = 256, NH = 16, HD = 64, FF = 4096;
constexpr int MLAT = NB * SEQ;
constexpr int MCTX = NB * CTXL;
constexpr int MALL = MLAT + MCTX;
constexpr float RMS_EPS = 1e-6f;
constexpr float LOG2E = 1.4426950408889634f;
constexpr float QSCALE = 0.125f * LOG2E;

constexpr size_t MiB = 1u << 20;
constexpr size_t WS_SHW = 0;
constexpr size_t WS_MOD = 1 * MiB;
constexpr size_t WS_WCIN = 2 * MiB;
constexpr size_t WS_WCOUT = 8 * MiB;
constexpr size_t WS_WQKV = 10 * MiB;
constexpr size_t WS_WAO = 16 * MiB;
constexpr size_t WS_W1 = 18 * MiB;
constexpr size_t WS_W2 = 34 * MiB;
constexpr size_t WS_H = 50 * MiB;
constexpr size_t WS_XCTX = 122 * MiB;
constexpr size_t WS_BIG = 138 * MiB;
constexpr size_t WS_H2 = 426 * MiB;
constexpr size_t WS_RSS = 498 * MiB;
constexpr size_t WS_CTL = 498 * MiB + 640 * 1024;
constexpr size_t CTL_BYTES = 16384;
constexpr size_t WS_SHA = 500 * MiB;
constexpr size_t WS_END = 502 * MiB;

constexpr int RING_BYTES = 131072;
constexpr int LDS_BYTES = 147456;
constexpr int MISC_OFF = RING_BYTES + 320;

namespace pg8 {
constexpr int BM = 256, BK = 64, HALF = 128, HTB = HALF * BK * 2, STAGE_BYTES = 8 * HTB, NXCD = 8, WGM = 8;
__host__ __device__ __forceinline__ int lds_byte(int r, int c) { const int st = (r >> 4) * 2 + (c >> 5), rr = r & 15, cc = c & 31, ob = rr * 64 + cc * 2; return st * 1024 + (ob ^ (((ob >> 9) & 1) << 5)); }
__host__ __device__ __forceinline__ void stage_rc(int b, int& R, int& C) { const int st = b / 1024, sb = b % 1024, swz = sb ^ (((sb >> 9) & 1) << 5); R = (st >> 1) * 16 + swz / 64; C = (st & 1) * 32 + (swz % 64) / 2; }
__host__ __device__ __forceinline__ int perm32(int rho) { const int n = rho >> 4, i = rho & 15; return 8 * (i >> 2) + 4 * n + (i & 3); }

struct Unit { int pm, pn; };
struct Gemm { const bf16_t* A; const bf16_t* Bt; int M, N, K; };

struct StaticOrder {
    int nM, nN, nwg, G, c, pm0, lbeg, lend;
    __host__ __device__ void init(int M, int N, int G_, int c_, int pm0_ = 0, int lbeg_ = 0, int lend_ = -1) { nM = M / BM; nN = N / BM; nwg = nM * nN; G = G_; c = c_; pm0 = pm0_; lbeg = lbeg_; lend = lend_ < 0 ? nwg : lend_; }
    __host__ __device__ bool next(int i, Unit& u) const {
        const long L = (long)lbeg + (long)i * G + c; if (L >= lend) return false;
        int wgid = (int)L; { const int q = nwg / NXCD, r = nwg % NXCD, xcd = wgid % NXCD, off = wgid / NXCD; wgid = (xcd < r ? xcd * (q + 1) : r * (q + 1) + (xcd - r) * q) + off; }
        const int nig = WGM * nN, gid = wgid / nig, fm = gid * WGM, gsz = (nM - fm) < WGM ? (nM - fm) : WGM;
        u.pm = pm0 + fm + ((wgid % nig) % gsz); u.pn = (wgid % nig) / gsz; return true;
    }
};

__device__ __forceinline__ unsigned cvt_pk_bf16(float lo, float hi) { unsigned r; asm volatile("v_cvt_pk_bf16_f32 %0, %1, %2" : "=v"(r) : "v"(lo), "v"(hi)); return r; }

__device__ __forceinline__ float xsum16(float x) {
    auto r = __builtin_amdgcn_permlane16_swap(__float_as_uint(x), __float_as_uint(x), false, false);
    x = __uint_as_float(r[0]) + __uint_as_float(r[1]);
    auto q = __builtin_amdgcn_permlane32_swap(__float_as_uint(x), __float_as_uint(x), false, false);
    return __uint_as_float(q[0]) + __uint_as_float(q[1]);
}
struct EpiU {
    int mode;
    bf16_t* O; bf16_t* O2; int ldc; int scale_tiles; float sc;
    const float* rss; const float* shw; int shw_ld;
    const float* inLat; const float* inCtx; const bf16_t* inbLat; const bf16_t* inbCtx; bf16_t* outLat; bf16_t* outCtx; const float* gate;
    float* outf5;
    bf16_t* An; const float* gn; const float* scn; float* rssn;
    __device__ __forceinline__ bool has_aux() const { return (mode <= 1 || mode == 4) && rss != nullptr; }
    __device__ __forceinline__ const float* aux_src(const Unit& u, int wid, int lane) const {
        const int i = (wid & 3) * 64 + lane;
        if (mode == 4) { const float* shp = shw + (size_t)(u.pn < (MLAT / BM) ? (u.pn >> 3) : 16) * shw_ld + 2048; return wid < 4 ? shp + u.pm * BM + i : rss + u.pn * BM + i; }
        return wid < 4 ? rss + u.pm * BM + i : shw + (size_t)(u.pm < (MLAT / BM) ? (u.pm >> 3) : 16) * shw_ld + u.pn * BM + i;
    }
    __device__ __forceinline__ void operator()(const f32x4 (&acc)[2][2][4][2], const Unit& u, int wr, int wc, int fr, int fq, const LAS float* aux) const {
        const int row0 = u.pm * BM + wr * 64 + fr;
        if (mode == 5) {
            if (wr == 0) {
#pragma unroll
                for (int m = 0; m < 2; ++m) { const int row = m * 16 + fr;
                    if (row < 17) {
#pragma unroll
                        for (int bj = 0; bj < 2; ++bj)
#pragma unroll
                            for (int n = 0; n < 2; ++n) *(f32x4*)(outf5 + (size_t)row * ldc + u.pn * BM + bj * HALF + wc * 32 + 8 * fq + 4 * n) = acc[0][bj][m][n]; } }
            }
            return;
        }
        if (mode <= 1) {
            const float s = (u.pn < scale_tiles) ? sc : 1.f;
            const int col0 = u.pn * BM + wc * 32 + 8 * fq;
            f32x4 bv[2][2];
#pragma unroll
            for (int bj = 0; bj < 2; ++bj)
#pragma unroll
                for (int n = 0; n < 2; ++n) bv[bj][n] = rss ? *(const LAS f32x4*)(aux + 256 + wc * 32 + 8 * fq + bj * HALF + 4 * n) * s : (f32x4){0.f, 0.f, 0.f, 0.f};
#pragma unroll
            for (int ai = 0; ai < 2; ++ai)
#pragma unroll
                for (int m = 0; m < 4; ++m) { const int row = row0 + ai * HALF + m * 16; bf16_t* rowp = O + (size_t)row * ldc + col0;
                    const float rinv = (rss ? __builtin_amdgcn_rsqf(aux[wr * 64 + fr + ai * HALF + m * 16] * (1.f / DM) + RMS_EPS) : 1.f) * s;
#pragma unroll
                    for (int bj = 0; bj < 2; ++bj) { f32x4 v0 = acc[ai][bj][m][0] * rinv + bv[bj][0], v1 = acc[ai][bj][m][1] * rinv + bv[bj][1];
                        if (mode == 1) { v0 = __builtin_elementwise_max(v0, (f32x4){0.f, 0.f, 0.f, 0.f}); v1 = __builtin_elementwise_max(v1, (f32x4){0.f, 0.f, 0.f, 0.f}); v0 = v0 * v0; v1 = v1 * v1; }
                        u32x4 w; w.x = cvt_pk_bf16(v0[0], v0[1]); w.y = cvt_pk_bf16(v0[2], v0[3]); w.z = cvt_pk_bf16(v1[0], v1[1]); w.w = cvt_pk_bf16(v1[2], v1[3]);
                        *(u32x4*)(rowp + bj * HALF) = w; } }
        } else if (mode == 4) {
            const int col0 = u.pn * BM + wc * 32 + 8 * fq;
            f32x4 cinv[2][2];
#pragma unroll
            for (int bj = 0; bj < 2; ++bj)
#pragma unroll
                for (int n = 0; n < 2; ++n) { const f32x4 q = *(const LAS f32x4*)(aux + 256 + wc * 32 + 8 * fq + bj * HALF + 4 * n);
#pragma unroll
                    for (int e = 0; e < 4; ++e) cinv[bj][n][e] = __builtin_amdgcn_rsqf(q[e] * (1.f / DM) + RMS_EPS); }
#pragma unroll
            for (int ai = 0; ai < 2; ++ai)
#pragma unroll
                for (int m = 0; m < 4; ++m) { const int row = row0 + ai * HALF + m * 16; bf16_t* rowp = O + (size_t)row * ldc + col0; const float bias = aux[wr * 64 + fr + ai * HALF + m * 16];
#pragma unroll
                    for (int bj = 0; bj < 2; ++bj) { const f32x4 v0 = acc[ai][bj][m][0] * cinv[bj][0] + bias, v1 = acc[ai][bj][m][1] * cinv[bj][1] + bias;
                        u32x4 w; w.x = cvt_pk_bf16(v0[0], v0[1]); w.y = cvt_pk_bf16(v0[2], v0[3]); w.z = cvt_pk_bf16(v1[0], v1[1]); w.w = cvt_pk_bf16(v1[2], v1[3]);
                        *(u32x4*)(rowp + bj * HALF) = w; } }
        } else if (mode == 2) {
            if (u.pn < 8) {
                const int col0 = u.pn * HALF + wc * 32 + 8 * fq;
#pragma unroll
                for (int ai = 0; ai < 2; ++ai)
#pragma unroll
                    for (int m = 0; m < 4; ++m) { bf16_t* rowp = O + (size_t)(row0 + ai * HALF + m * 16) * 1024 + col0;
                        const f32x4 v0 = acc[ai][0][m][0] * acc[ai][1][m][0], v1 = acc[ai][0][m][1] * acc[ai][1][m][1];
                        u32x4 w; w.x = cvt_pk_bf16(v0[0], v0[1]); w.y = cvt_pk_bf16(v0[2], v0[3]); w.z = cvt_pk_bf16(v1[0], v1[1]); w.w = cvt_pk_bf16(v1[2], v1[3]);
                        *(u32x4*)rowp = w; }
            } else {
                const int col0 = (u.pn - 8) * BM + wc * 32 + 8 * fq;
#pragma unroll
                for (int ai = 0; ai < 2; ++ai)
#pragma unroll
                    for (int m = 0; m < 4; ++m) { bf16_t* rowp = O2 + (size_t)(row0 + ai * HALF + m * 16) * 1024 + col0;
#pragma unroll
                        for (int bj = 0; bj < 2; ++bj) { const f32x4 v0 = acc[ai][bj][m][0], v1 = acc[ai][bj][m][1];
                            u32x4 w; w.x = cvt_pk_bf16(v0[0], v0[1]); w.y = cvt_pk_bf16(v0[2], v0[3]); w.z = cvt_pk_bf16(v1[0], v1[1]); w.w = cvt_pk_bf16(v1[2], v1[3]);
                            *(u32x4*)(rowp + bj * HALF) = w; } }
            }
        } else {
            const bool lat = u.pm < (MLAT / BM);
            const int prow = (lat ? u.pm : u.pm - MLAT / BM) * BM + wr * 64 + fr;
            const float* in = lat ? inLat : inCtx; const bf16_t* inb = lat ? inbLat : inbCtx; bf16_t* out = lat ? outLat : outCtx;
            const int brow = lat ? (u.pm >> 3) : 16;
            const float* gp = gate + (size_t)brow * 6144;
            const int col0 = u.pn * BM + wc * 32 + 8 * fq;
            f32x4 gv[2][2], gm[2][2];
#pragma unroll
            for (int bj = 0; bj < 2; ++bj)
#pragma unroll
                for (int n = 0; n < 2; ++n) { gv[bj][n] = *(const f32x4*)(gp + col0 + bj * HALF + 4 * n);
                    gm[bj][n] = An ? *(const f32x4*)(gn + col0 + bj * HALF + 4 * n) * (*(const f32x4*)(scn + (size_t)brow * 6144 + col0 + bj * HALF + 4 * n) + 1.0f) : (f32x4){0.f, 0.f, 0.f, 0.f}; }
#pragma unroll
            for (int ai = 0; ai < 2; ++ai)
#pragma unroll
                for (int m = 0; m < 4; ++m) { const size_t off = (size_t)(prow + ai * HALF + m * 16) * 1024 + col0; float ss = 0.f;
#pragma unroll
                    for (int bj = 0; bj < 2; ++bj) { f32x4 xo[2];
                        if (in) { xo[0] = *(const f32x4*)(in + off + bj * HALF); xo[1] = *(const f32x4*)(in + off + bj * HALF + 4); }
                        else { const u32x4 xw = *(const u32x4*)(inb + off + bj * HALF);
                            xo[0] = (f32x4){__builtin_bit_cast(float, xw.x << 16), __builtin_bit_cast(float, xw.x & 0xffff0000u), __builtin_bit_cast(float, xw.y << 16), __builtin_bit_cast(float, xw.y & 0xffff0000u)};
                            xo[1] = (f32x4){__builtin_bit_cast(float, xw.z << 16), __builtin_bit_cast(float, xw.z & 0xffff0000u), __builtin_bit_cast(float, xw.w << 16), __builtin_bit_cast(float, xw.w & 0xffff0000u)}; }
#pragma unroll
                        for (int n = 0; n < 2; ++n) { xo[n] = xo[n] + gv[bj][n] * acc[ai][bj][m][n];
                            ss += (xo[n][0] * xo[n][0] + xo[n][1] * xo[n][1]) + (xo[n][2] * xo[n][2] + xo[n][3] * xo[n][3]); }
                        { u32x4 w; w.x = cvt_pk_bf16(xo[0][0], xo[0][1]); w.y = cvt_pk_bf16(xo[0][2], xo[0][3]); w.z = cvt_pk_bf16(xo[1][0], xo[1][1]); w.w = cvt_pk_bf16(xo[1][2], xo[1][3]);
                          *(u32x4*)(out + off + bj * HALF) = w; }
                        if (An) { const f32x4 a0 = xo[0] * gm[bj][0], a1 = xo[1] * gm[bj][1];
                            u32x4 w; w.x = cvt_pk_bf16(a0[0], a0[1]); w.y = cvt_pk_bf16(a0[2], a0[3]); w.z = cvt_pk_bf16(a1[0], a1[1]); w.w = cvt_pk_bf16(a1[2], a1[3]);
                            *(u32x4*)(An + (size_t)(row0 + ai * HALF + m * 16) * 1024 + col0 + bj * HALF) = w; } }
                    if (rssn) { ss = xsum16(ss); if (fq == 0) atomicAdd(rssn + row0 + ai * HALF + m * 16, ss); }
                    if (m == 3) asm volatile("" ::: "memory"); }
        }
    }
};

template <class Epi, class Sched, bool ALIGN_EPI = false, bool SP2 = false>
__device__ __forceinline__ void gemm_phase(LAS unsigned char* lds, const Gemm g, const Sched& S, const Epi& E) {
    int tid = threadIdx.x; asm volatile("" : "+v"(tid));
    const int wid = __builtin_amdgcn_readfirstlane(tid >> 6), lane = tid & 63, wr = wid >> 2, wc = wid & 3, fr = lane & 15, fq = lane >> 4;
    const int K = g.K, nt = K / BK;
    unsigned voffA[2], voffB[2];
#pragma unroll
    for (int i = 0; i < 2; ++i) { int R, C; stage_rc(tid * 16 + i * 8192, R, C); const int Rb = (R & ~31) + perm32(R & 31);
        voffA[i] = (unsigned)(R * K + C) * 2u; voffB[i] = (unsigned)(Rb * K + C) * 2u; }
    const size_t kstep = (size_t)(BK * 2);
    const size_t hstep = (size_t)HALF * K * 2;
    const size_t tstep = 2 * hstep;
    const unsigned ldsw = (unsigned)wid * 1024u;
    const int aoff = lds_byte(wr * 64 + fr, fq * 8), boff = lds_byte(wc * 32 + fr, fq * 8);
#define PG8_SA(b, h) (((b) * 2 + (h)) * HTB)
#define PG8_SB(b, h) ((4 + (b) * 2 + (h)) * HTB)
#define PG8_STAGE(bufoff, gbase, voff) do { _Pragma("unroll") for (int _i = 0; _i < 2; ++_i) \
        __builtin_amdgcn_global_load_lds((const unsigned*)((const char*)(gbase) + (voff)[_i]), (LAS unsigned*)(lds + (bufoff) + ldsw + _i * 8192), 16, 0, 0); } while (0)
#define PG8_LDA(dst, b, h) do { _Pragma("unroll") for (int m = 0; m < 4; ++m) _Pragma("unroll") for (int k = 0; k < 2; ++k) dst[m][k] = *(const LAS bf16x8*)(lds + PG8_SA(b, h) + aoff + m * 2048 + k * 1024); } while (0)
#define PG8_LDB(dst, b, h) do { _Pragma("unroll") for (int n = 0; n < 2; ++n) _Pragma("unroll") for (int k = 0; k < 2; ++k) dst[n][k] = *(const LAS bf16x8*)(lds + PG8_SB(b, h) + boff + n * 2048 + k * 1024); } while (0)
#define PG8_MMA(ai, bj, At, Bt) do { __builtin_amdgcn_s_setprio(1); _Pragma("unroll") for (int m = 0; m < 4; ++m) _Pragma("unroll") for (int n = 0; n < 2; ++n) _Pragma("unroll") for (int k = 0; k < 2; ++k) \
        acc[ai][bj][m][n] = __builtin_amdgcn_mfma_f32_16x16x32_bf16(Bt[n][k], At[m][k], acc[ai][bj][m][n], 0, 0, 0); __builtin_amdgcn_s_setprio(0); } while (0)
#define PG8_WAIT_V(n) asm volatile("s_waitcnt vmcnt(" #n ")" ::: "memory")
#define PG8_WAIT_L(n) asm volatile("s_waitcnt lgkmcnt(" #n ")" ::: "memory")
#define PG8_BAR __builtin_amdgcn_s_barrier()
#define PG8_SCHED __builtin_amdgcn_sched_barrier(0)
    Unit cur, nxt; int ui = 0;
    if (!S.next(0, cur)) return;
    constexpr int AUX_OFF = STAGE_BYTES + 1024;
    const bool use_aux = E.has_aux();
    if (use_aux) __builtin_amdgcn_global_load_lds((const unsigned*)E.aux_src(cur, wid, lane), (LAS unsigned*)(lds + AUX_OFF + wid * 256), 4, 0, 0);
    f32x4 acc[2][2][4][2];
#pragma unroll
    for (int a = 0; a < 2; ++a)
#pragma unroll
        for (int b = 0; b < 2; ++b)
#pragma unroll
            for (int m = 0; m < 4; ++m)
#pragma unroll
                for (int n = 0; n < 2; ++n) acc[a][b][m][n] = (f32x4){0.f, 0.f, 0.f, 0.f};
    bf16x8 At[4][2], B0[2][2], B1[2][2];
    const char* cA = (const char*)g.A + (size_t)cur.pm * tstep; const char* cB = (const char*)g.Bt + (size_t)cur.pn * tstep;
    if constexpr (SP2) {
        PG8_STAGE(PG8_SB(0, 0), cB, voffB); PG8_STAGE(PG8_SB(0, 1), cB + hstep, voffB); PG8_STAGE(PG8_SA(0, 0), cA, voffA); PG8_STAGE(PG8_SA(0, 1), cA + hstep, voffA);
        if (wr == 1) PG8_BAR;
        PG8_WAIT_V(2); PG8_BAR;
        PG8_STAGE(PG8_SB(1, 0), cB + kstep, voffB); PG8_STAGE(PG8_SA(1, 0), cA + kstep, voffA); PG8_STAGE(PG8_SB(1, 1), cB + hstep + kstep, voffB);
        PG8_WAIT_V(6); PG8_BAR;
    } else {
        PG8_STAGE(PG8_SB(0, 0), cB, voffB); PG8_STAGE(PG8_SA(0, 0), cA, voffA); PG8_STAGE(PG8_SB(0, 1), cB + hstep, voffB); PG8_STAGE(PG8_SA(0, 1), cA + hstep, voffA);
        if (wr == 1) PG8_BAR;
        PG8_WAIT_V(4); PG8_BAR;
        PG8_STAGE(PG8_SB(1, 0), cB + kstep, voffB); PG8_STAGE(PG8_SA(1, 0), cA + kstep, voffA); PG8_STAGE(PG8_SB(1, 1), cB + hstep + kstep, voffB);
        PG8_WAIT_V(6); PG8_BAR;
    }
    for (;;) {
        const bool has_next = S.next(ui + 1, nxt);
        const char* nA = has_next ? (const char*)g.A + (size_t)nxt.pm * tstep : cA; const char* nB = has_next ? (const char*)g.Bt + (size_t)nxt.pn * tstep : cB;
        for (int t = 0; t < nt; t += 2) {
            const bool last = (t == nt - 2);
            const char* a1 = cA + (size_t)(t + 1) * kstep;
            const char* a2 = last ? nA : cA + (size_t)(t + 2) * kstep; const char* b2 = last ? nB : cB + (size_t)(t + 2) * kstep;
            const char* a3 = a2 + kstep; const char* b3 = b2 + kstep;
            if constexpr (SP2) {
            PG8_LDB(B0, 0, 0); PG8_LDB(B1, 0, 1); PG8_SCHED; PG8_LDA(At, 0, 0); PG8_STAGE(PG8_SA(1, 1), a1 + hstep, voffA);
            PG8_WAIT_V(8); PG8_WAIT_L(0); PG8_BAR; PG8_MMA(0, 0, At, B0); PG8_MMA(0, 1, At, B1); PG8_BAR; PG8_SCHED;
            PG8_LDA(At, 0, 1); PG8_STAGE(PG8_SB(0, 0), b2, voffB); PG8_STAGE(PG8_SB(0, 1), b2 + hstep, voffB); PG8_STAGE(PG8_SA(0, 0), a2, voffA);
            PG8_WAIT_V(8); PG8_WAIT_L(0); PG8_BAR; PG8_MMA(1, 0, At, B0); PG8_MMA(1, 1, At, B1); PG8_BAR; PG8_SCHED;
            PG8_LDB(B0, 1, 0); PG8_LDB(B1, 1, 1); PG8_SCHED; PG8_LDA(At, 1, 0); PG8_STAGE(PG8_SA(0, 1), a2 + hstep, voffA);
            PG8_WAIT_V(8); PG8_WAIT_L(0); PG8_BAR; PG8_MMA(0, 0, At, B0); PG8_MMA(0, 1, At, B1); PG8_BAR; PG8_SCHED;
            PG8_LDA(At, 1, 1); PG8_STAGE(PG8_SB(1, 0), b3, voffB); PG8_STAGE(PG8_SB(1, 1), b3 + hstep, voffB); PG8_STAGE(PG8_SA(1, 0), a3, voffA);
            PG8_WAIT_V(8); PG8_WAIT_L(0); PG8_BAR; PG8_MMA(1, 0, At, B0); PG8_MMA(1, 1, At, B1); PG8_BAR; PG8_SCHED;
            } else {
            PG8_LDB(B0, 0, 0); PG8_SCHED; PG8_LDA(At, 0, 0); PG8_STAGE(PG8_SA(1, 1), a1 + hstep, voffA);
            PG8_WAIT_L(8); PG8_BAR; PG8_WAIT_L(0); PG8_MMA(0, 0, At, B0); PG8_BAR; PG8_SCHED;
            PG8_LDB(B1, 0, 1); PG8_STAGE(PG8_SB(0, 0), b2, voffB);
            PG8_BAR; PG8_WAIT_L(0); PG8_MMA(0, 1, At, B1); PG8_BAR;
            PG8_LDA(At, 0, 1); PG8_STAGE(PG8_SA(0, 0), a2, voffA);
            PG8_BAR; PG8_WAIT_L(0); PG8_MMA(1, 0, At, B0); PG8_BAR; PG8_SCHED;
            PG8_STAGE(PG8_SB(0, 1), b2 + hstep, voffB);
            PG8_WAIT_V(6); PG8_BAR; PG8_MMA(1, 1, At, B1); PG8_BAR;
            PG8_LDB(B0, 1, 0); PG8_SCHED; PG8_LDA(At, 1, 0); PG8_STAGE(PG8_SA(0, 1), a2 + hstep, voffA);
            PG8_WAIT_L(8); PG8_BAR; PG8_WAIT_L(0); PG8_MMA(0, 0, At, B0); PG8_BAR; PG8_SCHED;
            PG8_LDB(B1, 1, 1); PG8_STAGE(PG8_SB(1, 0), b3, voffB);
            PG8_BAR; PG8_WAIT_L(0); PG8_MMA(0, 1, At, B1); PG8_BAR;
            PG8_LDA(At, 1, 1); PG8_STAGE(PG8_SA(1, 0), a3, voffA);
            PG8_BAR; PG8_WAIT_L(0); PG8_MMA(1, 0, At, B0); PG8_BAR; PG8_SCHED;
            PG8_STAGE(PG8_SB(1, 1), b3 + hstep, voffB);
            PG8_WAIT_V(6); PG8_BAR; PG8_MMA(1, 1, At, B1); PG8_BAR;
            }
        }
        if constexpr (ALIGN_EPI) { if (wr == 0) PG8_BAR; }
        E(acc, cur, wr, wc, fr, fq, (const LAS float*)(lds + AUX_OFF + (ui & 1) * 2048));
        if (use_aux && has_next) __builtin_amdgcn_global_load_lds((const unsigned*)E.aux_src(nxt, wid, lane), (LAS unsigned*)(lds + AUX_OFF + ((ui + 1) & 1) * 2048 + wid * 256), 4, 0, 0);
        if (!has_next) break;
#pragma unroll
        for (int a = 0; a < 2; ++a)
#pragma unroll
            for (int b = 0; b < 2; ++b)
#pragma unroll
                for (int m = 0; m < 4; ++m)
#pragma unroll
                    for (int n = 0; n < 2; ++n) acc[a][b][m][n] = (f32x4){0.f, 0.f, 0.f, 0.f};
        cur = nxt; cA = nA; cB = nB; ++ui;
        if constexpr (ALIGN_EPI) { if (wr == 1) PG8_BAR; }
    }
    PG8_WAIT_V(0);
    if constexpr (!ALIGN_EPI) { if (wr == 0) PG8_BAR; }
    PG8_BAR;
#undef PG8_SA
#undef PG8_SB
#undef PG8_STAGE
#undef PG8_LDA
#undef PG8_LDB
#undef PG8_MMA
#undef PG8_WAIT_V
#undef PG8_WAIT_L
#undef PG8_BAR
#undef PG8_SCHED
}
}

__device__ __forceinline__ unsigned f2bf(float f) { unsigned u = __builtin_bit_cast(unsigned, f); return (u + 0x7fffu + ((u >> 16) & 1u)) >> 16; }
__device__ __forceinline__ unsigned pk2(float lo, float hi) { return pg8::cvt_pk_bf16(lo, hi); }
__device__ __forceinline__ float bf_lo(unsigned w) { return __builtin_bit_cast(float, w << 16); }
__device__ __forceinline__ float bf_hi(unsigned w) { return __builtin_bit_cast(float, w & 0xffff0000u); }
__device__ __forceinline__ float wave_sum(float v) {
#pragma unroll
    for (int o = 1; o < 64; o <<= 1) v += __shfl_xor(v, o);
    return v;
}
#define LDS_WAIT() asm volatile("s_waitcnt lgkmcnt(0)" ::: "memory")

struct Args {
    const float* in[17];
    float* out; unsigned char* ws;
    int ph_lo, ph_hi;
};

__device__ __forceinline__ void transpose_item(const float* W, int K, int N, bf16_t* WT, int cinmap, LAS float* scr, int item, int lane) {
    const int nblk = N / 32, kb = item / nblk, nb = item % nblk, k0 = 64 * kb, n0 = 32 * nb;
    float wv[32];
#pragma unroll
    for (int i = 0; i < 32; ++i) { const int kk = 2 * i + (lane >> 5); wv[i] = W[(size_t)(k0 + kk) * N + n0 + (lane & 31)]; }
#pragma unroll
    for (int i = 0; i < 32; ++i) { const int kk = 2 * i + (lane >> 5); scr[kk * 33 + (lane & 31)] = wv[i]; }
    LDS_WAIT(); asm volatile("" ::: "memory");
    int d0 = n0;
    if (cinmap) { if (n0 < 1024) d0 = 2048 + n0; else if (n0 < 2048) { const int ch = n0 - 1024; d0 = (ch >> 7) * 256 + (ch & 127); } else { const int ch = n0 - 2048; d0 = (ch >> 7) * 256 + 128 + (ch & 127); } }
    const int c = lane & 7;
#pragma unroll
    for (int j = 0; j < 4; ++j) { const int n = (lane >> 3) + 8 * j; const LAS float* s = scr + (8 * c) * 33 + n;
        u32x4 o; o.x = pk2(s[0 * 33], s[1 * 33]); o.y = pk2(s[2 * 33], s[3 * 33]); o.z = pk2(s[4 * 33], s[5 * 33]); o.w = pk2(s[6 * 33], s[7 * 33]);
        *(u32x4*)(WT + (size_t)(d0 + n) * K + k0 + 8 * c) = o; }
    LDS_WAIT(); asm volatile("" ::: "memory");
}

__device__ __forceinline__ void gemv17_unit(const LAS float* S, LAS float* red, const float* W, int ldw, int n0, const float* bias, float* out, int ldo, int tid, int lane, int wave) {
    const float* Wp = W + n0 + (lane & 31);
    const int kbase = wave * 128 + (lane >> 5);
    float acc[17];
#pragma unroll
    for (int r = 0; r < 17; ++r) acc[r] = 0.f;
#pragma unroll 1
    for (int ib = 0; ib < 64; ib += 32) {
        float wv[32];
#pragma unroll
        for (int i = 0; i < 32; ++i) wv[i] = Wp[(size_t)(kbase + 2 * (ib + i)) * ldw];
#pragma unroll
        for (int i = 0; i < 32; ++i) { const int k = kbase + 2 * (ib + i);
#pragma unroll
            for (int r = 0; r < 17; ++r) acc[r] += S[r * 1024 + k] * wv[i]; }
    }
#pragma unroll
    for (int r = 0; r < 17; ++r) acc[r] += __shfl_xor(acc[r], 32);
    if (lane < 32) {
#pragma unroll
        for (int r = 0; r < 17; ++r) red[(wave * 17 + r) * 32 + lane] = acc[r]; }
    __syncthreads();
    for (int o = tid; o < 17 * 32; o += 512) { const int r = o >> 5, c2 = o & 31; float s = bias ? bias[n0 + c2] : 0.f;
#pragma unroll
        for (int w = 0; w < 8; ++w) s += red[(w * 17 + r) * 32 + c2];
        out[(size_t)r * ldo + n0 + c2] = s; }
    __syncthreads();
}

__device__ __forceinline__ void p0_phase(const Args& a, LAS unsigned char* lds, int tid, int lane, int wave, int bid, int G) {
    { float* rss = (float*)(a.ws + WS_RSS); for (int i = bid * 512 + tid; i < 4 * MALL; i += G * 512) rss[i] = 0.f; }
    {
        LAS float* S = (LAS float*)lds;
        LAS float* red = (LAS float*)(lds + 17 * 1024 * 4);
        const float* c = a.in[1]; const float* cc = a.in[3]; const float* ada_w = a.in[6]; const float* ada_b = a.in[7];
        float* mod = (float*)(a.ws + WS_MOD);
        for (int i = tid; i < 17 * 1024; i += 512) { const float v = i < 16384 ? c[i] : cc[i - 16384]; S[i] = v / (1.f + __expf(-v)); }
        __syncthreads();
        for (int unit = bid; unit < 384; unit += G) {
            const int l = unit / 192, n0 = (unit % 192) * 32;
            gemv17_unit(S, red, ada_w + (size_t)l * 1024 * 6144, 6144, n0, ada_b + l * 6144, mod + (size_t)l * 17 * 6144, 6144, tid, lane, wave);
        }
    }
    {
        LAS float* scr = (LAS float*)(lds + wave * 16384);
        const int gw = bid * 8 + wave, NGW = G * 8;
        constexpr int I_CIN = 16 * 96, I_SQ = 16 * 32, I_UP = 16 * 128, I_DN = 64 * 32;
        constexpr int NITEMS = 2 * I_CIN + 2 * I_SQ + 2 * I_UP + 2 * I_DN;
        bf16_t* ws16 = (bf16_t*)a.ws;
        for (int it = gw; it < NITEMS; it += NGW) {
            int r = it;
            if (r < I_CIN) { transpose_item(a.in[8], 1024, 3072, (bf16_t*)(a.ws + WS_WCIN), 1, scr, r, lane); continue; } r -= I_CIN;
            if (r < I_CIN) { transpose_item(a.in[11], 1024, 3072, (bf16_t*)(a.ws + WS_WQKV), 0, scr, r, lane); continue; } r -= I_CIN;
            if (r < I_SQ) { transpose_item(a.in[10], 1024, 1024, (bf16_t*)(a.ws + WS_WCOUT), 0, scr, r, lane); continue; } r -= I_SQ;
            if (r < I_SQ) { transpose_item(a.in[13], 1024, 1024, (bf16_t*)(a.ws + WS_WAO), 0, scr, r, lane); continue; } r -= I_SQ;
            if (r < 2 * I_UP) { const int l = r / I_UP; transpose_item(a.in[14] + (size_t)l * 1024 * 4096, 1024, 4096, (bf16_t*)(a.ws + WS_W1) + (size_t)l * 4096 * 1024, 0, scr, r % I_UP, lane); continue; } r -= 2 * I_UP;
            { const int l = r / I_DN; transpose_item(a.in[15] + (size_t)l * 4096 * 1024, 4096, 1024, (bf16_t*)(a.ws + WS_W2) + (size_t)l * 1024 * 4096, 0, scr, r % I_DN, lane); }
        }
        (void)ws16;
    }
}

__device__ __forceinline__ void shw_jobs(const Args& a, LAS unsigned char* lds, int tid, int lane, int wave, int bid, int G) {
    LAS float* S = (LAS float*)lds; LAS float* red = (LAS float*)(lds + 17 * 1024 * 4);
    const float* mod = (const float*)(a.ws + WS_MOD); float* shw = (float*)(a.ws + WS_SHW);
    __syncthreads();
#pragma unroll 1
    for (int job = 0; job < 3; ++job) {
        const int N = (job == 1) ? 3072 : 4096, nunits = N / 32, off = (job == 0) ? 0 : (job == 1) ? 128 : 224;
        const float* W = (job == 0) ? a.in[14] : (job == 1) ? a.in[11] : a.in[14] + (size_t)1024 * 4096;
        const float* sh = mod + (job == 0 ? 3 * 1024 : job == 1 ? 17 * 6144 : 17 * 6144 + 3 * 1024);
        float* out = shw + (job == 0 ? 0 : job == 1 ? 17 * 4096 : 17 * 4096 + 17 * 3072);
        int unit = bid - off; if (unit < 0) unit += G;
        if (unit < nunits) {
            for (int i = tid; i < 17 * 1024; i += 512) S[i] = sh[(size_t)(i >> 10) * 6144 + (i & 1023)];
            __syncthreads();
            for (; unit < nunits; unit += G) gemv17_unit(S, red, W, N, unit * 32, nullptr, out, N, tid, lane, wave);
        }
    }
}

__device__ __forceinline__ void norm_phase(const float* xlat, const float* xctx, int nrows, const float* g, const float* modl, int sh_chunk, int sc_chunk,
                                           bf16_t* H, float* outf, const float* rssf, int gw, int NGW, int lane) {
    constexpr int R = 4;
    const int ngroups = nrows / R;
    for (int grp = gw; grp < ngroups; grp += NGW) {
        f32x4 v[R][4]; float inv[R];
#pragma unroll
        for (int q = 0; q < R; ++q) { const int row = grp * R + q; const bool lat = row < MLAT;
            const f32x4* xr = (const f32x4*)(lat ? xlat + (size_t)row * DM : xctx + (size_t)(row - MLAT) * DM) + lane;
#pragma unroll
            for (int jx = 0; jx < 4; ++jx) v[q][jx] = xr[64 * jx]; }
        if (rssf) {
#pragma unroll
            for (int q = 0; q < R; ++q) inv[q] = rsqrtf(rssf[grp * R + q] * (1.f / DM) + RMS_EPS);
        } else {
            float s[R];
#pragma unroll
            for (int q = 0; q < R; ++q) { s[q] = 0.f;
#pragma unroll
                for (int jx = 0; jx < 4; ++jx) s[q] += (v[q][jx].x * v[q][jx].x + v[q][jx].y * v[q][jx].y) + (v[q][jx].z * v[q][jx].z + v[q][jx].w * v[q][jx].w); }
#pragma unroll
            for (int o = 1; o < 64; o <<= 1) {
#pragma unroll
                for (int q = 0; q < R; ++q) s[q] += __shfl_xor(s[q], o); }
#pragma unroll
            for (int q = 0; q < R; ++q) inv[q] = rsqrtf(s[q] * (1.f / DM) + RMS_EPS);
        }
#pragma unroll
        for (int q = 0; q < R; ++q) { const int row = grp * R + q; const bool lat = row < MLAT;
            if (modl) {
                const float* mr = modl + (size_t)(lat ? (row >> 11) : 16) * 6144;
                unsigned long long* o8 = (unsigned long long*)(H + (size_t)row * DM) + lane;
#pragma unroll
                for (int jx = 0; jx < 4; ++jx) { const int c = 4 * lane + 256 * jx;
                    const f32x4 gg = *(const f32x4*)(g + c), sc = *(const f32x4*)(mr + sc_chunk * 1024 + c), sh = *(const f32x4*)(mr + sh_chunk * 1024 + c);
                    const f32x4 o = (v[q][jx] * inv[q] * gg) * (sc + 1.0f) + sh;
                    o8[64 * jx] = (unsigned long long)pk2(o.x, o.y) | ((unsigned long long)pk2(o.z, o.w) << 32); }
            } else {
                f32x4* orow = (f32x4*)(outf + (size_t)row * DM) + lane;
#pragma unroll
                for (int jx = 0; jx < 4; ++jx) { const int c = 4 * lane + 256 * jx; const f32x4 gg = *(const f32x4*)(g + c); orow[64 * jx] = v[q][jx] * inv[q] * gg; }
            }
        }
    }
}

__device__ __forceinline__ void final_phase(const bf16_t* xb, const float* rssf, const float* g, float* out, int gw, int NGW, int lane) {
    constexpr int R = 4;
    for (int grp = gw; grp < MLAT / R; grp += NGW) {
        u32x4 v[R][2];
#pragma unroll
        for (int q = 0; q < R; ++q)
#pragma unroll
            for (int jx = 0; jx < 2; ++jx) v[q][jx] = *(const u32x4*)(xb + (size_t)(grp * R + q) * DM + jx * 512 + lane * 8);
#pragma unroll
        for (int q = 0; q < R; ++q) { const int row = grp * R + q; const float inv = rsqrtf(rssf[row] * (1.f / DM) + RMS_EPS);
#pragma unroll
            for (int jx = 0; jx < 2; ++jx) { const int c = jx * 512 + lane * 8; const f32x4 g0 = *(const f32x4*)(g + c), g1 = *(const f32x4*)(g + c + 4); const u32x4 w = v[q][jx];
                const f32x4 x0 = (f32x4){bf_lo(w.x), bf_hi(w.x), bf_lo(w.y), bf_hi(w.y)}, x1 = (f32x4){bf_lo(w.z), bf_hi(w.z), bf_lo(w.w), bf_hi(w.w)};
                *(f32x4*)(out + (size_t)row * DM + c) = x0 * inv * g0; *(f32x4*)(out + (size_t)row * DM + c + 4) = x1 * inv * g1; } }
    }
}

__device__ __forceinline__ void unpack8(const u32x4 w, float (&f)[8]) { f[0] = bf_lo(w.x); f[1] = bf_hi(w.x); f[2] = bf_lo(w.y); f[3] = bf_hi(w.y); f[4] = bf_lo(w.z); f[5] = bf_hi(w.z); f[6] = bf_lo(w.w); f[7] = bf_hi(w.w); }
__device__ __forceinline__ void unpack4(const u32x2 w, float (&f)[4]) { f[0] = bf_lo(w.x); f[1] = bf_hi(w.x); f[2] = bf_lo(w.y); f[3] = bf_hi(w.y); }
__device__ __forceinline__ void convgate_phase(const bf16_t* U, const bf16_t* Bg, const float* cw, bf16_t* Gout, int gw, int NGW, int lane) {
    constexpr int RC = 8;
    for (int item = gw; item < (MALL / RC) * 4; item += NGW) {
        const int chunk = item >> 2, strip = item & 3, t0 = chunk * RC, ch = strip * 256 + lane * 4;
        const int tl = t0 < MLAT ? (t0 & (SEQ - 1)) : ((t0 - MLAT) & (CTXL - 1)); const int sl = t0 < MLAT ? SEQ : CTXL;
        const bool first = (tl == 0), lastc = (tl + RC == sl);
        const f32x4 w0 = *(const f32x4*)(cw + ch), w1 = *(const f32x4*)(cw + 1024 + ch), w2 = *(const f32x4*)(cw + 2048 + ch);
        const bf16_t* up = U + (size_t)t0 * DM + ch; const bf16_t* bp = Bg + (size_t)t0 * DM + ch; bf16_t* gp = Gout + (size_t)t0 * DM + ch;
        const u32x2 zero = (u32x2){0u, 0u};
        u32x2 uw[RC + 2], bw[RC];
        uw[0] = first ? zero : *(const u32x2*)(up - DM);
#pragma unroll
        for (int t = 0; t < RC; ++t) { uw[t + 1] = *(const u32x2*)(up + (size_t)t * DM); bw[t] = *(const u32x2*)(bp + (size_t)t * DM); }
        uw[RC + 1] = lastc ? zero : *(const u32x2*)(up + (size_t)RC * DM);
#pragma unroll
        for (int t = 0; t < RC; ++t) {
            float pf[4], cf[4], nf[4], bf[4];
            unpack4(uw[t], pf); unpack4(uw[t + 1], cf); unpack4(uw[t + 2], nf); unpack4(bw[t], bf);
            float o[4];
#pragma unroll
            for (int e = 0; e < 4; ++e) o[e] = bf[e] * (w0[e] * pf[e] + w1[e] * cf[e] + w2[e] * nf[e]);
            u32x2 ow; ow.x = pk2(o[0], o[1]); ow.y = pk2(o[2], o[3]);
            *(u32x2*)(gp + (size_t)t * DM) = ow;
        }
    }
}

struct KBuf { bf16x8 k[2][2]; };
struct VBuf { bf16x8 v[4]; };
constexpr int VT_LD = MALL;
struct KVOff { unsigned k0, v0; };
typedef __amdgpu_buffer_rsrc_t rsrc_t;
__device__ __forceinline__ bf16x8 bload(rsrc_t r, unsigned voff, unsigned soff) { return __builtin_bit_cast(bf16x8, __builtin_amdgcn_raw_buffer_load_b128(r, (int)voff, (int)soff, 0)); }
__device__ __forceinline__ void k_load(KBuf& B, rsrc_t rk, const KVOff& f, int kt) {
    const unsigned sk = (unsigned)kt * 4096u;
    B.k[0][0] = bload(rk, f.k0, sk); B.k[0][1] = bload(rk, f.k0 + 64u, sk);
    B.k[1][0] = bload(rk, f.k0, sk + 16384u); B.k[1][1] = bload(rk, f.k0 + 64u, sk + 16384u);
}
__device__ __forceinline__ void v_load(VBuf& B, rsrc_t rv, const KVOff& f, int kt) {
    const unsigned sv = (unsigned)kt * 2u;
#pragma unroll
    for (int d = 0; d < 4; ++d) B.v[d] = bload(rv, f.v0, sv + (unsigned)d * (16u * VT_LD * 2u));
}
__device__ __forceinline__ float red16_max(float x) {
#if __has_builtin(__builtin_amdgcn_permlane16_swap)
    auto r = __builtin_amdgcn_permlane16_swap(__float_as_uint(x), __float_as_uint(x), false, false);
    x = fmaxf(__uint_as_float(r[0]), __uint_as_float(r[1]));
#else
    x = fmaxf(x, __shfl_xor(x, 16));
#endif
    auto q = __builtin_amdgcn_permlane32_swap(__float_as_uint(x), __float_as_uint(x), false, false);
    return fmaxf(__uint_as_float(q[0]), __uint_as_float(q[1]));
}
__device__ __forceinline__ float red16_sum(float x) {
#if __has_builtin(__builtin_amdgcn_permlane16_swap)
    auto r = __builtin_amdgcn_permlane16_swap(__float_as_uint(x), __float_as_uint(x), false, false);
    x = __uint_as_float(r[0]) + __uint_as_float(r[1]);
#else
    x = x + __shfl_xor(x, 16);
#endif
    auto q = __builtin_amdgcn_permlane32_swap(__float_as_uint(x), __float_as_uint(x), false, false);
    return __uint_as_float(q[0]) + __uint_as_float(q[1]);
}
__device__ __forceinline__ void attn_step(const KBuf& B, const VBuf& V, const bf16x8 (&qf)[2], f32x4 c0, f32x4 c1, float& m, float& l, f32x4 (&o)[4]) {
    f32x4 s0 = __builtin_amdgcn_mfma_f32_16x16x32_bf16(B.k[0][0], qf[0], c0, 0, 0, 0);
    f32x4 s1 = __builtin_amdgcn_mfma_f32_16x16x32_bf16(B.k[1][0], qf[0], c1, 0, 0, 0);
    s0 = __builtin_amdgcn_mfma_f32_16x16x32_bf16(B.k[0][1], qf[1], s0, 0, 0, 0);
    s1 = __builtin_amdgcn_mfma_f32_16x16x32_bf16(B.k[1][1], qf[1], s1, 0, 0, 0);
    float mx = fmaxf(fmaxf(fmaxf(s0[0], s0[1]), fmaxf(s0[2], s0[3])), fmaxf(fmaxf(s1[0], s1[1]), fmaxf(s1[2], s1[3])));
    mx = red16_max(mx);
    const float mn = fmaxf(m, mx);
    const float alpha = __builtin_amdgcn_exp2f(m - mn);
    m = mn;
    f32x4 p0, p1;
#pragma unroll
    for (int e = 0; e < 4; ++e) { p0[e] = __builtin_amdgcn_exp2f(s0[e] - mn); p1[e] = __builtin_amdgcn_exp2f(s1[e] - mn); }
    l = l * alpha + ((p0[0] + p0[1]) + (p0[2] + p0[3])) + ((p1[0] + p1[1]) + (p1[2] + p1[3]));
    u32x4 pw; pw.x = pk2(p0[0], p0[1]); pw.y = pk2(p0[2], p0[3]); pw.z = pk2(p1[0], p1[1]); pw.w = pk2(p1[2], p1[3]);
    const bf16x8 pf = __builtin_bit_cast(bf16x8, pw);
#pragma unroll
    for (int d = 0; d < 4; ++d) { o[d] = o[d] * alpha; o[d] = __builtin_amdgcn_mfma_f32_16x16x32_bf16(V.v[d], pf, o[d], 0, 0, 0); }
}

__device__ __forceinline__ void attn_step2(const KBuf& KA, const VBuf& VA, const KBuf& KB, const VBuf& VB, const bf16x8 (&qf)[2], f32x4 c0, f32x4 c1, float& m, float& l, f32x4 (&o)[4]) {
    const f32x4 z4 = (f32x4){0.f, 0.f, 0.f, 0.f};
    f32x4 a0 = __builtin_amdgcn_mfma_f32_16x16x32_bf16(KA.k[0][0], qf[0], z4, 0, 0, 0);
    f32x4 a1 = __builtin_amdgcn_mfma_f32_16x16x32_bf16(KA.k[1][0], qf[0], z4, 0, 0, 0);
    f32x4 b0 = __builtin_amdgcn_mfma_f32_16x16x32_bf16(KB.k[0][0], qf[0], c0, 0, 0, 0);
    f32x4 b1 = __builtin_amdgcn_mfma_f32_16x16x32_bf16(KB.k[1][0], qf[0], c1, 0, 0, 0);
    a0 = __builtin_amdgcn_mfma_f32_16x16x32_bf16(KA.k[0][1], qf[1], a0, 0, 0, 0);
    a1 = __builtin_amdgcn_mfma_f32_16x16x32_bf16(KA.k[1][1], qf[1], a1, 0, 0, 0);
    b0 = __builtin_amdgcn_mfma_f32_16x16x32_bf16(KB.k[0][1], qf[1], b0, 0, 0, 0);
    b1 = __builtin_amdgcn_mfma_f32_16x16x32_bf16(KB.k[1][1], qf[1], b1, 0, 0, 0);
    float mxa = fmaxf(fmaxf(fmaxf(a0[0], a0[1]), fmaxf(a0[2], a0[3])), fmaxf(fmaxf(a1[0], a1[1]), fmaxf(a1[2], a1[3])));
    float mxb = fmaxf(fmaxf(fmaxf(b0[0], b0[1]), fmaxf(b0[2], b0[3])), fmaxf(fmaxf(b1[0], b1[1]), fmaxf(b1[2], b1[3])));
    const float mx = red16_max(fmaxf(mxa, mxb));
    const float mn = fmaxf(m, mx);
    const float alpha = __builtin_amdgcn_exp2f(m - mn);
    m = mn;
    f32x4 pa0, pa1, pb0, pb1;
#pragma unroll
    for (int e = 0; e < 4; ++e) { pa0[e] = __builtin_amdgcn_exp2f(a0[e] - mn); pa1[e] = __builtin_amdgcn_exp2f(a1[e] - mn); pb0[e] = __builtin_amdgcn_exp2f(b0[e] - mn); pb1[e] = __builtin_amdgcn_exp2f(b1[e] - mn); }
    const f32x4 ps = (pa0 + pa1) + (pb0 + pb1);
    l = l * alpha + ((ps[0] + ps[1]) + (ps[2] + ps[3]));
    u32x4 wa, wb; wa.x = pk2(pa0[0], pa0[1]); wa.y = pk2(pa0[2], pa0[3]); wa.z = pk2(pa1[0], pa1[1]); wa.w = pk2(pa1[2], pa1[3]);
    wb.x = pk2(pb0[0], pb0[1]); wb.y = pk2(pb0[2], pb0[3]); wb.z = pk2(pb1[0], pb1[1]); wb.w = pk2(pb1[2], pb1[3]);
    const bf16x8 pfa = __builtin_bit_cast(bf16x8, wa), pfb = __builtin_bit_cast(bf16x8, wb);
#pragma unroll
    for (int d = 0; d < 4; ++d) { o[d] = o[d] * alpha; o[d] = __builtin_amdgcn_mfma_f32_16x16x32_bf16(VA.v[d], pfa, o[d], 0, 0, 0); o[d] = __builtin_amdgcn_mfma_f32_16x16x32_bf16(VB.v[d], pfb, o[d], 0, 0, 0); }
}

constexpr int TAB_LD = 48, TAB_ROWS = 15;
constexpr int CK_STRIDE = 144, CV_STRIDE = 528, RW_STRIDE = 144;
constexpr int LDS_TAB = 0, LDS_CK = 3072, LDS_CV = LDS_CK + CTXL * CK_STRIDE, LDS_RING = LDS_CV + HD * CV_STRIDE;
constexpr int ROWK_BYTES = 64 * RW_STRIDE, SLOT_BYTES = 2 * ROWK_BYTES, LDS_ATT_END = LDS_RING + 3 * SLOT_BYTES;
static_assert(TAB_ROWS * TAB_LD * 4 <= LDS_CK && LDS_ATT_END <= RING_BYTES, "attention LDS map");
__device__ __forceinline__ int rs_of(int r) { int v = r - 4; return v < 0 ? 0 : (v > 24 ? 24 : v); }
__device__ __forceinline__ void attn_phase(const bf16_t* QK, const bf16_t* VT, bf16_t* O, const float* rpb, LAS unsigned char* lds, int tid, int lane, int wave, int bid, int G) {
    LAS float* tab = (LAS float*)(lds + LDS_TAB);
    const int fr = lane & 15, fq = lane >> 4;
    const int j = wave & 3, rw = wave >> 2;
    const int kc0 = (j == 0) ? 0 : (j == 1) ? 8 : (j == 2) ? 24 : 32;
    unsigned bpk0 = 0u, bpk1 = 0u;
    { const int cq = 16 * j + fr; int cs = cq - 8; cs = cs < 0 ? 0 : (cs > 48 ? 48 : cs);
#pragma unroll
      for (int jj = 0; jj < 8; ++jj) { const int ck = kc0 + 8 * fq + jj; const bool valid = (ck >= cs) && (ck < cs + 16); const unsigned col = valid ? (unsigned)(ck - cq + 15) : 31u;
          if (jj < 4) bpk0 |= col << (8 * jj); else bpk1 |= col << (8 * (jj - 4)); } }
    LAS unsigned char* ckl = lds + LDS_CK + fr * CK_STRIDE + fq * 16;
    LAS unsigned char* cvl = lds + LDS_CV + fr * CV_STRIDE + fq * 16;
    const int klo = LDS_RING + (kc0 + 8 * (fr >> 2) + (fr & 3)) * RW_STRIDE + fq * 16;
    const int vlo = LDS_RING + ROWK_BYTES + fr * RW_STRIDE + (kc0 + 8 * fq) * 2;
    const int st_t = tid >> 3, st_ch = tid & 7;
    const int st_off = st_t * RW_STRIDE + st_ch * 16;
    for (int bh = bid; bh < NB * NH; bh += G) {
        const int b = bh >> 4, h = bh & 15;
        const int ctx_kt0 = MLAT + b * CTXL;
        const bf16_t* ksrc = QK + (size_t)(b * SEQ + st_t) * 2048 + 1024 + h * 64 + st_ch * 8;
        const bf16_t* vsrc = VT + (size_t)(h * 64 + st_t) * VT_LD + b * SEQ + st_ch * 8;
        __syncthreads();
        for (int i = tid; i < TAB_ROWS * TAB_LD; i += 512) { const int col = i % TAB_LD, dr = i / TAB_LD; tab[i] = col < 31 ? rpb[(h * TAB_ROWS + dr) * 31 + col] * LOG2E : -1e30f; }
        for (int p = tid; p < CTXL * 8; p += 512) { const int key = p >> 3, ch = p & 7, c = key >> 5, w = key & 31; const int slot = c * 32 + ((w >> 2) & 1) * 16 + (w >> 3) * 4 + (w & 3);
            *(LAS u32x4*)(lds + LDS_CK + slot * CK_STRIDE + ch * 16) = *(const u32x4*)(QK + (size_t)(ctx_kt0 + key) * 2048 + 1024 + h * 64 + ch * 8); }
        for (int p = tid; p < HD * 32; p += 512) { const int d = p >> 5, ch = p & 31;
            *(LAS u32x4*)(lds + LDS_CV + d * CV_STRIDE + ch * 16) = *(const u32x4*)(VT + (size_t)(h * 64 + d) * VT_LD + ctx_kt0 + ch * 8); }
#pragma unroll
        for (int s0 = 0; s0 < 2; ++s0) {
            *(LAS u32x4*)(lds + LDS_RING + s0 * SLOT_BYTES + st_off) = *(const u32x4*)(ksrc + (size_t)s0 * 64 * 2048);
            *(LAS u32x4*)(lds + LDS_RING + s0 * SLOT_BYTES + ROWK_BYTES + st_off) = *(const u32x4*)(vsrc + s0 * 64); }
        u32x4 kr0, vr0, kr1, vr1, kr2, vr2;
        kr2 = *(const u32x4*)(ksrc + (size_t)2 * 64 * 2048); vr2 = *(const u32x4*)(vsrc + 2 * 64);
        kr0 = *(const u32x4*)(ksrc + (size_t)3 * 64 * 2048); vr0 = *(const u32x4*)(vsrc + 3 * 64);
        kr1 = kr0; vr1 = vr0;
        asm volatile("s_waitcnt lgkmcnt(0)" ::: "memory"); __builtin_amdgcn_s_barrier(); asm volatile("" ::: "memory");
        int gslot = 0;
        int it = 0, sc = 0, n_cur = 8, rs_lo = 0;
        int r_ = rw, rsw_ = 0, tq0_ = b * SEQ + rw * 64 + j * 16;
        int itp = 0, sp = 4, np = 8, prow = 4;
        bf16x8 qf[2], qn[2]; float m = -1e30f, l = 0.f; f32x4 o[4];
        qf[0] = qf[1] = (bf16x8){0, 0, 0, 0, 0, 0, 0, 0};
#pragma unroll
        for (int ks = 0; ks < 2; ++ks) qn[ks] = *(const bf16x8*)(QK + (size_t)(b * SEQ + rw * 64 + j * 16 + fr) * 2048 + h * 64 + ks * 32 + fq * 8);
#pragma unroll
        for (int d = 0; d < 4; ++d) o[d] = (f32x4){0.f, 0.f, 0.f, 0.f};
#define ATT_STEP(KI, VI, KW, VW) do { \
            { const int row_ = itp < 16 ? prow : 0; KI = *(const u32x4*)(ksrc + (size_t)row_ * 64 * 2048); VI = *(const u32x4*)(vsrc + row_ * 64); } \
            ++prow; if (++sp >= np) { sp = 0; ++itp; prow = rs_of(2 * itp); np = 8 + rs_of(2 * itp + 1) - prow; } \
            if (it < 16) { \
                if (sc == 0) { qf[0] = qn[0]; qf[1] = qn[1]; \
                    m = -1e30f; l = 0.f; _Pragma("unroll") for (int d = 0; d < 4; ++d) o[d] = (f32x4){0.f, 0.f, 0.f, 0.f}; } \
                if (sc == n_cur - 2) { const int tqn_ = tq0_ + (it < 15 ? 128 : 0);        \
                    _Pragma("unroll") for (int ks = 0; ks < 2; ++ks) qn[ks] = *(const bf16x8*)(QK + (size_t)(tqn_ + fr) * 2048 + h * 64 + ks * 32 + fq * 8); } \
                const int c_ = rs_lo + sc - rsw_; \
                if (c_ >= 0 && c_ < 8) { \
                    KBuf kc_, kl_; VBuf vc_, vl_; \
                    const LAS unsigned char* cks = ckl + c_ * 32 * CK_STRIDE; const LAS unsigned char* cvs = cvl + c_ * 64; \
                    const LAS unsigned char* lk = lds + klo + gslot * SLOT_BYTES; const LAS unsigned char* lv = lds + vlo + gslot * SLOT_BYTES; \
                    _Pragma("unroll") for (int T = 0; T < 2; ++T) _Pragma("unroll") for (int ks = 0; ks < 2; ++ks) { \
                        kc_.k[T][ks] = *(const LAS bf16x8*)(cks + T * 16 * CK_STRIDE + ks * 64); kl_.k[T][ks] = *(const LAS bf16x8*)(lk + T * 4 * RW_STRIDE + ks * 64); } \
                    _Pragma("unroll") for (int d = 0; d < 4; ++d) { vc_.v[d] = *(const LAS bf16x8*)(cvs + d * 16 * CV_STRIDE); vl_.v[d] = *(const LAS bf16x8*)(lv + d * 16 * RW_STRIDE); } \
                    const int tb_ = (rsw_ - r_ + 7 + c_) * TAB_LD; f32x4 c0_, c1_; \
                    _Pragma("unroll") for (int e = 0; e < 4; ++e) { c0_[e] = tab[tb_ + (int)((bpk0 >> (8 * e)) & 255u)]; c1_[e] = tab[tb_ + (int)((bpk1 >> (8 * e)) & 255u)]; } \
                    attn_step2(kc_, vc_, kl_, vl_, qf, c0_, c1_, m, l, o); } \
                if (sc == n_cur - 1) { \
                    const float lt = red16_sum(l); const float rl = 1.0f / lt; \
                    bf16_t* op = O + (size_t)(tq0_ + fr) * DM + h * 64 + 4 * fq; \
                    _Pragma("unroll") for (int d = 0; d < 4; ++d) { const f32x4 v = o[d] * rl; u32x2 w; w.x = pk2(v[0], v[1]); w.y = pk2(v[2], v[3]); *(u32x2*)(op + d * 16) = w; } } \
                if (++sc >= n_cur) { sc = 0; ++it; rs_lo = rs_of(2 * it); const int rs_hi_ = rs_of(2 * it + 1); n_cur = 8 + rs_hi_ - rs_lo; \
                    r_ = 2 * it + rw; rsw_ = rw ? rs_hi_ : rs_lo; tq0_ = b * SEQ + r_ * 64 + j * 16; } } \
            { int wslot = gslot + 2; wslot = wslot >= 3 ? wslot - 3 : wslot; \
              *(LAS u32x4*)(lds + LDS_RING + wslot * SLOT_BYTES + st_off) = KW; *(LAS u32x4*)(lds + LDS_RING + wslot * SLOT_BYTES + ROWK_BYTES + st_off) = VW; } \
            asm volatile("s_waitcnt lgkmcnt(0)" ::: "memory"); __builtin_amdgcn_s_barrier(); asm volatile("" ::: "memory"); \
            gslot = gslot == 2 ? 0 : gslot + 1; } while (0)
#pragma unroll 1
        for (int g = 0; g < 141; g += 3) {
            ATT_STEP(kr1, vr1, kr2, vr2);
            ATT_STEP(kr2, vr2, kr0, vr0);
            ATT_STEP(kr0, vr0, kr1, vr1);
        }
#undef ATT_STEP
    }
}

#define XB_TMO      128
#define XB_XCNT(j)  (256  + 64 * (j))
#define XB_XSUB(j)  (1280 + 64 * (j))
#define XB_XGEN(j)  (2304 + 64 * (j))
#define XB_TOP      3328
#define XB_TOPGEN   3392
#define XCD_BAR_WORDS 3456
#define XB_SPIN_CAP (1u << 18)

__device__ __forceinline__ unsigned xb_ld(unsigned* p)              { return __hip_atomic_load(p, __ATOMIC_RELAXED, __HIP_MEMORY_SCOPE_AGENT); }
__device__ __forceinline__ unsigned xb_add(unsigned* p, unsigned v) { return __hip_atomic_fetch_add(p, v, __ATOMIC_RELAXED, __HIP_MEMORY_SCOPE_AGENT); }
__device__ __forceinline__ unsigned xb_xcc_id() { return (unsigned)__builtin_amdgcn_s_getreg((3 << 11) | 20) & 0xFu; }
#define XB_SPIN(cond, bar) do { unsigned _sp = 0; while (cond) { __builtin_amdgcn_s_sleep(1); \
    if ((++_sp & 255u) == 0u) { if (xb_ld(&(bar)[XB_TMO])) break; if (_sp > XB_SPIN_CAP) { atomicAdd(&(bar)[XB_TMO], 1u); break; } } } } while (0)

struct XcdBarrier {
    unsigned* bar; unsigned x;
    volatile LAS unsigned* st;
};

__device__ __forceinline__ XcdBarrier xcd_barrier_post(unsigned* bar, volatile LAS unsigned* st) {
    XcdBarrier b; b.bar = bar; b.x = xb_xcc_id(); b.st = st;
    if (threadIdx.x == 0) (void)xb_add(&bar[XB_XCNT(b.x)], 1u);
    return b;
}
__device__ __forceinline__ void xcd_barrier_complete(unsigned* bar, unsigned x, unsigned& nloc, unsigned& nx) {
    const unsigned G = gridDim.x * gridDim.y * gridDim.z;
    unsigned sum, cnt, mine, sp = 0u;
    for (;;) {
        sum = 0u; cnt = 0u; mine = 0u;
#pragma unroll
        for (unsigned j = 0; j < 16; ++j) { const unsigned c = xb_ld(&bar[XB_XCNT(j)]); sum += c; cnt += (c > 0u) ? 1u : 0u; mine = (j == x) ? c : mine; }
        if (sum == G) break;
        __builtin_amdgcn_s_sleep(1);
        if ((++sp & 255u) == 0u) { if (xb_ld(&bar[XB_TMO])) break; if (sp > XB_SPIN_CAP) { atomicAdd(&bar[XB_TMO], 1u); break; } }
    }
    nloc = mine > 0u ? mine : 1u; nx = cnt > 0u ? cnt : 1u;
}

__device__ __forceinline__ void xcd_barrier(const XcdBarrier& b) {
    asm volatile("s_waitcnt vmcnt(0)" ::: "memory");
    __syncthreads();
    if (threadIdx.x == 0) {
        unsigned* bar = b.bar;
        __builtin_amdgcn_s_waitcnt(0);
        unsigned nloc = b.st[0], nx = b.st[1];
        if (nloc == 0u) { xcd_barrier_complete(bar, b.x, nloc, nx); b.st[0] = nloc; b.st[1] = nx; }
        const unsigned old = xb_add(&bar[XB_XSUB(b.x)], 1u);
        const unsigned gen = old / nloc;
        if (old + 1u == (gen + 1u) * nloc) {
            __builtin_amdgcn_fence(__ATOMIC_RELEASE, "agent");
            asm volatile("s_waitcnt vmcnt(0)" ::: "memory");
            const unsigned og = xb_add(&bar[XB_TOP], 1u);
            const unsigned tg = og / nx;
            if (og + 1u == (tg + 1u) * nx) xb_add(&bar[XB_TOPGEN], 1u);
            else XB_SPIN(xb_ld(&bar[XB_TOPGEN]) == tg, bar);
            __builtin_amdgcn_fence(__ATOMIC_ACQUIRE, "agent");
            xb_add(&bar[XB_XGEN(b.x)], 1u);
            asm volatile("s_waitcnt vmcnt(0)" ::: "memory");
        } else {
            XB_SPIN(xb_ld(&bar[XB_XGEN(b.x)]) == gen, bar);
            __builtin_amdgcn_fence(__ATOMIC_ACQUIRE, "agent");
            asm volatile("s_waitcnt vmcnt(0)" ::: "memory");
        }
    }
    __syncthreads();
}


constexpr int NPHASE = 14;
__global__ void __launch_bounds__(512, 2) fwd_mega(Args args) {
    extern __shared__ __attribute__((aligned(16))) unsigned char lds_raw[];
    LAS unsigned char* lds = (LAS unsigned char*)lds_raw;
    cg::grid_group grid = cg::this_grid();
    const int G = gridDim.x, bid = blockIdx.x, NGW = G * 8;
    unsigned char* ws = args.ws;
    const float* x = args.in[0]; const float* ctx = args.in[2];
    const float* norm1_g = args.in[4]; const float* norm2_g = args.in[5];
    const float* conv_w = args.in[9]; const float* rpb = args.in[12]; const float* final_g = args.in[16];
    float* mod = (float*)(ws + WS_MOD);
    bf16_t* SHA = (bf16_t*)(ws + WS_SHA);
    bf16_t* H = (bf16_t*)(ws + WS_H); bf16_t* H2 = (bf16_t*)(ws + WS_H2); float* rss = (float*)(ws + WS_RSS); float* shw = (float*)(ws + WS_SHW);
    bf16_t* Xctx = (bf16_t*)(ws + WS_XCTX);
    bf16_t* Xlat = (bf16_t*)args.out;
    bf16_t* BIG = (bf16_t*)(ws + WS_BIG);
    bf16_t* U = BIG; bf16_t* Bg = BIG + (size_t)MALL * 1024;
    bf16_t* HID = BIG;
    bf16_t* QK = BIG; bf16_t* VT = BIG + (size_t)MALL * 2048;
    bf16_t* Wcin = (bf16_t*)(ws + WS_WCIN); bf16_t* Wcout = (bf16_t*)(ws + WS_WCOUT); bf16_t* Wqkv = (bf16_t*)(ws + WS_WQKV); bf16_t* Wao = (bf16_t*)(ws + WS_WAO);
    bf16_t* W1 = (bf16_t*)(ws + WS_W1); bf16_t* W2 = (bf16_t*)(ws + WS_W2);

#ifndef PROBE_PH
#define PROBE_PH -1
#endif
#ifndef PROBE_PH2
#define PROBE_PH2 -1
#endif
    if (threadIdx.x < 32) ((volatile LAS unsigned*)(lds + MISC_OFF))[threadIdx.x] = 0u;
    __syncthreads();
    const XcdBarrier xbar = xcd_barrier_post((unsigned*)(ws + WS_CTL), (volatile LAS unsigned*)(lds + MISC_OFF) + 8);
    if (args.ph_lo < 0) grid.sync();
    for (int ph = args.ph_lo; ph < args.ph_hi; ++ph) {
      for (int rep = 0; rep < ((ph == PROBE_PH || ph == PROBE_PH2) ? 2 : 1); ++rep) {
        if (rep) xcd_barrier(xbar);
        int tid = threadIdx.x; asm volatile("" : "+v"(tid));
        const int lane = tid & 63, wave = __builtin_amdgcn_readfirstlane(tid >> 6), gw = bid * 8 + wave;
        int kind = 0;
        bool sync_after = true;
        pg8::Gemm g{nullptr, nullptr, 0, 0, 0}; int cidx = bid;
        pg8::EpiU E{}; E.mode = 0; E.O = nullptr; E.O2 = nullptr; E.ldc = 0; E.scale_tiles = 0; E.sc = 1.f; E.rss = nullptr; E.shw = nullptr; E.shw_ld = 0; E.inLat = nullptr; E.inCtx = nullptr; E.inbLat = nullptr; E.inbCtx = nullptr; E.outLat = nullptr; E.outCtx = nullptr; E.gate = nullptr;
        E.An = nullptr; E.gn = nullptr; E.scn = nullptr; E.rssn = nullptr; E.outf5 = nullptr;
        switch (ph) {
        case 0: p0_phase(args, lds, tid, lane, wave, bid, G); break;
        case 1: norm_phase(x, ctx, MALL, norm1_g, mod, 0, 1, H, nullptr, nullptr, gw, NGW, lane);
                for (int i = bid * 512 + tid; i < 3 * 17 * 1024; i += G * 512) { const int jb = i / (17 * 1024), rr = (i / 1024) % 17, k = i & 1023;
                    const float* shp = mod + (jb == 0 ? 3 * 1024 : jb == 1 ? 17 * 6144 : 17 * 6144 + 3 * 1024) + (size_t)rr * 6144;
                    SHA[(size_t)(jb * 256 + rr) * 1024 + k] = (bf16_t)f2bf(shp[k]); }
                break;
        case 2: kind = 1; g = pg8::Gemm{H, Wcin, MALL, 3072, 1024}; E.mode = 2; E.O = U; E.O2 = Bg; break;
        case 3: convgate_phase(U, Bg, conv_w, H, gw, NGW, lane); break;
        case 4: kind = 1; g = pg8::Gemm{H, Wcout, MALL, 1024, 1024}; E.mode = 3; E.inLat = x; E.inCtx = ctx; E.outLat = Xlat; E.outCtx = Xctx; E.gate = mod + 2 * 1024;
                E.An = H2; E.gn = norm2_g; E.scn = mod + 4 * 1024; E.rssn = rss; break;
        case 5: kind = 1; g = pg8::Gemm{H2, W1, MALL, 4096, 1024}; E.mode = 1; E.O = HID; E.ldc = 4096; E.rss = rss; E.shw = shw; E.shw_ld = 4096; break;
        case 6: case 7:
                kind = 1; g = pg8::Gemm{HID, W2, MLAT, 1024, 4096}; E.mode = 3; E.inbLat = Xlat; E.inbCtx = Xctx; E.outLat = Xlat; E.outCtx = Xctx; E.gate = mod + 5 * 1024;
                E.An = H; E.gn = norm1_g + 1024; E.scn = mod + 17 * 6144 + 1 * 1024; E.rssn = rss + MALL; break;
        case 8: kind = 1; break;
        case 9: attn_phase(QK, VT, H2, rpb, lds, tid, lane, wave, bid, G); break;
        case 10: kind = 1; g = pg8::Gemm{H2, Wao, MLAT, 1024, 1024}; E.mode = 3; E.inbLat = Xlat; E.inbCtx = Xctx; E.outLat = Xlat; E.outCtx = Xctx; E.gate = mod + 17 * 6144 + 2 * 1024;
                E.An = H; E.gn = norm2_g + 1024; E.scn = mod + 17 * 6144 + 4 * 1024; E.rssn = rss + 2 * MALL; break;
        case 11: kind = 1; g = pg8::Gemm{H, W1 + (size_t)4096 * 1024, MLAT, 4096, 1024}; E.mode = 1; E.O = HID; E.ldc = 4096; E.rss = rss + 2 * MALL; E.shw = shw + 17 * 4096 + 17 * 3072; E.shw_ld = 4096; break;
        case 12: kind = 1; g = pg8::Gemm{HID, W2 + (size_t)4096 * 1024, MLAT, 1024, 4096}; E.mode = 3; E.inbLat = Xlat; E.inbCtx = Xctx; E.outLat = H2; E.outCtx = Xctx; E.gate = mod + 17 * 6144 + 5 * 1024;
                E.rssn = rss + 3 * MALL; break;
        case 13: final_phase(H2, rss + 3 * MALL, final_g, args.out, gw, NGW, lane); break;
        default: break;
        }
#ifndef NO_GEMM
        if (kind == 1) {
            const int qk_done = (G > 64) ? ((4 * (G - 64) < 1024) ? 4 * (G - 64) : 1024) : 0;
            const int nsub = (ph == 4) ? 4 : (ph == 8) ? 3 : 1;
            for (int sub = 0; sub < nsub; ++sub) {
                int Gs = G, pm0 = 0, lbeg = 0, lend = -1;
                if (ph == 4 && sub > 0) {
                    const int jb = sub - 1;
                    const int N5 = (jb == 1) ? 3072 : 4096;
                    g = pg8::Gemm{SHA + (size_t)jb * 256 * 1024, jb == 0 ? W1 : jb == 1 ? Wqkv : W1 + (size_t)4096 * 1024, 256, N5, 1024};
                    E.mode = 5; E.ldc = N5; E.outf5 = shw + (jb == 0 ? 0 : jb == 1 ? 17 * 4096 : 17 * 4096 + 17 * 3072); E.rss = nullptr; E.shw = nullptr;
                    cidx = (bid + G - ((G > 112) ? 64 + 16 * jb : 0)) % G;
                }
                const bool qk_role = (ph == 7 && G > 64 && bid >= 64) || (ph == 8 && sub < 2);
                if (ph == 7 && !qk_role) { g.M = MCTX; pm0 = MLAT / 256; Gs = (G > 64) ? 64 : G; cidx = bid; }
                if (qk_role) {
                    g = pg8::Gemm{H, Wqkv, MLAT, 2048, 1024}; E.mode = 0; E.O = QK; E.ldc = 2048; E.scale_tiles = 4; E.sc = QSCALE; E.rss = rss + MALL; E.shw = shw + 17 * 4096; E.shw_ld = 3072;
                    E.An = nullptr; E.rssn = nullptr;
                    if (ph == 7) { Gs = G - 64; cidx = bid - 64; lend = qk_done; }
                    else if (sub == 0) { lbeg = qk_done; }
                    else { g.M = MCTX; pm0 = MLAT / 256; cidx = (bid + G - G / 2) % G; }
                }
                if (ph == 8 && sub == 2) { g = pg8::Gemm{Wqkv + (size_t)2048 * 1024, H, 1024, MALL, 1024}; E.mode = 4; E.O = VT; E.ldc = VT_LD; E.rss = rss + MALL; E.shw = shw + 17 * 4096; E.shw_ld = 3072; cidx = bid; }
                pg8::StaticOrder S; S.init(g.M, g.N, Gs, cidx, pm0, lbeg, lend);
                pg8::gemm_phase<pg8::EpiU, pg8::StaticOrder, true, true>(lds, g, S, E);
            }
        } else
#endif
        {}
      }
        if (ph + 1 < args.ph_hi) xcd_barrier(xbar);
    }
}

extern "C" void kernel_launch(void* const* d_in, const int* in_sizes, int n_in, void* d_out, int out_size, void* d_ws, size_t ws_size, hipStream_t stream) {
    static int grid = 0;
    if (grid == 0) {
        if (n_in != 17 || ws_size < WS_END) { fprintf(stderr, "kernel_launch: unexpected n_in %d / ws_size %zu\n", n_in, ws_size); grid = -1; return; }
        int dev = 0, cus = 0, per_cu = 0;
        hipGetDevice(&dev); hipDeviceGetAttribute(&cus, hipDeviceAttributeMultiprocessorCount, dev);
        if (hipFuncSetAttribute((const void*)fwd_mega, hipFuncAttributeMaxDynamicSharedMemorySize, LDS_BYTES) != hipSuccess) { fprintf(stderr, "kernel_launch: hipFuncSetAttribute failed\n"); grid = -1; return; }
        if (hipOccupancyMaxActiveBlocksPerMultiprocessor(&per_cu, (const void*)fwd_mega, 512, LDS_BYTES) != hipSuccess || per_cu < 1) { fprintf(stderr, "kernel_launch: occupancy query says %d\n", per_cu); per_cu = 1; }
        (void)hipGetLastError();
        grid = cus * (per_cu > 1 ? 1 : per_cu);
        if (grid <= 0) grid = 256;
    }
    if (grid < 0) return;
    if (hipMemsetAsync((char*)d_ws + WS_CTL, 0, CTL_BYTES, stream) != hipSuccess) { fprintf(stderr, "kernel_launch: memset failed\n"); return; }
    Args a{};
    for (int i = 0; i < 17; ++i) a.in[i] = (const float*)d_in[i];
    a.out = (float*)d_out; a.ws = (unsigned char*)d_ws;
#if MK_N_LAUNCHES == 1
    a.ph_lo = 0; a.ph_hi = NPHASE;
    void* kargs[] = {&a};
    hipError_t e = hipLaunchCooperativeKernel((const void*)fwd_mega, dim3(grid), dim3(512), kargs, LDS_BYTES, stream);
    if (e != hipSuccess) fprintf(stderr, "kernel_launch: cooperative launch failed: %s (grid %d)\n", hipGetErrorString(e), grid);
#else
    for (int ph = 0; ph < NPHASE; ++ph) {
        a.ph_lo = ph; a.ph_hi = ph + 1;
        hipLaunchKernelGGL(fwd_mega, dim3(grid), dim3(512), LDS_BYTES, stream, a);
    }
#endif
}
```

```cpp
#include <hip/hip_runtime.h>
#include <hip/hip_cooperative_groups.h>
#include <cstdio>
#include <cstdint>
namespace cg = cooperative_groups;

#ifndef MK_N_LAUNCHES
#define MK_N_LAUNCHES 1
#endif

#define LAS __attribute__((address_space(3)))
typedef unsigned short bf16_t;
typedef short bf16x8 __attribute__((ext_vector_type(8)));
typedef float f32x4 __attribute__((ext_vector_type(4)));
typedef unsigned u32x4 __attribute__((ext_vector_type(4)));
typedef unsigned u32x2 __attribute__((ext_vector_type(2)));

constexpr int DM = 1024, NB = 16, SEQ = 2048, CTXL = 256, NH = 16, HD = 64, FF = 4096;
constexpr int MLAT = NB * SEQ;
constexpr int MCTX = NB * CTXL;
constexpr int MALL = MLAT + MCTX;
constexpr float RMS_EPS = 1e-6f;
constexpr float LOG2E = 1.4426950408889634f;
constexpr float QSCALE = 0.125f * LOG2E;

constexpr size_t MiB = 1u << 20;
constexpr size_t WS_SHW = 0;
constexpr size_t WS_MOD = 1 * MiB;
constexpr size_t WS_WCIN = 2 * MiB;
constexpr size_t WS_WCOUT = 8 * MiB;
constexpr size_t WS_WQKV = 10 * MiB;
constexpr size_t WS_WAO = 16 * MiB;
constexpr size_t WS_W1 = 18 * MiB;
constexpr size_t WS_W2 = 34 * MiB;
constexpr size_t WS_H = 50 * MiB;
constexpr size_t WS_XCTX = 122 * MiB;
constexpr size_t WS_BIG = 138 * MiB;
constexpr size_t WS_H2 = 426 * MiB;
constexpr size_t WS_RSS = 498 * MiB;
constexpr size_t WS_CTL = 498 * MiB + 640 * 1024;
constexpr size_t CTL_BYTES = 16384;
constexpr size_t WS_SHA = 500 * MiB;
constexpr size_t WS_END = 502 * MiB;

constexpr int RING_BYTES = 131072;
constexpr int LDS_BYTES = 147456;
constexpr int MISC_OFF = RING_BYTES + 320;

namespace pg8 {
constexpr int BM = 256, BK = 64, HALF = 128, HTB = HALF * BK * 2, STAGE_BYTES = 8 * HTB, NXCD = 8, WGM = 8;
__host__ __device__ __forceinline__ int lds_byte(int r, int c) { const int st = (r >> 4) * 2 + (c >> 5), rr = r & 15, cc = c & 31, ob = rr * 64 + cc * 2; return st * 1024 + (ob ^ (((ob >> 9) & 1) << 5)); }
__host__ __device__ __forceinline__ void stage_rc(int b, int& R, int& C) { const int st = b / 1024, sb = b % 1024, swz = sb ^ (((sb >> 9) & 1) << 5); R = (st >> 1) * 16 + swz / 64; C = (st & 1) * 32 + (swz % 64) / 2; }
__host__ __device__ __forceinline__ int perm32(int rho) { const int n = rho >> 4, i = rho & 15; return 8 * (i >> 2) + 4 * n + (i & 3); }

struct Unit { int pm, pn; };
struct Gemm { const bf16_t* A; const bf16_t* Bt; int M, N, K; };

struct StaticOrder {
    int nM, nN, nwg, G, c, pm0, lbeg, lend;
    __host__ __device__ void init(int M, int N, int G_, int c_, int pm0_ = 0, int lbeg_ = 0, int lend_ = -1) { nM = M / BM; nN = N / BM; nwg = nM * nN; G = G_; c = c_; pm0 = pm0_; lbeg = lbeg_; lend = lend_ < 0 ? nwg : lend_; }
    __host__ __device__ bool next(int i, Unit& u) const {
        const long L = (long)lbeg + (long)i * G + c; if (L >= lend) return false;
        int wgid = (int)L; { const int q = nwg / NXCD, r = nwg % NXCD, xcd = wgid % NXCD, off = wgid / NXCD; wgid = (xcd < r ? xcd * (q + 1) : r * (q + 1) + (xcd - r) * q) + off; }
        const int nig = WGM * nN, gid = wgid / nig, fm = gid * WGM, gsz = (nM - fm) < WGM ? (nM - fm) : WGM;
        u.pm = pm0 + fm + ((wgid % nig) % gsz); u.pn = (wgid % nig) / gsz; return true;
    }
};

__device__ __forceinline__ unsigned cvt_pk_bf16(float lo, float hi) { unsigned r; asm volatile("v_cvt_pk_bf16_f32 %0, %1, %2" : "=v"(r) : "v"(lo), "v"(hi)); return r; }

__device__ __forceinline__ float xsum16(float x) {
    auto r = __builtin_amdgcn_permlane16_swap(__float_as_uint(x), __float_as_uint(x), false, false);
    x = __uint_as_float(r[0]) + __uint_as_float(r[1]);
    auto q = __builtin_amdgcn_permlane32_swap(__float_as_uint(x), __float_as_uint(x), false, false);
    return __uint_as_float(q[0]) + __uint_as_float(q[1]);
}
struct EpiU {
    int mode;
    bf16_t* O; bf16_t* O2; int ldc; int scale_tiles; float sc;
    const float* rss; const float* shw; int shw_ld;
    const float* inLat; const float* inCtx; const bf16_t* inbLat; const bf16_t* inbCtx; bf16_t* outLat; bf16_t* outCtx; const float* gate;
    float* outf5;
    bf16_t* An; const float* gn; const float* scn; float* rssn;
    __device__ __forceinline__ bool has_aux() const { return (mode <= 1 || mode == 4) && rss != nullptr; }
    __device__ __forceinline__ const float* aux_src(const Unit& u, int wid, int lane) const {
        const int i = (wid & 3) * 64 + lane;
        if (mode == 4) { const float* shp = shw + (size_t)(u.pn < (MLAT / BM) ? (u.pn >> 3) : 16) * shw_ld + 2048; return wid < 4 ? shp + u.pm * BM + i : rss + u.pn * BM + i; }
        return wid < 4 ? rss + u.pm * BM + i : shw + (size_t)(u.pm < (MLAT / BM) ? (u.pm >> 3) : 16) * shw_ld + u.pn * BM + i;
    }
    __device__ __forceinline__ void operator()(const f32x4 (&acc)[2][2][4][2], const Unit& u, int wr, int wc, int fr, int fq, const LAS float* aux) const {
        const int row0 = u.pm * BM + wr * 64 + fr;
        if (mode == 5) {
            if (wr == 0) {
#pragma unroll
                for (int m = 0; m < 2; ++m) { const int row = m * 16 + fr;
                    if (row < 17) {
#pragma unroll
                        for (int bj = 0; bj < 2; ++bj)
#pragma unroll
                            for (int n = 0; n < 2; ++n) *(f32x4*)(outf5 + (size_t)row * ldc + u.pn * BM + bj * HALF + wc * 32 + 8 * fq + 4 * n) = acc[0][bj][m][n]; } }
            }
            return;
        }
        if (mode <= 1) {
            const float s = (u.pn < scale_tiles) ? sc : 1.f;
            const int col0 = u.pn * BM + wc * 32 + 8 * fq;
            f32x4 bv[2][2];
#pragma unroll
            for (int bj = 0; bj < 2; ++bj)
#pragma unroll
                for (int n = 0; n < 2; ++n) bv[bj][n] = rss ? *(const LAS f32x4*)(aux + 256 + wc * 32 + 8 * fq + bj * HALF + 4 * n) : (f32x4){0.f, 0.f, 0.f, 0.f};
#pragma unroll
            for (int ai = 0; ai < 2; ++ai)
#pragma unroll
                for (int m = 0; m < 4; ++m) { const int row = row0 + ai * HALF + m * 16; bf16_t* rowp = O + (size_t)row * ldc + col0;
                    const float rinv = rss ? __builtin_amdgcn_rsqf(aux[wr * 64 + fr + ai * HALF + m * 16] * (1.f / DM) + RMS_EPS) : 1.f;
#pragma unroll
                    for (int bj = 0; bj < 2; ++bj) { f32x4 v0 = acc[ai][bj][m][0] * rinv + bv[bj][0], v1 = acc[ai][bj][m][1] * rinv + bv[bj][1];
                        if (mode == 1) { v0 = __builtin_elementwise_max(v0, (f32x4){0.f, 0.f, 0.f, 0.f}); v1 = __builtin_elementwise_max(v1, (f32x4){0.f, 0.f, 0.f, 0.f}); v0 = v0 * v0; v1 = v1 * v1; }
                        v0 = v0 * s; v1 = v1 * s;
                        u32x4 w; w.x = cvt_pk_bf16(v0[0], v0[1]); w.y = cvt_pk_bf16(v0[2], v0[3]); w.z = cvt_pk_bf16(v1[0], v1[1]); w.w = cvt_pk_bf16(v1[2], v1[3]);
                        *(u32x4*)(rowp + bj * HALF) = w; } }
        } else if (mode == 4) {
            const int col0 = u.pn * BM + wc * 32 + 8 * fq;
            f32x4 cinv[2][2];
#pragma unroll
            for (int bj = 0; bj < 2; ++bj)
#pragma unroll
                for (int n = 0; n < 2; ++n) { const f32x4 q = *(const LAS f32x4*)(aux + 256 + wc * 32 + 8 * fq + bj * HALF + 4 * n);
#pragma unroll
                    for (int e = 0; e < 4; ++e) cinv[bj][n][e] = __builtin_amdgcn_rsqf(q[e] * (1.f / DM) + RMS_EPS); }
#pragma unroll
            for (int ai = 0; ai < 2; ++ai)
#pragma unroll
                for (int m = 0; m < 4; ++m) { const int row = row0 + ai * HALF + m * 16; bf16_t* rowp = O + (size_t)row * ldc + col0; const float bias = aux[wr * 64 + fr + ai * HALF + m * 16];
#pragma unroll
                    for (int bj = 0; bj < 2; ++bj) { const f32x4 v0 = acc[ai][bj][m][0] * cinv[bj][0] + bias, v1 = acc[ai][bj][m][1] * cinv[bj][1] + bias;
                        u32x4 w; w.x = cvt_pk_bf16(v0[0], v0[1]); w.y = cvt_pk_bf16(v0[2], v0[3]); w.z = cvt_pk_bf16(v1[0], v1[1]); w.w = cvt_pk_bf16(v1[2], v1[3]);
                        *(u32x4*)(rowp + bj * HALF) = w; } }
        } else if (mode == 2) {
            if (u.pn < 8) {
                const int col0 = u.pn * HALF + wc * 32 + 8 * fq;
#pragma unroll
                for (int ai = 0; ai < 2; ++ai)
#pragma unroll
                    for (int m = 0; m < 4; ++m) { bf16_t* rowp = O + (size_t)(row0 + ai * HALF + m * 16) * 1024 + col0;
                        const f32x4 v0 = acc[ai][0][m][0] * acc[ai][1][m][0], v1 = acc[ai][0][m][1] * acc[ai][1][m][1];
                        u32x4 w; w.x = cvt_pk_bf16(v0[0], v0[1]); w.y = cvt_pk_bf16(v0[2], v0[3]); w.z = cvt_pk_bf16(v1[0], v1[1]); w.w = cvt_pk_bf16(v1[2], v1[3]);
                        *(u32x4*)rowp = w; }
            } else {
                const int col0 = (u.pn - 8) * BM + wc * 32 + 8 * fq;
#pragma unroll
                for (int ai = 0; ai < 2; ++ai)
#pragma unroll
                    for (int m = 0; m < 4; ++m) { bf16_t* rowp = O2 + (size_t)(row0 + ai * HALF + m * 16) * 1024 + col0;
#pragma unroll
                        for (int bj = 0; bj < 2; ++bj) { const f32x4 v0 = acc[ai][bj][m][0], v1 = acc[ai][bj][m][1];
                            u32x4 w; w.x = cvt_pk_bf16(v0[0], v0[1]); w.y = cvt_pk_bf16(v0[2], v0[3]); w.z = cvt_pk_bf16(v1[0], v1[1]); w.w = cvt_pk_bf16(v1[2], v1[3]);
                            *(u32x4*)(rowp + bj * HALF) = w; } }
            }
        } else {
            const bool lat = u.pm < (MLAT / BM);
            const int prow = (lat ? u.pm : u.pm - MLAT / BM) * BM + wr * 64 + fr;
            const float* in = lat ? inLat : inCtx; const bf16_t* inb = lat ? inbLat : inbCtx; bf16_t* out = lat ? outLat : outCtx;
            const int brow = lat ? (u.pm >> 3) : 16;
            const float* gp = gate + (size_t)brow * 6144;
            const int col0 = u.pn * BM + wc * 32 + 8 * fq;
            f32x4 gv[2][2], gm[2][2];
#pragma unroll
            for (int bj = 0; bj < 2; ++bj)
#pragma unroll
                for (int n = 0; n < 2; ++n) { gv[bj][n] = *(const f32x4*)(gp + col0 + bj * HALF + 4 * n);
                    gm[bj][n] = An ? *(const f32x4*)(gn + col0 + bj * HALF + 4 * n) * (*(const f32x4*)(scn + (size_t)brow * 6144 + col0 + bj * HALF + 4 * n) + 1.0f) : (f32x4){0.f, 0.f, 0.f, 0.f}; }
#pragma unroll
            for (int ai = 0; ai < 2; ++ai)
#pragma unroll
                for (int m = 0; m < 4; ++m) { const size_t off = (size_t)(prow + ai * HALF + m * 16) * 1024 + col0; float ss = 0.f;
#pragma unroll
                    for (int bj = 0; bj < 2; ++bj) { f32x4 xo[2];
                        if (in) { xo[0] = *(const f32x4*)(in + off + bj * HALF); xo[1] = *(const f32x4*)(in + off + bj * HALF + 4); }
                        else { const u32x4 xw = *(const u32x4*)(inb + off + bj * HALF);
                            xo[0] = (f32x4){__builtin_bit_cast(float, xw.x << 16), __builtin_bit_cast(float, xw.x & 0xffff0000u), __builtin_bit_cast(float, xw.y << 16), __builtin_bit_cast(float, xw.y & 0xffff0000u)};
                            xo[1] = (f32x4){__builtin_bit_cast(float, xw.z << 16), __builtin_bit_cast(float, xw.z & 0xffff0000u), __builtin_bit_cast(float, xw.w << 16), __builtin_bit_cast(float, xw.w & 0xffff0000u)}; }
#pragma unroll
                        for (int n = 0; n < 2; ++n) { xo[n] = xo[n] + gv[bj][n] * acc[ai][bj][m][n];
                            ss += (xo[n][0] * xo[n][0] + xo[n][1] * xo[n][1]) + (xo[n][2] * xo[n][2] + xo[n][3] * xo[n][3]); }
                        { u32x4 w; w.x = cvt_pk_bf16(xo[0][0], xo[0][1]); w.y = cvt_pk_bf16(xo[0][2], xo[0][3]); w.z = cvt_pk_bf16(xo[1][0], xo[1][1]); w.w = cvt_pk_bf16(xo[1][2], xo[1][3]);
                          *(u32x4*)(out + off + bj * HALF) = w; }
                        if (An) { const f32x4 a0 = xo[0] * gm[bj][0], a1 = xo[1] * gm[bj][1];
                            u32x4 w; w.x = cvt_pk_bf16(a0[0], a0[1]); w.y = cvt_pk_bf16(a0[2], a0[3]); w.z = cvt_pk_bf16(a1[0], a1[1]); w.w = cvt_pk_bf16(a1[2], a1[3]);
                            *(u32x4*)(An + (size_t)(row0 + ai * HALF + m * 16) * 1024 + col0 + bj * HALF) = w; } }
                    if (rssn) { ss = xsum16(ss); if (fq == 0) atomicAdd(rssn + row0 + ai * HALF + m * 16, ss); }
                    if (m == 3) asm volatile("" ::: "memory"); }
        }
    }
};

template <class Epi, class Sched, bool ALIGN_EPI = false, bool SP2 = false>
__device__ __forceinline__ void gemm_phase(LAS unsigned char* lds, const Gemm g, const Sched& S, const Epi& E) {
    int tid = threadIdx.x; asm volatile("" : "+v"(tid));
    const int wid = __builtin_amdgcn_readfirstlane(tid >> 6), lane = tid & 63, wr = wid >> 2, wc = wid & 3, fr = lane & 15, fq = lane >> 4;
    const int K = g.K, nt = K / BK;
    unsigned voffA[2], voffB[2];
#pragma unroll
    for (int i = 0; i < 2; ++i) { int R, C; stage_rc(tid * 16 + i * 8192, R, C); const int Rb = (R & ~31) + perm32(R & 31);
        voffA[i] = (unsigned)(R * K + C) * 2u; voffB[i] = (unsigned)(Rb * K + C) * 2u; }
    const size_t kstep = (size_t)(BK * 2);
    const size_t hstep = (size_t)HALF * K * 2;
    const size_t tstep = 2 * hstep;
    const unsigned ldsw = (unsigned)wid * 1024u;
    const int aoff = lds_byte(wr * 64 + fr, fq * 8), boff = lds_byte(wc * 32 + fr, fq * 8);
#define PG8_SA(b, h) (((b) * 2 + (h)) * HTB)
#define PG8_SB(b, h) ((4 + (b) * 2 + (h)) * HTB)
#define PG8_STAGE(bufoff, gbase, voff) do { _Pragma("unroll") for (int _i = 0; _i < 2; ++_i) \
        __builtin_amdgcn_global_load_lds((const unsigned*)((const char*)(gbase) + (voff)[_i]), (LAS unsigned*)(lds + (bufoff) + ldsw + _i * 8192), 16, 0, 0); } while (0)
#define PG8_LDA(dst, b, h) do { _Pragma("unroll") for (int m = 0; m < 4; ++m) _Pragma("unroll") for (int k = 0; k < 2; ++k) dst[m][k] = *(const LAS bf16x8*)(lds + PG8_SA(b, h) + aoff + m * 2048 + k * 1024); } while (0)
#define PG8_LDB(dst, b, h) do { _Pragma("unroll") for (int n = 0; n < 2; ++n) _Pragma("unroll") for (int k = 0; k < 2; ++k) dst[n][k] = *(const LAS bf16x8*)(lds + PG8_SB(b, h) + boff + n * 2048 + k * 1024); } while (0)
#define PG8_MMA(ai, bj, At, Bt) do { __builtin_amdgcn_s_setprio(1); _Pragma("unroll") for (int m = 0; m < 4; ++m) _Pragma("unroll") for (int n = 0; n < 2; ++n) _Pragma("unroll") for (int k = 0; k < 2; ++k) \
        acc[ai][bj][m][n] = __builtin_amdgcn_mfma_f32_16x16x32_bf16(Bt[n][k], At[m][k], acc[ai][bj][m][n], 0, 0, 0); __builtin_amdgcn_s_setprio(0); } while (0)
#define PG8_WAIT_V(n) asm volatile("s_waitcnt vmcnt(" #n ")" ::: "memory")
#define PG8_WAIT_L(n) asm volatile("s_waitcnt lgkmcnt(" #n ")" ::: "memory")
#define PG8_BAR __builtin_amdgcn_s_barrier()
#define PG8_SCHED __builtin_amdgcn_sched_barrier(0)
    Unit cur, nxt; int ui = 0;
    if (!S.next(0, cur)) return;
    constexpr int AUX_OFF = STAGE_BYTES + 1024;
    const bool use_aux = E.has_aux();
    if (use_aux) __builtin_amdgcn_global_load_lds((const unsigned*)E.aux_src(cur, wid, lane), (LAS unsigned*)(lds + AUX_OFF + wid * 256), 4, 0, 0);
    f32x4 acc[2][2][4][2];
#pragma unroll
    for (int a = 0; a < 2; ++a)
#pragma unroll
        for (int b = 0; b < 2; ++b)
#pragma unroll
            for (int m = 0; m < 4; ++m)
#pragma unroll
                for (int n = 0; n < 2; ++n) acc[a][b][m][n] = (f32x4){0.f, 0.f, 0.f, 0.f};
    bf16x8 At[4][2], B0[2][2], B1[2][2];
    const char* cA = (const char*)g.A + (size_t)cur.pm * tstep; const char* cB = (const char*)g.Bt + (size_t)cur.pn * tstep;
    if constexpr (SP2) {
        PG8_STAGE(PG8_SB(0, 0), cB, voffB); PG8_STAGE(PG8_SB(0, 1), cB + hstep, voffB); PG8_STAGE(PG8_SA(0, 0), cA, voffA); PG8_STAGE(PG8_SA(0, 1), cA + hstep, voffA);
        if (wr == 1) PG8_BAR;
        PG8_WAIT_V(2); PG8_BAR;
        PG8_STAGE(PG8_SB(1, 0), cB + kstep, voffB); PG8_STAGE(PG8_SA(1, 0), cA + kstep, voffA); PG8_STAGE(PG8_SB(1, 1), cB + hstep + kstep, voffB);
        PG8_WAIT_V(6); PG8_BAR;
    } else {
        PG8_STAGE(PG8_SB(0, 0), cB, voffB); PG8_STAGE(PG8_SA(0, 0), cA, voffA); PG8_STAGE(PG8_SB(0, 1), cB + hstep, voffB); PG8_STAGE(PG8_SA(0, 1), cA + hstep, voffA);
        if (wr == 1) PG8_BAR;
        PG8_WAIT_V(4); PG8_BAR;
        PG8_STAGE(PG8_SB(1, 0), cB + kstep, voffB); PG8_STAGE(PG8_SA(1, 0), cA + kstep, voffA); PG8_STAGE(PG8_SB(1, 1), cB + hstep + kstep, voffB);
        PG8_WAIT_V(6); PG8_BAR;
    }
    for (;;) {
        const bool has_next = S.next(ui + 1, nxt);
        const char* nA = has_next ? (const char*)g.A + (size_t)nxt.pm * tstep : cA; const char* nB = has_next ? (const char*)g.Bt + (size_t)nxt.pn * tstep : cB;
        for (int t = 0; t < nt; t += 2) {
            const bool last = (t == nt - 2);
            const char* a1 = cA + (size_t)(t + 1) * kstep;
            const char* a2 = last ? nA : cA + (size_t)(t + 2) * kstep; const char* b2 = last ? nB : cB + (size_t)(t + 2) * kstep;
            const char* a3 = a2 + kstep; const char* b3 = b2 + kstep;
            if constexpr (SP2) {
            PG8_LDB(B0, 0, 0); PG8_LDB(B1, 0, 1); PG8_SCHED; PG8_LDA(At, 0, 0); PG8_STAGE(PG8_SA(1, 1), a1 + hstep, voffA);
            PG8_WAIT_V(8); PG8_WAIT_L(0); PG8_BAR; PG8_MMA(0, 0, At, B0); PG8_MMA(0, 1, At, B1); PG8_BAR; PG8_SCHED;
            PG8_LDA(At, 0, 1); PG8_STAGE(PG8_SB(0, 0), b2, voffB); PG8_STAGE(PG8_SB(0, 1), b2 + hstep, voffB); PG8_STAGE(PG8_SA(0, 0), a2, voffA);
            PG8_WAIT_V(8); PG8_WAIT_L(0); PG8_BAR; PG8_MMA(1, 0, At, B0); PG8_MMA(1, 1, At, B1); PG8_BAR; PG8_SCHED;
            PG8_LDB(B0, 1, 0); PG8_LDB(B1, 1, 1); PG8_SCHED; PG8_LDA(At, 1, 0); PG8_STAGE(PG8_SA(0, 1), a2 + hstep, voffA);
            PG8_WAIT_V(8); PG8_WAIT_L(0); PG8_BAR; PG8_MMA(0, 0, At, B0); PG8_MMA(0, 1, At, B1); PG8_BAR; PG8_SCHED;
            PG8_LDA(At, 1, 1); PG8_STAGE(PG8_SB(1, 0), b3, voffB); PG8_STAGE(PG8_SB(1, 1), b3 + hstep, voffB); PG8_STAGE(PG8_SA(1, 0), a3, voffA);
            PG8_WAIT_V(8); PG8_WAIT_L(0); PG8_BAR; PG8_MMA(1, 0, At, B0); PG8_MMA(1, 1, At, B1); PG8_BAR; PG8_SCHED;
            } else {
            PG8_LDB(B0, 0, 0); PG8_SCHED; PG8_LDA(At, 0, 0); PG8_STAGE(PG8_SA(1, 1), a1 + hstep, voffA);
            PG8_WAIT_L(8); PG8_BAR; PG8_WAIT_L(0); PG8_MMA(0, 0, At, B0); PG8_BAR; PG8_SCHED;
            PG8_LDB(B1, 0, 1); PG8_STAGE(PG8_SB(0, 0), b2, voffB);
            PG8_BAR; PG8_WAIT_L(0); PG8_MMA(0, 1, At, B1); PG8_BAR;
            PG8_LDA(At, 0, 1); PG8_STAGE(PG8_SA(0, 0), a2, voffA);
            PG8_BAR; PG8_WAIT_L(0); PG8_MMA(1, 0, At, B0); PG8_BAR; PG8_SCHED;
            PG8_STAGE(PG8_SB(0, 1), b2 + hstep, voffB);
            PG8_WAIT_V(6); PG8_BAR; PG8_MMA(1, 1, At, B1); PG8_BAR;
            PG8_LDB(B0, 1, 0); PG8_SCHED; PG8_LDA(At, 1, 0); PG8_STAGE(PG8_SA(0, 1), a2 + hstep, voffA);
            PG8_WAIT_L(8); PG8_BAR; PG8_WAIT_L(0); PG8_MMA(0, 0, At, B0); PG8_BAR; PG8_SCHED;
            PG8_LDB(B1, 1, 1); PG8_STAGE(PG8_SB(1, 0), b3, voffB);
            PG8_BAR; PG8_WAIT_L(0); PG8_MMA(0, 1, At, B1); PG8_BAR;
            PG8_LDA(At, 1, 1); PG8_STAGE(PG8_SA(1, 0), a3, voffA);
            PG8_BAR; PG8_WAIT_L(0); PG8_MMA(1, 0, At, B0); PG8_BAR; PG8_SCHED;
            PG8_STAGE(PG8_SB(1, 1), b3 + hstep, voffB);
            PG8_WAIT_V(6); PG8_BAR; PG8_MMA(1, 1, At, B1); PG8_BAR;
            }
        }
        if constexpr (ALIGN_EPI) { if (wr == 0) PG8_BAR; }
        E(acc, cur, wr, wc, fr, fq, (const LAS float*)(lds + AUX_OFF + (ui & 1) * 2048));
        if (use_aux && has_next) __builtin_amdgcn_global_load_lds((const unsigned*)E.aux_src(nxt, wid, lane), (LAS unsigned*)(lds + AUX_OFF + ((ui + 1) & 1) * 2048 + wid * 256), 4, 0, 0);
        if (!has_next) break;
#pragma unroll
        for (int a = 0; a < 2; ++a)
#pragma unroll
            for (int b = 0; b < 2; ++b)
#pragma unroll
                for (int m = 0; m < 4; ++m)
#pragma unroll
                    for (int n = 0; n < 2; ++n) acc[a][b][m][n] = (f32x4){0.f, 0.f, 0.f, 0.f};
        cur = nxt; cA = nA; cB = nB; ++ui;
        if constexpr (ALIGN_EPI) { if (wr == 1) PG8_BAR; }
    }
    PG8_WAIT_V(0);
    if constexpr (!ALIGN_EPI) { if (wr == 0) PG8_BAR; }
    PG8_BAR;
#undef PG8_SA
#undef PG8_SB
#undef PG8_STAGE
#undef PG8_LDA
#undef PG8_LDB
#undef PG8_MMA
#undef PG8_WAIT_V
#undef PG8_WAIT_L
#undef PG8_BAR
#undef PG8_SCHED
}
}

__device__ __forceinline__ unsigned f2bf(float f) { unsigned u = __builtin_bit_cast(unsigned, f); return (u + 0x7fffu + ((u >> 16) & 1u)) >> 16; }
__device__ __forceinline__ unsigned pk2(float lo, float hi) { return pg8::cvt_pk_bf16(lo, hi); }
__device__ __forceinline__ float bf_lo(unsigned w) { return __builtin_bit_cast(float, w << 16); }
__device__ __forceinline__ float bf_hi(unsigned w) { return __builtin_bit_cast(float, w & 0xffff0000u); }
__device__ __forceinline__ float wave_sum(float v) {
#pragma unroll
    for (int o = 1; o < 64; o <<= 1) v += __shfl_xor(v, o);
    return v;
}
#define LDS_WAIT() asm volatile("s_waitcnt lgkmcnt(0)" ::: "memory")

struct Args {
    const float* in[17];
    float* out; unsigned char* ws;
    int ph_lo, ph_hi;
};

__device__ __forceinline__ void transpose_item(const float* W, int K, int N, bf16_t* WT, int cinmap, LAS float* scr, int item, int lane) {
    const int nblk = N / 32, kb = item / nblk, nb = item % nblk, k0 = 64 * kb, n0 = 32 * nb;
    float wv[32];
#pragma unroll
    for (int i = 0; i < 32; ++i) { const int kk = 2 * i + (lane >> 5); wv[i] = W[(size_t)(k0 + kk) * N + n0 + (lane & 31)]; }
#pragma unroll
    for (int i = 0; i < 32; ++i) { const int kk = 2 * i + (lane >> 5); scr[kk * 33 + (lane & 31)] = wv[i]; }
    LDS_WAIT(); asm volatile("" ::: "memory");
    int d0 = n0;
    if (cinmap) { if (n0 < 1024) d0 = 2048 + n0; else if (n0 < 2048) { const int ch = n0 - 1024; d0 = (ch >> 7) * 256 + (ch & 127); } else { const int ch = n0 - 2048; d0 = (ch >> 7) * 256 + 128 + (ch & 127); } }
    const int c = lane & 7;
#pragma unroll
    for (int j = 0; j < 4; ++j) { const int n = (lane >> 3) + 8 * j; const LAS float* s = scr + (8 * c) * 33 + n;
        u32x4 o; o.x = pk2(s[0 * 33], s[1 * 33]); o.y = pk2(s[2 * 33], s[3 * 33]); o.z = pk2(s[4 * 33], s[5 * 33]); o.w = pk2(s[6 * 33], s[7 * 33]);
        *(u32x4*)(WT + (size_t)(d0 + n) * K + k0 + 8 * c) = o; }
    LDS_WAIT(); asm volatile("" ::: "memory");
}

__device__ __forceinline__ void gemv17_unit(const LAS float* S, LAS float* red, const float* W, int ldw, int n0, const float* bias, float* out, int ldo, int tid, int lane, int wave) {
    const float* Wp = W + n0 + (lane & 31);
    const int kbase = wave * 128 + (lane >> 5);
    float acc[17];
#pragma unroll
    for (int r = 0; r < 17; ++r) acc[r] = 0.f;
#pragma unroll 1
    for (int ib = 0; ib < 64; ib += 32) {
        float wv[32];
#pragma unroll
        for (int i = 0; i < 32; ++i) wv[i] = Wp[(size_t)(kbase + 2 * (ib + i)) * ldw];
#pragma unroll
        for (int i = 0; i < 32; ++i) { const int k = kbase + 2 * (ib + i);
#pragma unroll
            for (int r = 0; r < 17; ++r) acc[r] += S[r * 1024 + k] * wv[i]; }
    }
#pragma unroll
    for (int r = 0; r < 17; ++r) acc[r] += __shfl_xor(acc[r], 32);
    if (lane < 32) {
#pragma unroll
        for (int r = 0; r < 17; ++r) red[(wave * 17 + r) * 32 + lane] = acc[r]; }
    __syncthreads();
    for (int o = tid; o < 17 * 32; o += 512) { const int r = o >> 5, c2 = o & 31; float s = bias ? bias[n0 + c2] : 0.f;
#pragma unroll
        for (int w = 0; w < 8; ++w) s += red[(w * 17 + r) * 32 + c2];
        out[(size_t)r * ldo + n0 + c2] = s; }
    __syncthreads();
}

__device__ __forceinline__ void p0_phase(const Args& a, LAS unsigned char* lds, int tid, int lane, int wave, int bid, int G) {
    { float* rss = (float*)(a.ws + WS_RSS); for (int i = bid * 512 + tid; i < 4 * MALL; i += G * 512) rss[i] = 0.f; }
    {
        LAS float* S = (LAS float*)lds;
        LAS float* red = (LAS float*)(lds + 17 * 1024 * 4);
        const float* c = a.in[1]; const float* cc = a.in[3]; const float* ada_w = a.in[6]; const float* ada_b = a.in[7];
        float* mod = (float*)(a.ws + WS_MOD);
        for (int i = tid; i < 17 * 1024; i += 512) { const float v = i < 16384 ? c[i] : cc[i - 16384]; S[i] = v / (1.f + __expf(-v)); }
        __syncthreads();
        for (int unit = bid; unit < 384; unit += G) {
            const int l = unit / 192, n0 = (unit % 192) * 32;
            gemv17_unit(S, red, ada_w + (size_t)l * 1024 * 6144, 6144, n0, ada_b + l * 6144, mod + (size_t)l * 17 * 6144, 6144, tid, lane, wave);
        }
    }
    {
        LAS float* scr = (LAS float*)(lds + wave * 16384);
        const int gw = bid * 8 + wave, NGW = G * 8;
        constexpr int I_CIN = 16 * 96, I_SQ = 16 * 32, I_UP = 16 * 128, I_DN = 64 * 32;
        constexpr int NITEMS = 2 * I_CIN + 2 * I_SQ + 2 * I_UP + 2 * I_DN;
        bf16_t* ws16 = (bf16_t*)a.ws;
        for (int it = gw; it < NITEMS; it += NGW) {
            int r = it;
            if (r < I_CIN) { transpose_item(a.in[8], 1024, 3072, (bf16_t*)(a.ws + WS_WCIN), 1, scr, r, lane); continue; } r -= I_CIN;
            if (r < I_CIN) { transpose_item(a.in[11], 1024, 3072, (bf16_t*)(a.ws + WS_WQKV), 0, scr, r, lane); continue; } r -= I_CIN;
            if (r < I_SQ) { transpose_item(a.in[10], 1024, 1024, (bf16_t*)(a.ws + WS_WCOUT), 0, scr, r, lane); continue; } r -= I_SQ;
            if (r < I_SQ) { transpose_item(a.in[13], 1024, 1024, (bf16_t*)(a.ws + WS_WAO), 0, scr, r, lane); continue; } r -= I_SQ;
            if (r < 2 * I_UP) { const int l = r / I_UP; transpose_item(a.in[14] + (size_t)l * 1024 * 4096, 1024, 4096, (bf16_t*)(a.ws + WS_W1) + (size_t)l * 4096 * 1024, 0, scr, r % I_UP, lane); continue; } r -= 2 * I_UP;
            { const int l = r / I_DN; transpose_item(a.in[15] + (size_t)l * 4096 * 1024, 4096, 1024, (bf16_t*)(a.ws + WS_W2) + (size_t)l * 1024 * 4096, 0, scr, r % I_DN, lane); }
        }
        (void)ws16;
    }
}

__device__ __forceinline__ void shw_jobs(const Args& a, LAS unsigned char* lds, int tid, int lane, int wave, int bid, int G) {
    LAS float* S = (LAS float*)lds; LAS float* red = (LAS float*)(lds + 17 * 1024 * 4);
    const float* mod = (const float*)(a.ws + WS_MOD); float* shw = (float*)(a.ws + WS_SHW);
    __syncthreads();
#pragma unroll 1
    for (int job = 0; job < 3; ++job) {
        const int N = (job == 1) ? 3072 : 4096, nunits = N / 32, off = (job == 0) ? 0 : (job == 1) ? 128 : 224;
        const float* W = (job == 0) ? a.in[14] : (job == 1) ? a.in[11] : a.in[14] + (size_t)1024 * 4096;
        const float* sh = mod + (job == 0 ? 3 * 1024 : job == 1 ? 17 * 6144 : 17 * 6144 + 3 * 1024);
        float* out = shw + (job == 0 ? 0 : job == 1 ? 17 * 4096 : 17 * 4096 + 17 * 3072);
        int unit = bid - off; if (unit < 0) unit += G;
        if (unit < nunits) {
            for (int i = tid; i < 17 * 1024; i += 512) S[i] = sh[(size_t)(i >> 10) * 6144 + (i & 1023)];
            __syncthreads();
            for (; unit < nunits; unit += G) gemv17_unit(S, red, W, N, unit * 32, nullptr, out, N, tid, lane, wave);
        }
    }
}

__device__ __forceinline__ void norm_phase(const float* xlat, const float* xctx, int nrows, const float* g, const float* modl, int sh_chunk, int sc_chunk,
                                           bf16_t* H, float* outf, const float* rssf, int gw, int NGW, int lane) {
    constexpr int R = 4;
    const int ngroups = nrows / R;
    for (int grp = gw; grp < ngroups; grp += NGW) {
        f32x4 v[R][4]; float inv[R];
#pragma unroll
        for (int q = 0; q < R; ++q) { const int row = grp * R + q; const bool lat = row < MLAT;
            const f32x4* xr = (const f32x4*)(lat ? xlat + (size_t)row * DM : xctx + (size_t)(row - MLAT) * DM) + lane;
#pragma unroll
            for (int jx = 0; jx < 4; ++jx) v[q][jx] = xr[64 * jx]; }
        if (rssf) {
#pragma unroll
            for (int q = 0; q < R; ++q) inv[q] = rsqrtf(rssf[grp * R + q] * (1.f / DM) + RMS_EPS);
        } else {
            float s[R];
#pragma unroll
            for (int q = 0; q < R; ++q) { s[q] = 0.f;
#pragma unroll
                for (int jx = 0; jx < 4; ++jx) s[q] += (v[q][jx].x * v[q][jx].x + v[q][jx].y * v[q][jx].y) + (v[q][jx].z * v[q][jx].z + v[q][jx].w * v[q][jx].w); }
#pragma unroll
            for (int o = 1; o < 64; o <<= 1) {
#pragma unroll
                for (int q = 0; q < R; ++q) s[q] += __shfl_xor(s[q], o); }
#pragma unroll
            for (int q = 0; q < R; ++q) inv[q] = rsqrtf(s[q] * (1.f / DM) + RMS_EPS);
        }
#pragma unroll
        for (int q = 0; q < R; ++q) { const int row = grp * R + q; const bool lat = row < MLAT;
            if (modl) {
                const float* mr = modl + (size_t)(lat ? (row >> 11) : 16) * 6144;
                unsigned long long* o8 = (unsigned long long*)(H + (size_t)row * DM) + lane;
#pragma unroll
                for (int jx = 0; jx < 4; ++jx) { const int c = 4 * lane + 256 * jx;
                    const f32x4 gg = *(const f32x4*)(g + c), sc = *(const f32x4*)(mr + sc_chunk * 1024 + c), sh = *(const f32x4*)(mr + sh_chunk * 1024 + c);
                    const f32x4 o = (v[q][jx] * inv[q] * gg) * (sc + 1.0f) + sh;
                    o8[64 * jx] = (unsigned long long)pk2(o.x, o.y) | ((unsigned long long)pk2(o.z, o.w) << 32); }
            } else {
                f32x4* orow = (f32x4*)(outf + (size_t)row * DM) + lane;
#pragma unroll
                for (int jx = 0; jx < 4; ++jx) { const int c = 4 * lane + 256 * jx; const f32x4 gg = *(const f32x4*)(g + c); orow[64 * jx] = v[q][jx] * inv[q] * gg; }
            }
        }
    }
}

__device__ __forceinline__ void final_phase(const bf16_t* xb, const float* rssf, const float* g, float* out, int gw, int NGW, int lane) {
    constexpr int R = 4;
    for (int grp = gw; grp < MLAT / R; grp += NGW) {
        u32x4 v[R][2];
#pragma unroll
        for (int q = 0; q < R; ++q)
#pragma unroll
            for (int jx = 0; jx < 2; ++jx) v[q][jx] = *(const u32x4*)(xb + (size_t)(grp * R + q) * DM + jx * 512 + lane * 8);
#pragma unroll
        for (int q = 0; q < R; ++q) { const int row = grp * R + q; const float inv = rsqrtf(rssf[row] * (1.f / DM) + RMS_EPS);
#pragma unroll
            for (int jx = 0; jx < 2; ++jx) { const int c = jx * 512 + lane * 8; const f32x4 g0 = *(const f32x4*)(g + c), g1 = *(const f32x4*)(g + c + 4); const u32x4 w = v[q][jx];
                const f32x4 x0 = (f32x4){bf_lo(w.x), bf_hi(w.x), bf_lo(w.y), bf_hi(w.y)}, x1 = (f32x4){bf_lo(w.z), bf_hi(w.z), bf_lo(w.w), bf_hi(w.w)};
                *(f32x4*)(out + (size_t)row * DM + c) = x0 * inv * g0; *(f32x4*)(out + (size_t)row * DM + c + 4) = x1 * inv * g1; } }
    }
}

__device__ __forceinline__ void unpack8(const u32x4 w, float (&f)[8]) { f[0] = bf_lo(w.x); f[1] = bf_hi(w.x); f[2] = bf_lo(w.y); f[3] = bf_hi(w.y); f[4] = bf_lo(w.z); f[5] = bf_hi(w.z); f[6] = bf_lo(w.w); f[7] = bf_hi(w.w); }
__device__ __forceinline__ void unpack4(const u32x2 w, float (&f)[4]) { f[0] = bf_lo(w.x); f[1] = bf_hi(w.x); f[2] = bf_lo(w.y); f[3] = bf_hi(w.y); }
__device__ __forceinline__ void convgate_phase(const bf16_t* U, const bf16_t* Bg, const float* cw, bf16_t* Gout, int gw, int NGW, int lane) {
    constexpr int RC = 8;
    for (int item = gw; item < (MALL / RC) * 4; item += NGW) {
        const int chunk = item >> 2, strip = item & 3, t0 = chunk * RC, ch = strip * 256 + lane * 4;
        const int tl = t0 < MLAT ? (t0 & (SEQ - 1)) : ((t0 - MLAT) & (CTXL - 1)); const int sl = t0 < MLAT ? SEQ : CTXL;
        const bool first = (tl == 0), lastc = (tl + RC == sl);
        const f32x4 w0 = *(const f32x4*)(cw + ch), w1 = *(const f32x4*)(cw + 1024 + ch), w2 = *(const f32x4*)(cw + 2048 + ch);
        const bf16_t* up = U + (size_t)t0 * DM + ch; const bf16_t* bp = Bg + (size_t)t0 * DM + ch; bf16_t* gp = Gout + (size_t)t0 * DM + ch;
        const u32x2 zero = (u32x2){0u, 0u};
        u32x2 uw[RC + 2], bw[RC];
        uw[0] = first ? zero : *(const u32x2*)(up - DM);
#pragma unroll
        for (int t = 0; t < RC; ++t) { uw[t + 1] = *(const u32x2*)(up + (size_t)t * DM); bw[t] = *(const u32x2*)(bp + (size_t)t * DM); }
        uw[RC + 1] = lastc ? zero : *(const u32x2*)(up + (size_t)RC * DM);
#pragma unroll
        for (int t = 0; t < RC; ++t) {
            float pf[4], cf[4], nf[4], bf[4];
            unpack4(uw[t], pf); unpack4(uw[t + 1], cf); unpack4(uw[t + 2], nf); unpack4(bw[t], bf);
            float o[4];
#pragma unroll
            for (int e = 0; e < 4; ++e) o[e] = bf[e] * (w0[e] * pf[e] + w1[e] * cf[e] + w2[e] * nf[e]);
            u32x2 ow; ow.x = pk2(o[0], o[1]); ow.y = pk2(o[2], o[3]);
            *(u32x2*)(gp + (size_t)t * DM) = ow;
        }
    }
}

struct KBuf { bf16x8 k[2][2]; };
struct VBuf { bf16x8 v[4]; };
constexpr int VT_LD = MALL;
struct KVOff { unsigned k0, v0; };
typedef __amdgpu_buffer_rsrc_t rsrc_t;
__device__ __forceinline__ bf16x8 bload(rsrc_t r, unsigned voff, unsigned soff) { return __builtin_bit_cast(bf16x8, __builtin_amdgcn_raw_buffer_load_b128(r, (int)voff, (int)soff, 0)); }
__device__ __forceinline__ void k_load(KBuf& B, rsrc_t rk, const KVOff& f, int kt) {
    const unsigned sk = (unsigned)kt * 4096u;
    B.k[0][0] = bload(rk, f.k0, sk); B.k[0][1] = bload(rk, f.k0 + 64u, sk);
    B.k[1][0] = bload(rk, f.k0, sk + 16384u); B.k[1][1] = bload(rk, f.k0 + 64u, sk + 16384u);
}
__device__ __forceinline__ void v_load(VBuf& B, rsrc_t rv, const KVOff& f, int kt) {
    const unsigned sv = (unsigned)kt * 2u;
#pragma unroll
    for (int d = 0; d < 4; ++d) B.v[d] = bload(rv, f.v0, sv + (unsigned)d * (16u * VT_LD * 2u));
}
__device__ __forceinline__ float red16_max(float x) {
#if __has_builtin(__builtin_amdgcn_permlane16_swap)
    auto r = __builtin_amdgcn_permlane16_swap(__float_as_uint(x), __float_as_uint(x), false, false);
    x = fmaxf(__uint_as_float(r[0]), __uint_as_float(r[1]));
#else
    x = fmaxf(x, __shfl_xor(x, 16));
#endif
    auto q = __builtin_amdgcn_permlane32_swap(__float_as_uint(x), __float_as_uint(x), false, false);
    return fmaxf(__uint_as_float(q[0]), __uint_as_float(q[1]));
}
__device__ __forceinline__ float red16_sum(float x) {
#if __has_builtin(__builtin_amdgcn_permlane16_swap)
    auto r = __builtin_amdgcn_permlane16_swap(__float_as_uint(x), __float_as_uint(x), false, false);
    x = __uint_as_float(r[0]) + __uint_as_float(r[1]);
#else
    x = x + __shfl_xor(x, 16);
#endif
    auto q = __builtin_amdgcn_permlane32_swap(__float_as_uint(x), __float_as_uint(x), false, false);
    return __uint_as_float(q[0]) + __uint_as_float(q[1]);
}
__device__ __forceinline__ void attn_step(const KBuf& B, const VBuf& V, const bf16x8 (&qf)[2], f32x4 c0, f32x4 c1, float& m, float& l, f32x4 (&o)[4]) {
    f32x4 s0 = __builtin_amdgcn_mfma_f32_16x16x32_bf16(B.k[0][0], qf[0], c0, 0, 0, 0);
    f32x4 s1 = __builtin_amdgcn_mfma_f32_16x16x32_bf16(B.k[1][0], qf[0], c1, 0, 0, 0);
    s0 = __builtin_amdgcn_mfma_f32_16x16x32_bf16(B.k[0][1], qf[1], s0, 0, 0, 0);
    s1 = __builtin_amdgcn_mfma_f32_16x16x32_bf16(B.k[1][1], qf[1], s1, 0, 0, 0);
    float mx = fmaxf(fmaxf(fmaxf(s0[0], s0[1]), fmaxf(s0[2], s0[3])), fmaxf(fmaxf(s1[0], s1[1]), fmaxf(s1[2], s1[3])));
    mx = red16_max(mx);
    const float mn = fmaxf(m, mx);
    const float alpha = __builtin_amdgcn_exp2f(m - mn);
    m = mn;
    f32x4 p0, p1;
#pragma unroll
    for (int e = 0; e < 4; ++e) { p0[e] = __builtin_amdgcn_exp2f(s0[e] - mn); p1[e] = __builtin_amdgcn_exp2f(s1[e] - mn); }
    l = l * alpha + ((p0[0] + p0[1]) + (p0[2] + p0[3])) + ((p1[0] + p1[1]) + (p1[2] + p1[3]));
    u32x4 pw; pw.x = pk2(p0[0], p0[1]); pw.y = pk2(p0[2], p0[3]); pw.z = pk2(p1[0], p1[1]); pw.w = pk2(p1[2], p1[3]);
    const bf16x8 pf = __builtin_bit_cast(bf16x8, pw);
#pragma unroll
    for (int d = 0; d < 4; ++d) { o[d] = o[d] * alpha; o[d] = __builtin_amdgcn_mfma_f32_16x16x32_bf16(V.v[d], pf, o[d], 0, 0, 0); }
}

__device__ __forceinline__ void attn_step2(const KBuf& KA, const VBuf& VA, const KBuf& KB, const VBuf& VB, const bf16x8 (&qf)[2], f32x4 c0, f32x4 c1, float& m, float& l, f32x4 (&o)[4]) {
    const f32x4 z4 = (f32x4){0.f, 0.f, 0.f, 0.f};
    f32x4 a0 = __builtin_amdgcn_mfma_f32_16x16x32_bf16(KA.k[0][0], qf[0], z4, 0, 0, 0);
    f32x4 a1 = __builtin_amdgcn_mfma_f32_16x16x32_bf16(KA.k[1][0], qf[0], z4, 0, 0, 0);
    f32x4 b0 = __builtin_amdgcn_mfma_f32_16x16x32_bf16(KB.k[0][0], qf[0], c0, 0, 0, 0);
    f32x4 b1 = __builtin_amdgcn_mfma_f32_16x16x32_bf16(KB.k[1][0], qf[0], c1, 0, 0, 0);
    a0 = __builtin_amdgcn_mfma_f32_16x16x32_bf16(KA.k[0][1], qf[1], a0, 0, 0, 0);
    a1 = __builtin_amdgcn_mfma_f32_16x16x32_bf16(KA.k[1][1], qf[1], a1, 0, 0, 0);
    b0 = __builtin_amdgcn_mfma_f32_16x16x32_bf16(KB.k[0][1], qf[1], b0, 0, 0, 0);
    b1 = __builtin_amdgcn_mfma_f32_16x16x32_bf16(KB.k[1][1], qf[1], b1, 0, 0, 0);
    float mxa = fmaxf(fmaxf(fmaxf(a0[0], a0[1]), fmaxf(a0[2], a0[3])), fmaxf(fmaxf(a1[0], a1[1]), fmaxf(a1[2], a1[3])));
    float mxb = fmaxf(fmaxf(fmaxf(b0[0], b0[1]), fmaxf(b0[2], b0[3])), fmaxf(fmaxf(b1[0], b1[1]), fmaxf(b1[2], b1[3])));
    const float mx = red16_max(fmaxf(mxa, mxb));
    const float mn = fmaxf(m, mx);
    const float alpha = __builtin_amdgcn_exp2f(m - mn);
    m = mn;
    f32x4 pa0, pa1, pb0, pb1;
#pragma unroll
    for (int e = 0; e < 4; ++e) { pa0[e] = __builtin_amdgcn_exp2f(a0[e] - mn); pa1[e] = __builtin_amdgcn_exp2f(a1[e] - mn); pb0[e] = __builtin_amdgcn_exp2f(b0[e] - mn); pb1[e] = __builtin_amdgcn_exp2f(b1[e] - mn); }
    const f32x4 ps = (pa0 + pa1) + (pb0 + pb1);
    l = l * alpha + ((ps[0] + ps[1]) + (ps[2] + ps[3]));
    u32x4 wa, wb; wa.x = pk2(pa0[0], pa0[1]); wa.y = pk2(pa0[2], pa0[3]); wa.z = pk2(pa1[0], pa1[1]); wa.w = pk2(pa1[2], pa1[3]);
    wb.x = pk2(pb0[0], pb0[1]); wb.y = pk2(pb0[2], pb0[3]); wb.z = pk2(pb1[0], pb1[1]); wb.w = pk2(pb1[2], pb1[3]);
    const bf16x8 pfa = __builtin_bit_cast(bf16x8, wa), pfb = __builtin_bit_cast(bf16x8, wb);
#pragma unroll
    for (int d = 0; d < 4; ++d) { o[d] = o[d] * alpha; o[d] = __builtin_amdgcn_mfma_f32_16x16x32_bf16(VA.v[d], pfa, o[d], 0, 0, 0); o[d] = __builtin_amdgcn_mfma_f32_16x16x32_bf16(VB.v[d], pfb, o[d], 0, 0, 0); }
}

typedef short v4i16_t __attribute__((ext_vector_type(4)));
__device__ __forceinline__ bf16x8 vtr8(const LAS unsigned char* p, int step) {
    const v4i16_t lo = __builtin_amdgcn_ds_read_tr16_b64_v4i16((LAS v4i16_t*)p), hi = __builtin_amdgcn_ds_read_tr16_b64_v4i16((LAS v4i16_t*)(p + step));
    return (bf16x8){lo[0], lo[1], lo[2], lo[3], hi[0], hi[1], hi[2], hi[3]};
}
constexpr int TAB_LD = 48, TAB_ROWS = 15;
constexpr int CK_STRIDE = 144, CV_STRIDE = 136, RW_STRIDE = 144, VP = 1024;
constexpr int LDS_TAB = 0, LDS_CK = 3072, LDS_CV = LDS_CK + CTXL * CK_STRIDE, LDS_RING = LDS_CV + CTXL * CV_STRIDE;
constexpr int ROWK_BYTES = 64 * RW_STRIDE, SLOT_BYTES = 2 * ROWK_BYTES, LDS_ATT_END = LDS_RING + 3 * SLOT_BYTES;
static_assert(TAB_ROWS * TAB_LD * 4 <= LDS_CK && LDS_ATT_END <= RING_BYTES, "attention LDS map");
__device__ __forceinline__ int rs_of(int r) { int v = r - 4; return v < 0 ? 0 : (v > 24 ? 24 : v); }
__device__ __forceinline__ void attn_phase(const bf16_t* QK, const bf16_t* VT, bf16_t* O, const float* rpb, LAS unsigned char* lds, int tid, int lane, int wave, int bid, int G) {
    LAS float* tab = (LAS float*)(lds + LDS_TAB);
    const int fr = lane & 15, fq = lane >> 4;
    const int j = wave & 3, rw = wave >> 2;
    const int kc0 = (j == 0) ? 0 : (j == 1) ? 8 : (j == 2) ? 24 : 32;
    unsigned bpk0 = 0u, bpk1 = 0u;
    { const int cq = 16 * j + fr; int cs = cq - 8; cs = cs < 0 ? 0 : (cs > 48 ? 48 : cs);
#pragma unroll
      for (int jj = 0; jj < 8; ++jj) { const int ck = kc0 + 8 * fq + jj; const bool valid = (ck >= cs) && (ck < cs + 16); const unsigned col = valid ? (unsigned)(ck - cq + 15) : 31u;
          if (jj < 4) bpk0 |= col << (8 * jj); else bpk1 |= col << (8 * (jj - 4)); } }
    LAS unsigned char* ckl = lds + LDS_CK + fr * CK_STRIDE + fq * 16;
    LAS unsigned char* cvl = lds + LDS_CV + (8 * fq + (fr >> 2)) * CV_STRIDE + (fr & 3) * 8;
    const int klo = LDS_RING + (kc0 + 8 * (fr >> 2) + (fr & 3)) * RW_STRIDE + fq * 16;
    const int vlo = LDS_RING + ROWK_BYTES + (kc0 + 8 * fq + (fr >> 2)) * RW_STRIDE + (fr & 3) * 8;
    const int st_t = tid >> 3, st_ch = tid & 7;
    const int st_off = st_t * RW_STRIDE + st_ch * 16;
    for (int bh = bid; bh < NB * NH; bh += G) {
        const int b = bh >> 4, h = bh & 15;
        const int ctx_kt0 = MLAT + b * CTXL;
        const bf16_t* ksrc = QK + (size_t)(b * SEQ + st_t) * 2048 + 1024 + h * 64 + st_ch * 8;
        const bf16_t* vsrc = VT + (size_t)(b * SEQ + st_t) * VP + h * 64 + st_ch * 8;
        __syncthreads();
        for (int i = tid; i < TAB_ROWS * TAB_LD; i += 512) { const int col = i % TAB_LD, dr = i / TAB_LD; tab[i] = col < 31 ? rpb[(h * TAB_ROWS + dr) * 31 + col] * LOG2E : -1e30f; }
        for (int p = tid; p < CTXL * 8; p += 512) { const int key = p >> 3, ch = p & 7, c = key >> 5, w = key & 31; const int slot = c * 32 + ((w >> 2) & 1) * 16 + (w >> 3) * 4 + (w & 3);
            *(LAS u32x4*)(lds + LDS_CK + slot * CK_STRIDE + ch * 16) = *(const u32x4*)(QK + (size_t)(ctx_kt0 + key) * 2048 + 1024 + h * 64 + ch * 8); }
        for (int p = tid; p < CTXL * 8; p += 512) { const int key = p >> 3, ch = p & 7; const u32x4 w = *(const u32x4*)(VT + (size_t)(ctx_kt0 + key) * VP + h * 64 + ch * 8);
            LAS u32x2* dp = (LAS u32x2*)(lds + LDS_CV + key * CV_STRIDE + ch * 16); dp[0] = (u32x2){w.x, w.y}; dp[1] = (u32x2){w.z, w.w}; }
#pragma unroll
        for (int s0 = 0; s0 < 2; ++s0) {
            *(LAS u32x4*)(lds + LDS_RING + s0 * SLOT_BYTES + st_off) = *(const u32x4*)(ksrc + (size_t)s0 * 64 * 2048);
            *(LAS u32x4*)(lds + LDS_RING + s0 * SLOT_BYTES + ROWK_BYTES + st_off) = *(const u32x4*)(vsrc + (size_t)s0 * 64 * VP); }
        u32x4 kr0, vr0, kr1, vr1, kr2, vr2;
        kr2 = *(const u32x4*)(ksrc + (size_t)2 * 64 * 2048); vr2 = *(const u32x4*)(vsrc + (size_t)2 * 64 * VP);
        kr0 = *(const u32x4*)(ksrc + (size_t)3 * 64 * 2048); vr0 = *(const u32x4*)(vsrc + (size_t)3 * 64 * VP);
        kr1 = kr0; vr1 = vr0;
        asm volatile("s_waitcnt lgkmcnt(0)" ::: "memory"); __builtin_amdgcn_s_barrier(); asm volatile("" ::: "memory");
        int gslot = 0;
        int it = 0, sc = 0, n_cur = 8, rs_lo = 0;
        int r_ = rw, rsw_ = 0, tq0_ = b * SEQ + rw * 64 + j * 16;
        int itp = 0, sp = 4, np = 8, prow = 4;
        bf16x8 qf[2], qn[2]; float m = -1e30f, l = 0.f; f32x4 o[4];
        qf[0] = qf[1] = (bf16x8){0, 0, 0, 0, 0, 0, 0, 0};
#pragma unroll
        for (int ks = 0; ks < 2; ++ks) qn[ks] = *(const bf16x8*)(QK + (size_t)(b * SEQ + rw * 64 + j * 16 + fr) * 2048 + h * 64 + ks * 32 + fq * 8);
#pragma unroll
        for (int d = 0; d < 4; ++d) o[d] = (f32x4){0.f, 0.f, 0.f, 0.f};
#define ATT_STEP(KI, VI, KW, VW) do { \
            { const int row_ = itp < 16 ? prow : 0; KI = *(const u32x4*)(ksrc + (size_t)row_ * 64 * 2048); VI = *(const u32x4*)(vsrc + (size_t)row_ * 64 * VP); } \
            ++prow; if (++sp >= np) { sp = 0; ++itp; prow = rs_of(2 * itp); np = 8 + rs_of(2 * itp + 1) - prow; } \
            if (it < 16) { \
                if (sc == 0) { qf[0] = qn[0]; qf[1] = qn[1]; \
                    m = -1e30f; l = 0.f; _Pragma("unroll") for (int d = 0; d < 4; ++d) o[d] = (f32x4){0.f, 0.f, 0.f, 0.f}; } \
                if (sc == n_cur - 2) { const int tqn_ = tq0_ + (it < 15 ? 128 : 0);        \
                    _Pragma("unroll") for (int ks = 0; ks < 2; ++ks) qn[ks] = *(const bf16x8*)(QK + (size_t)(tqn_ + fr) * 2048 + h * 64 + ks * 32 + fq * 8); } \
                const int c_ = rs_lo + sc - rsw_; \
                if (c_ >= 0 && c_ < 8) { \
                    KBuf kc_, kl_; VBuf vc_, vl_; \
                    const LAS unsigned char* cks = ckl + c_ * 32 * CK_STRIDE; const LAS unsigned char* cvs = cvl + c_ * 32 * CV_STRIDE; \
                    const LAS unsigned char* lk = lds + klo + gslot * SLOT_BYTES; const LAS unsigned char* lv = lds + vlo + gslot * SLOT_BYTES; \
                    _Pragma("unroll") for (int T = 0; T < 2; ++T) _Pragma("unroll") for (int ks = 0; ks < 2; ++ks) { \
                        kc_.k[T][ks] = *(const LAS bf16x8*)(cks + T * 16 * CK_STRIDE + ks * 64); kl_.k[T][ks] = *(const LAS bf16x8*)(lk + T * 4 * RW_STRIDE + ks * 64); } \
                    _Pragma("unroll") for (int d = 0; d < 4; ++d) { vc_.v[d] = vtr8(cvs + d * 32, 4 * CV_STRIDE); vl_.v[d] = vtr8(lv + d * 32, 4 * RW_STRIDE); } \
                    const int tb_ = (rsw_ - r_ + 7 + c_) * TAB_LD; f32x4 c0_, c1_; \
                    _Pragma("unroll") for (int e = 0; e < 4; ++e) { c0_[e] = tab[tb_ + (int)((bpk0 >> (8 * e)) & 255u)]; c1_[e] = tab[tb_ + (int)((bpk1 >> (8 * e)) & 255u)]; } \
                    attn_step2(kc_, vc_, kl_, vl_, qf, c0_, c1_, m, l, o); } \
                if (sc == n_cur - 1) { \
                    const float lt = red16_sum(l); const float rl = 1.0f / lt; \
                    bf16_t* op = O + (size_t)(tq0_ + fr) * DM + h * 64 + 4 * fq; \
                    _Pragma("unroll") for (int d = 0; d < 4; ++d) { const f32x4 v = o[d] * rl; u32x2 w; w.x = pk2(v[0], v[1]); w.y = pk2(v[2], v[3]); *(u32x2*)(op + d * 16) = w; } } \
                if (++sc >= n_cur) { sc = 0; ++it; rs_lo = rs_of(2 * it); const int rs_hi_ = rs_of(2 * it + 1); n_cur = 8 + rs_hi_ - rs_lo; \
                    r_ = 2 * it + rw; rsw_ = rw ? rs_hi_ : rs_lo; tq0_ = b * SEQ + r_ * 64 + j * 16; } } \
            { int wslot = gslot + 2; wslot = wslot >= 3 ? wslot - 3 : wslot; \
              *(LAS u32x4*)(lds + LDS_RING + wslot * SLOT_BYTES + st_off) = KW; *(LAS u32x4*)(lds + LDS_RING + wslot * SLOT_BYTES + ROWK_BYTES + st_off) = VW; } \
            asm volatile("s_waitcnt lgkmcnt(0)" ::: "memory"); __builtin_amdgcn_s_barrier(); asm volatile("" ::: "memory"); \
            gslot = gslot == 2 ? 0 : gslot + 1; } while (0)
#pragma unroll 1
        for (int g = 0; g < 141; g += 3) {
            ATT_STEP(kr1, vr1, kr2, vr2);
            ATT_STEP(kr2, vr2, kr0, vr0);
            ATT_STEP(kr0, vr0, kr1, vr1);
        }
#undef ATT_STEP
    }
}

#define XB_TMO      128
#define XB_XCNT(j)  (256  + 64 * (j))
#define XB_XSUB(j)  (1280 + 64 * (j))
#define XB_XGEN(j)  (2304 + 64 * (j))
#define XB_TOP      3328
#define XB_TOPGEN   3392
#define XCD_BAR_WORDS 3456
#define XB_SPIN_CAP (1u << 18)

__device__ __forceinline__ unsigned xb_ld(unsigned* p)              { return __hip_atomic_load(p, __ATOMIC_RELAXED, __HIP_MEMORY_SCOPE_AGENT); }
__device__ __forceinline__ unsigned xb_add(unsigned* p, unsigned v) { return __hip_atomic_fetch_add(p, v, __ATOMIC_RELAXED, __HIP_MEMORY_SCOPE_AGENT); }
__device__ __forceinline__ unsigned xb_xcc_id() { return (unsigned)__builtin_amdgcn_s_getreg((3 << 11) | 20) & 0xFu; }
#define XB_SPIN(cond, bar) do { unsigned _sp = 0; while (cond) { __builtin_amdgcn_s_sleep(1); \
    if ((++_sp & 255u) == 0u) { if (xb_ld(&(bar)[XB_TMO])) break; if (_sp > XB_SPIN_CAP) { atomicAdd(&(bar)[XB_TMO], 1u); break; } } } } while (0)

struct XcdBarrier {
    unsigned* bar; unsigned x;
    volatile LAS unsigned* st;
};

__device__ __forceinline__ XcdBarrier xcd_barrier_post(unsigned* bar, volatile LAS unsigned* st) {
    XcdBarrier b; b.bar = bar; b.x = xb_xcc_id(); b.st = st;
    if (threadIdx.x == 0) (void)xb_add(&bar[XB_XCNT(b.x)], 1u);
    return b;
}
__device__ __forceinline__ void xcd_barrier_complete(unsigned* bar, unsigned x, unsigned& nloc, unsigned& nx) {
    const unsigned G = gridDim.x * gridDim.y * gridDim.z;
    unsigned sum, cnt, mine, sp = 0u;
    for (;;) {
        sum = 0u; cnt = 0u; mine = 0u;
#pragma unroll
        for (unsigned j = 0; j < 16; ++j) { const unsigned c = xb_ld(&bar[XB_XCNT(j)]); sum += c; cnt += (c > 0u) ? 1u : 0u; mine = (j == x) ? c : mine; }
        if (sum == G) break;
        __builtin_amdgcn_s_sleep(1);
        if ((++sp & 255u) == 0u) { if (xb_ld(&bar[XB_TMO])) break; if (sp > XB_SPIN_CAP) { atomicAdd(&bar[XB_TMO], 1u); break; } }
    }
    nloc = mine > 0u ? mine : 1u; nx = cnt > 0u ? cnt : 1u;
}

__device__ __forceinline__ void xcd_barrier(const XcdBarrier& b) {
    asm volatile("s_waitcnt vmcnt(0)" ::: "memory");
    __syncthreads();
    if (threadIdx.x == 0) {
        unsigned* bar = b.bar;
        __builtin_amdgcn_s_waitcnt(0);
        unsigned nloc = b.st[0], nx = b.st[1];
        if (nloc == 0u) { xcd_barrier_complete(bar, b.x, nloc, nx); b.st[0] = nloc; b.st[1] = nx; }
        const unsigned old = xb_add(&bar[XB_XSUB(b.x)], 1u);
        const unsigned gen = old / nloc;
        if (old + 1u == (gen + 1u) * nloc) {
            __builtin_amdgcn_fence(__ATOMIC_RELEASE, "agent");
            asm volatile("s_waitcnt vmcnt(0)" ::: "memory");
            const unsigned og = xb_add(&bar[XB_TOP], 1u);
            const unsigned tg = og / nx;
            if (og + 1u == (tg + 1u) * nx) xb_add(&bar[XB_TOPGEN], 1u);
            else XB_SPIN(xb_ld(&bar[XB_TOPGEN]) == tg, bar);
            __builtin_amdgcn_fence(__ATOMIC_ACQUIRE, "agent");
            xb_add(&bar[XB_XGEN(b.x)], 1u);
            asm volatile("s_waitcnt vmcnt(0)" ::: "memory");
        } else {
            XB_SPIN(xb_ld(&bar[XB_XGEN(b.x)]) == gen, bar);
            __builtin_amdgcn_fence(__ATOMIC_ACQUIRE, "agent");
            asm volatile("s_waitcnt vmcnt(0)" ::: "memory");
        }
    }
    __syncthreads();
}


constexpr int NPHASE = 14;
__global__ void __launch_bounds__(512, 2) fwd_mega(Args args) {
    extern __shared__ __attribute__((aligned(16))) unsigned char lds_raw[];
    LAS unsigned char* lds = (LAS unsigned char*)lds_raw;
    cg::grid_group grid = cg::this_grid();
    const int G = gridDim.x, bid = blockIdx.x, NGW = G * 8;
    unsigned char* ws = args.ws;
    const float* x = args.in[0]; const float* ctx = args.in[2];
    const float* norm1_g = args.in[4]; const float* norm2_g = args.in[5];
    const float* conv_w = args.in[9]; const float* rpb = args.in[12]; const float* final_g = args.in[16];
    float* mod = (float*)(ws + WS_MOD);
    bf16_t* SHA = (bf16_t*)(ws + WS_SHA);
    bf16_t* H = (bf16_t*)(ws + WS_H); bf16_t* H2 = (bf16_t*)(ws + WS_H2); float* rss = (float*)(ws + WS_RSS); float* shw = (float*)(ws + WS_SHW);
    bf16_t* Xctx = (bf16_t*)(ws + WS_XCTX);
    bf16_t* Xlat = (bf16_t*)args.out;
    bf16_t* BIG = (bf16_t*)(ws + WS_BIG);
    bf16_t* U = BIG; bf16_t* Bg = BIG + (size_t)MALL * 1024;
    bf16_t* HID = BIG;
    bf16_t* QK = BIG; bf16_t* VT = BIG + (size_t)MALL * 2048;
    bf16_t* Wcin = (bf16_t*)(ws + WS_WCIN); bf16_t* Wcout = (bf16_t*)(ws + WS_WCOUT); bf16_t* Wqkv = (bf16_t*)(ws + WS_WQKV); bf16_t* Wao = (bf16_t*)(ws + WS_WAO);
    bf16_t* W1 = (bf16_t*)(ws + WS_W1); bf16_t* W2 = (bf16_t*)(ws + WS_W2);

#ifndef PROBE_PH
#define PROBE_PH -1
#endif
#ifndef PROBE_PH2
#define PROBE_PH2 -1
#endif
    if (threadIdx.x < 32) ((volatile LAS unsigned*)(lds + MISC_OFF))[threadIdx.x] = 0u;
    __syncthreads();
    const XcdBarrier xbar = xcd_barrier_post((unsigned*)(ws + WS_CTL), (volatile LAS unsigned*)(lds + MISC_OFF) + 8);
    if (args.ph_lo < 0) grid.sync();
    for (int ph = args.ph_lo; ph < args.ph_hi; ++ph) {
      for (int rep = 0; rep < ((ph == PROBE_PH || ph == PROBE_PH2) ? 2 : 1); ++rep) {
        if (rep) xcd_barrier(xbar);
        int tid = threadIdx.x; asm volatile("" : "+v"(tid));
        const int lane = tid & 63, wave = __builtin_amdgcn_readfirstlane(tid >> 6), gw = bid * 8 + wave;
        int kind = 0;
        bool sync_after = true;
        pg8::Gemm g{nullptr, nullptr, 0, 0, 0}; int cidx = bid;
        pg8::EpiU E{}; E.mode = 0; E.O = nullptr; E.O2 = nullptr; E.ldc = 0; E.scale_tiles = 0; E.sc = 1.f; E.rss = nullptr; E.shw = nullptr; E.shw_ld = 0; E.inLat = nullptr; E.inCtx = nullptr; E.inbLat = nullptr; E.inbCtx = nullptr; E.outLat = nullptr; E.outCtx = nullptr; E.gate = nullptr;
        E.An = nullptr; E.gn = nullptr; E.scn = nullptr; E.rssn = nullptr; E.outf5 = nullptr;
        switch (ph) {
        case 0: p0_phase(args, lds, tid, lane, wave, bid, G); break;
        case 1: norm_phase(x, ctx, MALL, norm1_g, mod, 0, 1, H, nullptr, nullptr, gw, NGW, lane);
                for (int i = bid * 512 + tid; i < 3 * 17 * 1024; i += G * 512) { const int jb = i / (17 * 1024), rr = (i / 1024) % 17, k = i & 1023;
                    const float* shp = mod + (jb == 0 ? 3 * 1024 : jb == 1 ? 17 * 6144 : 17 * 6144 + 3 * 1024) + (size_t)rr * 6144;
                    SHA[(size_t)(jb * 256 + rr) * 1024 + k] = (bf16_t)f2bf(shp[k]); }
                break;
        case 2: kind = 1; g = pg8::Gemm{H, Wcin, MALL, 3072, 1024}; E.mode = 2; E.O = U; E.O2 = Bg; break;
        case 3: convgate_phase(U, Bg, conv_w, H, gw, NGW, lane); break;
        case 4: kind = 1; g = pg8::Gemm{H, Wcout, MALL, 1024, 1024}; E.mode = 3; E.inLat = x; E.inCtx = ctx; E.outLat = Xlat; E.outCtx = Xctx; E.gate = mod + 2 * 1024;
                E.An = H2; E.gn = norm2_g; E.scn = mod + 4 * 1024; E.rssn = rss; break;
        case 5: kind = 1; g = pg8::Gemm{H2, W1, MALL, 4096, 1024}; E.mode = 1; E.O = HID; E.ldc = 4096; E.rss = rss; E.shw = shw; E.shw_ld = 4096; break;
        case 6: case 7:
                kind = 1; g = pg8::Gemm{HID, W2, MLAT, 1024, 4096}; E.mode = 3; E.inbLat = Xlat; E.inbCtx = Xctx; E.outLat = Xlat; E.outCtx = Xctx; E.gate = mod + 5 * 1024;
                E.An = H; E.gn = norm1_g + 1024; E.scn = mod + 17 * 6144 + 1 * 1024; E.rssn = rss + MALL; break;
        case 8: kind = 1; break;
        case 9: attn_phase(QK, VT, H2, rpb, lds, tid, lane, wave, bid, G); break;
        case 10: kind = 1; g = pg8::Gemm{H2, Wao, MLAT, 1024, 1024}; E.mode = 3; E.inbLat = Xlat; E.inbCtx = Xctx; E.outLat = Xlat; E.outCtx = Xctx; E.gate = mod + 17 * 6144 + 2 * 1024;
                E.An = H; E.gn = norm2_g + 1024; E.scn = mod + 17 * 6144 + 4 * 1024; E.rssn = rss + 2 * MALL; break;
        case 11: kind = 1; g = pg8::Gemm{H, W1 + (size_t)4096 * 1024, MLAT, 4096, 1024}; E.mode = 1; E.O = HID; E.ldc = 4096; E.rss = rss + 2 * MALL; E.shw = shw + 17 * 4096 + 17 * 3072; E.shw_ld = 4096; break;
        case 12: kind = 1; g = pg8::Gemm{HID, W2 + (size_t)4096 * 1024, MLAT, 1024, 4096}; E.mode = 3; E.inbLat = Xlat; E.inbCtx = Xctx; E.outLat = H2; E.outCtx = Xctx; E.gate = mod + 17 * 6144 + 5 * 1024;
                E.rssn = rss + 3 * MALL; break;
        case 13: final_phase(H2, rss + 3 * MALL, final_g, args.out, gw, NGW, lane); break;
        default: break;
        }
#ifndef NO_GEMM
        if (kind == 1) {
            const int qk_done = (G > 64) ? ((4 * (G - 64) < 1024) ? 4 * (G - 64) : 1024) : 0;
            const int nsub = (ph == 4) ? 4 : (ph == 8) ? 3 : 1;
            for (int sub = 0; sub < nsub; ++sub) {
                int Gs = G, pm0 = 0, lbeg = 0, lend = -1;
                if (ph == 4 && sub > 0) {
                    const int jb = sub - 1;
                    const int N5 = (jb == 1) ? 3072 : 4096;
                    g = pg8::Gemm{SHA + (size_t)jb * 256 * 1024, jb == 0 ? W1 : jb == 1 ? Wqkv : W1 + (size_t)4096 * 1024, 256, N5, 1024};
                    E.mode = 5; E.ldc = N5; E.outf5 = shw + (jb == 0 ? 0 : jb == 1 ? 17 * 4096 : 17 * 4096 + 17 * 3072); E.rss = nullptr; E.shw = nullptr;
                    cidx = (bid + G - ((G > 112) ? 64 + 16 * jb : 0)) % G;
                }
                const bool qk_role = (ph == 7 && G > 64 && bid >= 64) || (ph == 8 && sub < 2);
                if (ph == 7 && !qk_role) { g.M = MCTX; pm0 = MLAT / 256; Gs = (G > 64) ? 64 : G; cidx = bid; }
                if (qk_role) {
                    g = pg8::Gemm{H, Wqkv, MLAT, 2048, 1024}; E.mode = 0; E.O = QK; E.ldc = 2048; E.scale_tiles = 4; E.sc = QSCALE; E.rss = rss + MALL; E.shw = shw + 17 * 4096; E.shw_ld = 3072;
                    E.An = nullptr; E.rssn = nullptr;
                    if (ph == 7) { Gs = G - 64; cidx = bid - 64; lend = qk_done; }
                    else if (sub == 0) { lbeg = qk_done; }
                    else { g.M = MCTX; pm0 = MLAT / 256; cidx = (bid + G - G / 2) % G; }
                }
                if (ph == 8 && sub == 2) { g = pg8::Gemm{H, Wqkv + (size_t)2048 * 1024, MALL, 1024, 1024}; E.mode = 0; E.O = VT; E.ldc = 1024; E.scale_tiles = 0; E.rss = rss + MALL; E.shw = shw + 17 * 4096 + 2048; E.shw_ld = 3072; pm0 = 0; cidx = bid; }
                pg8::StaticOrder S; S.init(g.M, g.N, Gs, cidx, pm0, lbeg, lend);
                pg8::gemm_phase<pg8::EpiU, pg8::StaticOrder, true, true>(lds, g, S, E);
            }
        } else
#endif
        {}
      }
        if (ph + 1 < args.ph_hi) xcd_barrier(xbar);
    }
}

extern "C" void kernel_launch(void* const* d_in, const int* in_sizes, int n_in, void* d_out, int out_size, void* d_ws, size_t ws_size, hipStream_t stream) {
    static int grid = 0;
    if (grid == 0) {
        if (n_in != 17 || ws_size < WS_END) { fprintf(stderr, "kernel_launch: unexpected n_in %d / ws_size %zu\n", n_in, ws_size); grid = -1; return; }
        int dev = 0, cus = 0, per_cu = 0;
        hipGetDevice(&dev); hipDeviceGetAttribute(&cus, hipDeviceAttributeMultiprocessorCount, dev);
        if (hipFuncSetAttribute((const void*)fwd_mega, hipFuncAttributeMaxDynamicSharedMemorySize, LDS_BYTES) != hipSuccess) { fprintf(stderr, "kernel_launch: hipFuncSetAttribute failed\n"); grid = -1; return; }
        if (hipOccupancyMaxActiveBlocksPerMultiprocessor(&per_cu, (const void*)fwd_mega, 512, LDS_BYTES) != hipSuccess || per_cu < 1) { fprintf(stderr, "kernel_launch: occupancy query says %d\n", per_cu); per_cu = 1; }
        (void)hipGetLastError();
        grid = cus * (per_cu > 1 ? 1 : per_cu);
        if (grid <= 0) grid = 256;
    }
    if (grid < 0) return;
    if (hipMemsetAsync((char*)d_ws + WS_CTL, 0, CTL_BYTES, stream) != hipSuccess) { fprintf(stderr, "kernel_launch: memset failed\n"); return; }
    Args a{};
    for (int i = 0; i < 17; ++i) a.in[i] = (const float*)d_in[i];
    a.out = (float*)d_out; a.ws = (unsigned char*)d_ws;
#if MK_N_LAUNCHES == 1
    a.ph_lo = 0; a.ph_hi = NPHASE;
    void* kargs[] = {&a};
    hipError_t e = hipLaunchCooperativeKernel((const void*)fwd_mega, dim3(grid), dim3(512), kargs, LDS_BYTES, stream);
    if (e != hipSuccess) fprintf(stderr, "kernel_launch: cooperative launch failed: %s (grid %d)\n", hipGetErrorString(e), grid);
#else
    for (int ph = 0; ph < NPHASE; ++ph) {
        a.ph_lo = ph; a.ph_hi = ph + 1;
        hipLaunchKernelGGL(fwd_mega, dim3(grid), dim3(512), LDS_BYTES, stream, a);
    }
#endif
}
```

```cpp
#include <hip/hip_runtime.h>
#include <hip/hip_cooperative_groups.h>
#include <cstdio>
#include <cstdint>
namespace cg = cooperative_groups;

#ifndef MK_N_LAUNCHES
#define MK_N_LAUNCHES 1
#endif

#define LAS __attribute__((address_space(3)))
typedef unsigned short bf16_t;
typedef short bf16x8 __attribute__((ext_vector_type(8)));
typedef float f32x4 __attribute__((ext_vector_type(4)));
typedef unsigned u32x4 __attribute__((ext_vector_type(4)));
typedef unsigned u32x2 __attribute__((ext_vector_type(2)));

constexpr int DM = 1024, NB = 16, SEQ = 2048, CTXL = 256, NH = 16, HD = 64, FF = 4096;
constexpr int MLAT = NB * SEQ;
constexpr int MCTX = NB * CTXL;
constexpr int MALL = MLAT + MCTX;
constexpr float RMS_EPS = 1e-6f;
constexpr float LOG2E = 1.4426950408889634f;
constexpr float QSCALE = 0.125f * LOG2E;

constexpr size_t MiB = 1u << 20;
constexpr size_t WS_SHW = 0;
constexpr size_t WS_MOD = 1 * MiB;
constexpr size_t WS_WCIN = 2 * MiB;
constexpr size_t WS_WCOUT = 8 * MiB;
constexpr size_t WS_WQKV = 10 * MiB;
constexpr size_t WS_WAO = 16 * MiB;
constexpr size_t WS_W1 = 18 * MiB;
constexpr size_t WS_W2 = 34 * MiB;
constexpr size_t WS_H = 50 * MiB;
constexpr size_t WS_XCTX = 122 * MiB;
constexpr size_t WS_BIG = 138 * MiB;
constexpr size_t WS_H2 = 426 * MiB;
constexpr size_t WS_RSS = 498 * MiB;
constexpr size_t WS_CTL = 498 * MiB + 640 * 1024;
constexpr size_t CTL_BYTES = 16384;
constexpr size_t WS_SHA = 500 * MiB;
constexpr size_t WS_END = 502 * MiB;

constexpr int RING_BYTES = 131072;
constexpr int LDS_BYTES = 147456;
constexpr int MISC_OFF = RING_BYTES + 320;

namespace pg8 {
constexpr int BM = 256, BK = 64, HALF = 128, HTB = HALF * BK * 2, STAGE_BYTES = 8 * HTB, NXCD = 8, WGM = 8;
__host__ __device__ __forceinline__ int lds_byte(int r, int c) { const int st = (r >> 4) * 2 + (c >> 5), rr = r & 15, cc = c & 31, ob = rr * 64 + cc * 2; return st * 1024 + (ob ^ (((ob >> 9) & 1) << 5)); }
__host__ __device__ __forceinline__ void stage_rc(int b, int& R, int& C) { const int st = b / 1024, sb = b % 1024, swz = sb ^ (((sb >> 9) & 1) << 5); R = (st >> 1) * 16 + swz / 64; C = (st & 1) * 32 + (swz % 64) / 2; }
__host__ __device__ __forceinline__ int perm32(int rho) { const int n = rho >> 4, i = rho & 15; return 8 * (i >> 2) + 4 * n + (i & 3); }

struct Unit { int pm, pn; };
struct Gemm { const bf16_t* A; const bf16_t* Bt; int M, N, K; };

struct StaticOrder {
    int nM, nN, nwg, G, c, pm0, lbeg, lend;
    __host__ __device__ void init(int M, int N, int G_, int c_, int pm0_ = 0, int lbeg_ = 0, int lend_ = -1) { nM = M / BM; nN = N / BM; nwg = nM * nN; G = G_; c = c_; pm0 = pm0_; lbeg = lbeg_; lend = lend_ < 0 ? nwg : lend_; }
    __host__ __device__ bool next(int i, Unit& u) const {
        const long L = (long)lbeg + (long)i * G + c; if (L >= lend) return false;
        int wgid = (int)L; { const int q = nwg / NXCD, r = nwg % NXCD, xcd = wgid % NXCD, off = wgid / NXCD; wgid = (xcd < r ? xcd * (q + 1) : r * (q + 1) + (xcd - r) * q) + off; }
        const int nig = WGM * nN, gid = wgid / nig, fm = gid * WGM, gsz = (nM - fm) < WGM ? (nM - fm) : WGM;
        u.pm = pm0 + fm + ((wgid % nig) % gsz); u.pn = (wgid % nig) / gsz; return true;
    }
};

__device__ __forceinline__ unsigned cvt_pk_bf16(float lo, float hi) { unsigned r; asm volatile("v_cvt_pk_bf16_f32 %0, %1, %2" : "=v"(r) : "v"(lo), "v"(hi)); return r; }

__device__ __forceinline__ float xsum16(float x) {
    auto r = __builtin_amdgcn_permlane16_swap(__float_as_uint(x), __float_as_uint(x), false, false);
    x = __uint_as_float(r[0]) + __uint_as_float(r[1]);
    auto q = __builtin_amdgcn_permlane32_swap(__float_as_uint(x), __float_as_uint(x), false, false);
    return __uint_as_float(q[0]) + __uint_as_float(q[1]);
}
struct EpiU {
    int mode;
    bf16_t* O; bf16_t* O2; int ldc; int scale_tiles; float sc;
    const float* rss; const float* shw; int shw_ld;
    const float* inLat; const float* inCtx; const bf16_t* inbLat; const bf16_t* inbCtx; bf16_t* outLat; bf16_t* outCtx; const float* gate;
    float* outf5;
    bf16_t* An; const float* gn; const float* scn; float* rssn;
    __device__ __forceinline__ bool has_aux() const { return (mode <= 1 || mode == 4) && rss != nullptr; }
    __device__ __forceinline__ const float* aux_src(const Unit& u, int wid, int lane) const {
        const int i = (wid & 3) * 64 + lane;
        if (mode == 4) { const float* shp = shw + (size_t)(u.pn < (MLAT / BM) ? (u.pn >> 3) : 16) * shw_ld + 2048; return wid < 4 ? shp + u.pm * BM + i : rss + u.pn * BM + i; }
        return wid < 4 ? rss + u.pm * BM + i : shw + (size_t)(u.pm < (MLAT / BM) ? (u.pm >> 3) : 16) * shw_ld + u.pn * BM + i;
    }
    __device__ __forceinline__ void operator()(const f32x4 (&acc)[2][2][4][2], const Unit& u, int wr, int wc, int fr, int fq, const LAS float* aux) const {
        const int row0 = u.pm * BM + wr * 64 + fr;
        if (mode == 5) {
            if (wr == 0) {
#pragma unroll
                for (int m = 0; m < 2; ++m) { const int row = m * 16 + fr;
                    if (row < 17) {
#pragma unroll
                        for (int bj = 0; bj < 2; ++bj)
#pragma unroll
                            for (int n = 0; n < 2; ++n) *(f32x4*)(outf5 + (size_t)row * ldc + u.pn * BM + bj * HALF + wc * 32 + 8 * fq + 4 * n) = acc[0][bj][m][n]; } }
            }
            return;
        }
        if (mode <= 1) {
            const float s = (u.pn < scale_tiles) ? sc : 1.f;
            const int col0 = u.pn * BM + wc * 32 + 8 * fq;
            f32x4 bv[2][2];
#pragma unroll
            for (int bj = 0; bj < 2; ++bj)
#pragma unroll
                for (int n = 0; n < 2; ++n) bv[bj][n] = rss ? *(const LAS f32x4*)(aux + 256 + wc * 32 + 8 * fq + bj * HALF + 4 * n) : (f32x4){0.f, 0.f, 0.f, 0.f};
#pragma unroll
            for (int ai = 0; ai < 2; ++ai)
#pragma unroll
                for (int m = 0; m < 4; ++m) { const int row = row0 + ai * HALF + m * 16; bf16_t* rowp = O + (size_t)row * ldc + col0;
                    const float rinv = rss ? __builtin_amdgcn_rsqf(aux[wr * 64 + fr + ai * HALF + m * 16] * (1.f / DM) + RMS_EPS) : 1.f;
#pragma unroll
                    for (int bj = 0; bj < 2; ++bj) { f32x4 v0 = acc[ai][bj][m][0] * rinv + bv[bj][0], v1 = acc[ai][bj][m][1] * rinv + bv[bj][1];
                        if (mode == 1) { v0 = __builtin_elementwise_max(v0, (f32x4){0.f, 0.f, 0.f, 0.f}); v1 = __builtin_elementwise_max(v1, (f32x4){0.f, 0.f, 0.f, 0.f}); v0 = v0 * v0; v1 = v1 * v1; }
                        v0 = v0 * s; v1 = v1 * s;
                        u32x4 w; w.x = cvt_pk_bf16(v0[0], v0[1]); w.y = cvt_pk_bf16(v0[2], v0[3]); w.z = cvt_pk_bf16(v1[0], v1[1]); w.w = cvt_pk_bf16(v1[2], v1[3]);
                        *(u32x4*)(rowp + bj * HALF) = w; } }
        } else if (mode == 4) {
            const int col0 = u.pn * BM + wc * 32 + 8 * fq;
            f32x4 cinv[2][2];
#pragma unroll
            for (int bj = 0; bj < 2; ++bj)
#pragma unroll
                for (int n = 0; n < 2; ++n) { const f32x4 q = *(const LAS f32x4*)(aux + 256 + wc * 32 + 8 * fq + bj * HALF + 4 * n);
#pragma unroll
                    for (int e = 0; e < 4; ++e) cinv[bj][n][e] = __builtin_amdgcn_rsqf(q[e] * (1.f / DM) + RMS_EPS); }
#pragma unroll
            for (int ai = 0; ai < 2; ++ai)
#pragma unroll
                for (int m = 0; m < 4; ++m) { const int row = row0 + ai * HALF + m * 16; bf16_t* rowp = O + (size_t)row * ldc + col0; const float bias = aux[wr * 64 + fr + ai * HALF + m * 16];
#pragma unroll
                    for (int bj = 0; bj < 2; ++bj) { const f32x4 v0 = acc[ai][bj][m][0] * cinv[bj][0] + bias, v1 = acc[ai][bj][m][1] * cinv[bj][1] + bias;
                        u32x4 w; w.x = cvt_pk_bf16(v0[0], v0[1]); w.y = cvt_pk_bf16(v0[2], v0[3]); w.z = cvt_pk_bf16(v1[0], v1[1]); w.w = cvt_pk_bf16(v1[2], v1[3]);
                        *(u32x4*)(rowp + bj * HALF) = w; } }
        } else if (mode == 2) {
            if (u.pn < 8) {
                const int col0 = u.pn * HALF + wc * 32 + 8 * fq;
#pragma unroll
                for (int ai = 0; ai < 2; ++ai)
#pragma unroll
                    for (int m = 0; m < 4; ++m) { bf16_t* rowp = O + (size_t)(row0 + ai * HALF + m * 16) * 1024 + col0;
                        const f32x4 v0 = acc[ai][0][m][0] * acc[ai][1][m][0], v1 = acc[ai][0][m][1] * acc[ai][1][m][1];
                        u32x4 w; w.x = cvt_pk_bf16(v0[0], v0[1]); w.y = cvt_pk_bf16(v0[2], v0[3]); w.z = cvt_pk_bf16(v1[0], v1[1]); w.w = cvt_pk_bf16(v1[2], v1[3]);
                        *(u32x4*)rowp = w; }
            } else {
                const int col0 = (u.pn - 8) * BM + wc * 32 + 8 * fq;
#pragma unroll
                for (int ai = 0; ai < 2; ++ai)
#pragma unroll
                    for (int m = 0; m < 4; ++m) { bf16_t* rowp = O2 + (size_t)(row0 + ai * HALF + m * 16) * 1024 + col0;
#pragma unroll
                        for (int bj = 0; bj < 2; ++bj) { const f32x4 v0 = acc[ai][bj][m][0], v1 = acc[ai][bj][m][1];
                            u32x4 w; w.x = cvt_pk_bf16(v0[0], v0[1]); w.y = cvt_pk_bf16(v0[2], v0[3]); w.z = cvt_pk_bf16(v1[0], v1[1]); w.w = cvt_pk_bf16(v1[2], v1[3]);
                            *(u32x4*)(rowp + bj * HALF) = w; } }
            }
        } else {
            const bool lat = u.pm < (MLAT / BM);
            const int prow = (lat ? u.pm : u.pm - MLAT / BM) * BM + wr * 64 + fr;
            const float* in = lat ? inLat : inCtx; const bf16_t* inb = lat ? inbLat : inbCtx; bf16_t* out = lat ? outLat : outCtx;
            const int brow = lat ? (u.pm >> 3) : 16;
            const float* gp = gate + (size_t)brow * 6144;
            const int col0 = u.pn * BM + wc * 32 + 8 * fq;
            f32x4 gv[2][2], gm[2][2];
#pragma unroll
            for (int bj = 0; bj < 2; ++bj)
#pragma unroll
                for (int n = 0; n < 2; ++n) { gv[bj][n] = *(const f32x4*)(gp + col0 + bj * HALF + 4 * n);
                    gm[bj][n] = An ? *(const f32x4*)(gn + col0 + bj * HALF + 4 * n) * (*(const f32x4*)(scn + (size_t)brow * 6144 + col0 + bj * HALF + 4 * n) + 1.0f) : (f32x4){0.f, 0.f, 0.f, 0.f}; }
#pragma unroll
            for (int ai = 0; ai < 2; ++ai)
#pragma unroll
                for (int m = 0; m < 4; ++m) { const size_t off = (size_t)(prow + ai * HALF + m * 16) * 1024 + col0; float ss = 0.f;
#pragma unroll
                    for (int bj = 0; bj < 2; ++bj) { f32x4 xo[2];
                        if (in) { xo[0] = *(const f32x4*)(in + off + bj * HALF); xo[1] = *(const f32x4*)(in + off + bj * HALF + 4); }
                        else { const u32x4 xw = *(const u32x4*)(inb + off + bj * HALF);
                            xo[0] = (f32x4){__builtin_bit_cast(float, xw.x << 16), __builtin_bit_cast(float, xw.x & 0xffff0000u), __builtin_bit_cast(float, xw.y << 16), __builtin_bit_cast(float, xw.y & 0xffff0000u)};
                            xo[1] = (f32x4){__builtin_bit_cast(float, xw.z << 16), __builtin_bit_cast(float, xw.z & 0xffff0000u), __builtin_bit_cast(float, xw.w << 16), __builtin_bit_cast(float, xw.w & 0xffff0000u)}; }
#pragma unroll
                        for (int n = 0; n < 2; ++n) { xo[n] = xo[n] + gv[bj][n] * acc[ai][bj][m][n];
                            ss += (xo[n][0] * xo[n][0] + xo[n][1] * xo[n][1]) + (xo[n][2] * xo[n][2] + xo[n][3] * xo[n][3]); }
                        { u32x4 w; w.x = cvt_pk_bf16(xo[0][0], xo[0][1]); w.y = cvt_pk_bf16(xo[0][2], xo[0][3]); w.z = cvt_pk_bf16(xo[1][0], xo[1][1]); w.w = cvt_pk_bf16(xo[1][2], xo[1][3]);
                          *(u32x4*)(out + off + bj * HALF) = w; }
                        if (An) { const f32x4 a0 = xo[0] * gm[bj][0], a1 = xo[1] * gm[bj][1];
                            u32x4 w; w.x = cvt_pk_bf16(a0[0], a0[1]); w.y = cvt_pk_bf16(a0[2], a0[3]); w.z = cvt_pk_bf16(a1[0], a1[1]); w.w = cvt_pk_bf16(a1[2], a1[3]);
                            *(u32x4*)(An + (size_t)(row0 + ai * HALF + m * 16) * 1024 + col0 + bj * HALF) = w; } }
                    if (rssn) { ss = xsum16(ss); if (fq == 0) atomicAdd(rssn + row0 + ai * HALF + m * 16, ss); }
                    if (m == 3) asm volatile("" ::: "memory"); }
        }
    }
};

template <class Epi, class Sched, bool ALIGN_EPI = false, bool SP2 = false>
__device__ __forceinline__ void gemm_phase(LAS unsigned char* lds, const Gemm g, const Sched& S, const Epi& E) {
    int tid = threadIdx.x; asm volatile("" : "+v"(tid));
    const int wid = __builtin_amdgcn_readfirstlane(tid >> 6), lane = tid & 63, wr = wid >> 2, wc = wid & 3, fr = lane & 15, fq = lane >> 4;
    const int K = g.K, nt = K / BK;
    unsigned voffA[2], voffB[2];
#pragma unroll
    for (int i = 0; i < 2; ++i) { int R, C; stage_rc(tid * 16 + i * 8192, R, C); const int Rb = (R & ~31) + perm32(R & 31);
        voffA[i] = (unsigned)(R * K + C) * 2u; voffB[i] = (unsigned)(Rb * K + C) * 2u; }
    const size_t kstep = (size_t)(BK * 2);
    const size_t hstep = (size_t)HALF * K * 2;
    const size_t tstep = 2 * hstep;
    const unsigned ldsw = (unsigned)wid * 1024u;
    const int aoff = lds_byte(wr * 64 + fr, fq * 8), boff = lds_byte(wc * 32 + fr, fq * 8);
#define PG8_SA(b, h) (((b) * 2 + (h)) * HTB)
#define PG8_SB(b, h) ((4 + (b) * 2 + (h)) * HTB)
#define PG8_STAGE(bufoff, gbase, voff) do { _Pragma("unroll") for (int _i = 0; _i < 2; ++_i) \
        __builtin_amdgcn_global_load_lds((const unsigned*)((const char*)(gbase) + (voff)[_i]), (LAS unsigned*)(lds + (bufoff) + ldsw + _i * 8192), 16, 0, 0); } while (0)
#define PG8_LDA(dst, b, h) do { _Pragma("unroll") for (int m = 0; m < 4; ++m) _Pragma("unroll") for (int k = 0; k < 2; ++k) dst[m][k] = *(const LAS bf16x8*)(lds + PG8_SA(b, h) + aoff + m * 2048 + k * 1024); } while (0)
#define PG8_LDB(dst, b, h) do { _Pragma("unroll") for (int n = 0; n < 2; ++n) _Pragma("unroll") for (int k = 0; k < 2; ++k) dst[n][k] = *(const LAS bf16x8*)(lds + PG8_SB(b, h) + boff + n * 2048 + k * 1024); } while (0)
#define PG8_MMA(ai, bj, At, Bt) do { __builtin_amdgcn_s_setprio(1); _Pragma("unroll") for (int m = 0; m < 4; ++m) _Pragma("unroll") for (int n = 0; n < 2; ++n) _Pragma("unroll") for (int k = 0; k < 2; ++k) \
        acc[ai][bj][m][n] = __builtin_amdgcn_mfma_f32_16x16x32_bf16(Bt[n][k], At[m][k], acc[ai][bj][m][n], 0, 0, 0); __builtin_amdgcn_s_setprio(0); } while (0)
#define PG8_WAIT_V(n) asm volatile("s_waitcnt vmcnt(" #n ")" ::: "memory")
#define PG8_WAIT_L(n) asm volatile("s_waitcnt lgkmcnt(" #n ")" ::: "memory")
#define PG8_BAR __builtin_amdgcn_s_barrier()
#define PG8_SCHED __builtin_amdgcn_sched_barrier(0)
    Unit cur, nxt; int ui = 0;
    if (!S.next(0, cur)) return;
    constexpr int AUX_OFF = STAGE_BYTES + 1024;
    const bool use_aux = E.has_aux();
    if (use_aux) __builtin_amdgcn_global_load_lds((const unsigned*)E.aux_src(cur, wid, lane), (LAS unsigned*)(lds + AUX_OFF + wid * 256), 4, 0, 0);
    f32x4 acc[2][2][4][2];
#pragma unroll
    for (int a = 0; a < 2; ++a)
#pragma unroll
        for (int b = 0; b < 2; ++b)
#pragma unroll
            for (int m = 0; m < 4; ++m)
#pragma unroll
                for (int n = 0; n < 2; ++n) acc[a][b][m][n] = (f32x4){0.f, 0.f, 0.f, 0.f};
    bf16x8 At[4][2], B0[2][2], B1[2][2];
    const char* cA = (const char*)g.A + (size_t)cur.pm * tstep; const char* cB = (const char*)g.Bt + (size_t)cur.pn * tstep;
    if constexpr (SP2) {
        PG8_STAGE(PG8_SB(0, 0), cB, voffB); PG8_STAGE(PG8_SB(0, 1), cB + hstep, voffB); PG8_STAGE(PG8_SA(0, 0), cA, voffA); PG8_STAGE(PG8_SA(0, 1), cA + hstep, voffA);
        if (wr == 1) PG8_BAR;
        PG8_WAIT_V(2); PG8_BAR;
        PG8_STAGE(PG8_SB(1, 0), cB + kstep, voffB); PG8_STAGE(PG8_SA(1, 0), cA + kstep, voffA); PG8_STAGE(PG8_SB(1, 1), cB + hstep + kstep, voffB);
        PG8_WAIT_V(6); PG8_BAR;
    } else {
        PG8_STAGE(PG8_SB(0, 0), cB, voffB); PG8_STAGE(PG8_SA(0, 0), cA, voffA); PG8_STAGE(PG8_SB(0, 1), cB + hstep, voffB); PG8_STAGE(PG8_SA(0, 1), cA + hstep, voffA);
        if (wr == 1) PG8_BAR;
        PG8_WAIT_V(4); PG8_BAR;
        PG8_STAGE(PG8_SB(1, 0), cB + kstep, voffB); PG8_STAGE(PG8_SA(1, 0), cA + kstep, voffA); PG8_STAGE(PG8_SB(1, 1), cB + hstep + kstep, voffB);
        PG8_WAIT_V(6); PG8_BAR;
    }
    for (;;) {
        const bool has_next = S.next(ui + 1, nxt);
        const char* nA = has_next ? (const char*)g.A + (size_t)nxt.pm * tstep : cA; const char* nB = has_next ? (const char*)g.Bt + (size_t)nxt.pn * tstep : cB;
        for (int t = 0; t < nt; t += 2) {
            const bool last = (t == nt - 2);
            const char* a1 = cA + (size_t)(t + 1) * kstep;
            const char* a2 = last ? nA : cA + (size_t)(t + 2) * kstep; const char* b2 = last ? nB : cB + (size_t)(t + 2) * kstep;
            const char* a3 = a2 + kstep; const char* b3 = b2 + kstep;
            if constexpr (SP2) {
            PG8_LDB(B0, 0, 0); PG8_LDB(B1, 0, 1); PG8_SCHED; PG8_LDA(At, 0, 0); PG8_STAGE(PG8_SA(1, 1), a1 + hstep, voffA);
            PG8_WAIT_V(8); PG8_WAIT_L(0); PG8_BAR; PG8_MMA(0, 0, At, B0); PG8_MMA(0, 1, At, B1); PG8_BAR; PG8_SCHED;
            PG8_LDA(At, 0, 1); PG8_STAGE(PG8_SB(0, 0), b2, voffB); PG8_STAGE(PG8_SB(0, 1), b2 + hstep, voffB); PG8_STAGE(PG8_SA(0, 0), a2, voffA);
            PG8_WAIT_V(8); PG8_WAIT_L(0); PG8_BAR; PG8_MMA(1, 0, At, B0); PG8_MMA(1, 1, At, B1); PG8_BAR; PG8_SCHED;
            PG8_LDB(B0, 1, 0); PG8_LDB(B1, 1, 1); PG8_SCHED; PG8_LDA(At, 1, 0); PG8_STAGE(PG8_SA(0, 1), a2 + hstep, voffA);
            PG8_WAIT_V(8); PG8_WAIT_L(0); PG8_BAR; PG8_MMA(0, 0, At, B0); PG8_MMA(0, 1, At, B1); PG8_BAR; PG8_SCHED;
            PG8_LDA(At, 1, 1); PG8_STAGE(PG8_SB(1, 0), b3, voffB); PG8_STAGE(PG8_SB(1, 1), b3 + hstep, voffB); PG8_STAGE(PG8_SA(1, 0), a3, voffA);
            PG8_WAIT_V(8); PG8_WAIT_L(0); PG8_BAR; PG8_MMA(1, 0, At, B0); PG8_MMA(1, 1, At, B1); PG8_BAR; PG8_SCHED;
            } else {
            PG8_LDB(B0, 0, 0); PG8_SCHED; PG8_LDA(At, 0, 0); PG8_STAGE(PG8_SA(1, 1), a1 + hstep, voffA);
            PG8_WAIT_L(8); PG8_BAR; PG8_WAIT_L(0); PG8_MMA(0, 0, At, B0); PG8_BAR; PG8_SCHED;
            PG8_LDB(B1, 0, 1); PG8_STAGE(PG8_SB(0, 0), b2, voffB);
            PG8_BAR; PG8_WAIT_L(0); PG8_MMA(0, 1, At, B1); PG8_BAR;
            PG8_LDA(At, 0, 1); PG8_STAGE(PG8_SA(0, 0), a2, voffA);
            PG8_BAR; PG8_WAIT_L(0); PG8_MMA(1, 0, At, B0); PG8_BAR; PG8_SCHED;
            PG8_STAGE(PG8_SB(0, 1), b2 + hstep, voffB);
            PG8_WAIT_V(6); PG8_BAR; PG8_MMA(1, 1, At, B1); PG8_BAR;
            PG8_LDB(B0, 1, 0); PG8_SCHED; PG8_LDA(At, 1, 0); PG8_STAGE(PG8_SA(0, 1), a2 + hstep, voffA);
            PG8_WAIT_L(8); PG8_BAR; PG8_WAIT_L(0); PG8_MMA(0, 0, At, B0); PG8_BAR; PG8_SCHED;
            PG8_LDB(B1, 1, 1); PG8_STAGE(PG8_SB(1, 0), b3, voffB);
            PG8_BAR; PG8_WAIT_L(0); PG8_MMA(0, 1, At, B1); PG8_BAR;
            PG8_LDA(At, 1, 1); PG8_STAGE(PG8_SA(1, 0), a3, voffA);
            PG8_BAR; PG8_WAIT_L(0); PG8_MMA(1, 0, At, B0); PG8_BAR; PG8_SCHED;
            PG8_STAGE(PG8_SB(1, 1), b3 + hstep, voffB);
            PG8_WAIT_V(6); PG8_BAR; PG8_MMA(1, 1, At, B1); PG8_BAR;
            }
        }
        if constexpr (ALIGN_EPI) { if (wr == 0) PG8_BAR; }
        E(acc, cur, wr, wc, fr, fq, (const LAS float*)(lds + AUX_OFF + (ui & 1) * 2048));
        if (use_aux && has_next) __builtin_amdgcn_global_load_lds((const unsigned*)E.aux_src(nxt, wid, lane), (LAS unsigned*)(lds + AUX_OFF + ((ui + 1) & 1) * 2048 + wid * 256), 4, 0, 0);
        if (!has_next) break;
#pragma unroll
        for (int a = 0; a < 2; ++a)
#pragma unroll
            for (int b = 0; b < 2; ++b)
#pragma unroll
                for (int m = 0; m < 4; ++m)
#pragma unroll
                    for (int n = 0; n < 2; ++n) acc[a][b][m][n] = (f32x4){0.f, 0.f, 0.f, 0.f};
        cur = nxt; cA = nA; cB = nB; ++ui;
        if constexpr (ALIGN_EPI) { if (wr == 1) PG8_BAR; }
    }
    PG8_WAIT_V(0);
    if constexpr (!ALIGN_EPI) { if (wr == 0) PG8_BAR; }
    PG8_BAR;
#undef PG8_SA
#undef PG8_SB
#undef PG8_STAGE
#undef PG8_LDA
#undef PG8_LDB
#undef PG8_MMA
#undef PG8_WAIT_V
#undef PG8_WAIT_L
#undef PG8_BAR
#undef PG8_SCHED
}
}

__device__ __forceinline__ unsigned f2bf(float f) { unsigned u = __builtin_bit_cast(unsigned, f); return (u + 0x7fffu + ((u >> 16) & 1u)) >> 16; }
__device__ __forceinline__ unsigned pk2(float lo, float hi) { return pg8::cvt_pk_bf16(lo, hi); }
__device__ __forceinline__ float bf_lo(unsigned w) { return __builtin_bit_cast(float, w << 16); }
__device__ __forceinline__ float bf_hi(unsigned w) { return __builtin_bit_cast(float, w & 0xffff0000u); }
__device__ __forceinline__ float wave_sum(float v) {
#pragma unroll
    for (int o = 1; o < 64; o <<= 1) v += __shfl_xor(v, o);
    return v;
}
#define LDS_WAIT() asm volatile("s_waitcnt lgkmcnt(0)" ::: "memory")

struct Args {
    const float* in[17];
    float* out; unsigned char* ws;
    int ph_lo, ph_hi;
};

__device__ __forceinline__ void transpose_item(const float* W, int K, int N, bf16_t* WT, int cinmap, LAS float* scr, int item, int lane) {
    const int nblk = N / 32, kb = item / nblk, nb = item % nblk, k0 = 64 * kb, n0 = 32 * nb;
    float wv[32];
#pragma unroll
    for (int i = 0; i < 32; ++i) { const int kk = 2 * i + (lane >> 5); wv[i] = W[(size_t)(k0 + kk) * N + n0 + (lane & 31)]; }
#pragma unroll
    for (int i = 0; i < 32; ++i) { const int kk = 2 * i + (lane >> 5); scr[kk * 33 + (lane & 31)] = wv[i]; }
    LDS_WAIT(); asm volatile("" ::: "memory");
    int d0 = n0;
    if (cinmap) { if (n0 < 1024) d0 = 2048 + n0; else if (n0 < 2048) { const int ch = n0 - 1024; d0 = (ch >> 7) * 256 + (ch & 127); } else { const int ch = n0 - 2048; d0 = (ch >> 7) * 256 + 128 + (ch & 127); } }
    const int c = lane & 7;
#pragma unroll
    for (int j = 0; j < 4; ++j) { const int n = (lane >> 3) + 8 * j; const LAS float* s = scr + (8 * c) * 33 + n;
        u32x4 o; o.x = pk2(s[0 * 33], s[1 * 33]); o.y = pk2(s[2 * 33], s[3 * 33]); o.z = pk2(s[4 * 33], s[5 * 33]); o.w = pk2(s[6 * 33], s[7 * 33]);
        *(u32x4*)(WT + (size_t)(d0 + n) * K + k0 + 8 * c) = o; }
    LDS_WAIT(); asm volatile("" ::: "memory");
}

__device__ __forceinline__ void gemv17_unit(const LAS float* S, LAS float* red, const float* W, int ldw, int n0, const float* bias, float* out, int ldo, int tid, int lane, int wave) {
    const float* Wp = W + n0 + (lane & 31);
    const int kbase = wave * 128 + (lane >> 5);
    float acc[17];
#pragma unroll
    for (int r = 0; r < 17; ++r) acc[r] = 0.f;
#pragma unroll 1
    for (int ib = 0; ib < 64; ib += 32) {
        float wv[32];
#pragma unroll
        for (int i = 0; i < 32; ++i) wv[i] = Wp[(size_t)(kbase + 2 * (ib + i)) * ldw];
#pragma unroll
        for (int i = 0; i < 32; ++i) { const int k = kbase + 2 * (ib + i);
#pragma unroll
            for (int r = 0; r < 17; ++r) acc[r] += S[r * 1024 + k] * wv[i]; }
    }
#pragma unroll
    for (int r = 0; r < 17; ++r) acc[r] += __shfl_xor(acc[r], 32);
    if (lane < 32) {
#pragma unroll
        for (int r = 0; r < 17; ++r) red[(wave * 17 + r) * 32 + lane] = acc[r]; }
    __syncthreads();
    for (int o = tid; o < 17 * 32; o += 512) { const int r = o >> 5, c2 = o & 31; float s = bias ? bias[n0 + c2] : 0.f;
#pragma unroll
        for (int w = 0; w < 8; ++w) s += red[(w * 17 + r) * 32 + c2];
        out[(size_t)r * ldo + n0 + c2] = s; }
    __syncthreads();
}

__device__ __forceinline__ void p0_phase(const Args& a, LAS unsigned char* lds, int tid, int lane, int wave, int bid, int G) {
    { float* rss = (float*)(a.ws + WS_RSS); for (int i = bid * 512 + tid; i < 4 * MALL; i += G * 512) rss[i] = 0.f; }
    {
        LAS float* S = (LAS float*)lds;
        LAS float* red = (LAS float*)(lds + 17 * 1024 * 4);
        const float* c = a.in[1]; const float* cc = a.in[3]; const float* ada_w = a.in[6]; const float* ada_b = a.in[7];
        float* mod = (float*)(a.ws + WS_MOD);
        for (int i = tid; i < 17 * 1024; i += 512) { const float v = i < 16384 ? c[i] : cc[i - 16384]; S[i] = v / (1.f + __expf(-v)); }
        __syncthreads();
        for (int unit = bid; unit < 384; unit += G) {
            const int l = unit / 192, n0 = (unit % 192) * 32;
            gemv17_unit(S, red, ada_w + (size_t)l * 1024 * 6144, 6144, n0, ada_b + l * 6144, mod + (size_t)l * 17 * 6144, 6144, tid, lane, wave);
        }
    }
    {
        LAS float* scr = (LAS float*)(lds + wave * 16384);
        const int gw = bid * 8 + wave, NGW = G * 8;
        constexpr int I_CIN = 16 * 96, I_SQ = 16 * 32, I_UP = 16 * 128, I_DN = 64 * 32;
        constexpr int NITEMS = 2 * I_CIN + 2 * I_SQ + 2 * I_UP + 2 * I_DN;
        bf16_t* ws16 = (bf16_t*)a.ws;
        for (int it = gw; it < NITEMS; it += NGW) {
            int r = it;
            if (r < I_CIN) { transpose_item(a.in[8], 1024, 3072, (bf16_t*)(a.ws + WS_WCIN), 1, scr, r, lane); continue; } r -= I_CIN;
            if (r < I_CIN) { transpose_item(a.in[11], 1024, 3072, (bf16_t*)(a.ws + WS_WQKV), 0, scr, r, lane); continue; } r -= I_CIN;
            if (r < I_SQ) { transpose_item(a.in[10], 1024, 1024, (bf16_t*)(a.ws + WS_WCOUT), 0, scr, r, lane); continue; } r -= I_SQ;
            if (r < I_SQ) { transpose_item(a.in[13], 1024, 1024, (bf16_t*)(a.ws + WS_WAO), 0, scr, r, lane); continue; } r -= I_SQ;
            if (r < 2 * I_UP) { const int l = r / I_UP; transpose_item(a.in[14] + (size_t)l * 1024 * 4096, 1024, 4096, (bf16_t*)(a.ws + WS_W1) + (size_t)l * 4096 * 1024, 0, scr, r % I_UP, lane); continue; } r -= 2 * I_UP;
            { const int l = r / I_DN; transpose_item(a.in[15] + (size_t)l * 4096 * 1024, 4096, 1024, (bf16_t*)(a.ws + WS_W2) + (size_t)l * 1024 * 4096, 0, scr, r % I_DN, lane); }
        }
        (void)ws16;
    }
}

__device__ __forceinline__ void shw_jobs(const Args& a, LAS unsigned char* lds, int tid, int lane, int wave, int bid, int G) {
    LAS float* S = (LAS float*)lds; LAS float* red = (LAS float*)(lds + 17 * 1024 * 4);
    const float* mod = (const float*)(a.ws + WS_MOD); float* shw = (float*)(a.ws + WS_SHW);
    __syncthreads();
#pragma unroll 1
    for (int job = 0; job < 3; ++job) {
        const int N = (job == 1) ? 3072 : 4096, nunits = N / 32, off = (job == 0) ? 0 : (job == 1) ? 128 : 224;
        const float* W = (job == 0) ? a.in[14] : (job == 1) ? a.in[11] : a.in[14] + (size_t)1024 * 4096;
        const float* sh = mod + (job == 0 ? 3 * 1024 : job == 1 ? 17 * 6144 : 17 * 6144 + 3 * 1024);
        float* out = shw + (job == 0 ? 0 : job == 1 ? 17 * 4096 : 17 * 4096 + 17 * 3072);
        int unit = bid - off; if (unit < 0) unit += G;
        if (unit < nunits) {
            for (int i = tid; i < 17 * 1024; i += 512) S[i] = sh[(size_t)(i >> 10) * 6144 + (i & 1023)];
            __syncthreads();
            for (; unit < nunits; unit += G) gemv17_unit(S, red, W, N, unit * 32, nullptr, out, N, tid, lane, wave);
        }
    }
}

__device__ __forceinline__ void norm_phase(const float* xlat, const float* xctx, int nrows, const float* g, const float* modl, int sh_chunk, int sc_chunk,
                                           bf16_t* H, float* outf, const float* rssf, int gw, int NGW, int lane) {
    constexpr int R = 4;
    const int ngroups = nrows / R;
    for (int grp = gw; grp < ngroups; grp += NGW) {
        f32x4 v[R][4]; float inv[R];
#pragma unroll
        for (int q = 0; q < R; ++q) { const int row = grp * R + q; const bool lat = row < MLAT;
            const f32x4* xr = (const f32x4*)(lat ? xlat + (size_t)row * DM : xctx + (size_t)(row - MLAT) * DM) + lane;
#pragma unroll
            for (int jx = 0; jx < 4; ++jx) v[q][jx] = xr[64 * jx]; }
        if (rssf) {
#pragma unroll
            for (int q = 0; q < R; ++q) inv[q] = rsqrtf(rssf[grp * R + q] * (1.f / DM) + RMS_EPS);
        } else {
            float s[R];
#pragma unroll
            for (int q = 0; q < R; ++q) { s[q] = 0.f;
#pragma unroll
                for (int jx = 0; jx < 4; ++jx) s[q] += (v[q][jx].x * v[q][jx].x + v[q][jx].y * v[q][jx].y) + (v[q][jx].z * v[q][jx].z + v[q][jx].w * v[q][jx].w); }
#pragma unroll
            for (int o = 1; o < 64; o <<= 1) {
#pragma unroll
                for (int q = 0; q < R; ++q) s[q] += __shfl_xor(s[q], o); }
#pragma unroll
            for (int q = 0; q < R; ++q) inv[q] = rsqrtf(s[q] * (1.f / DM) + RMS_EPS);
        }
        f32x4 mg[4], ms[4];
        if (modl) { const int row0_ = grp * R; const float* mr = modl + (size_t)(row0_ < MLAT ? (row0_ >> 11) : 16) * 6144;
#pragma unroll
            for (int jx = 0; jx < 4; ++jx) { const int c = 4 * lane + 256 * jx;
                mg[jx] = *(const f32x4*)(g + c) * (*(const f32x4*)(mr + sc_chunk * 1024 + c) + 1.0f); ms[jx] = *(const f32x4*)(mr + sh_chunk * 1024 + c); } }
#pragma unroll
        for (int q = 0; q < R; ++q) { const int row = grp * R + q;
            if (modl) {
                unsigned long long* o8 = (unsigned long long*)(H + (size_t)row * DM) + lane;
#pragma unroll
                for (int jx = 0; jx < 4; ++jx) {
                    const f32x4 o = (v[q][jx] * inv[q]) * mg[jx] + ms[jx];
                    o8[64 * jx] = (unsigned long long)pk2(o.x, o.y) | ((unsigned long long)pk2(o.z, o.w) << 32); }
            } else {
                f32x4* orow = (f32x4*)(outf + (size_t)row * DM) + lane;
#pragma unroll
                for (int jx = 0; jx < 4; ++jx) { const int c = 4 * lane + 256 * jx; const f32x4 gg = *(const f32x4*)(g + c); orow[64 * jx] = v[q][jx] * inv[q] * gg; }
            }
        }
    }
}

__device__ __forceinline__ void final_phase(const bf16_t* xb, const float* rssf, const float* g, float* out, int gw, int NGW, int lane) {
    constexpr int R = 4;
    for (int grp = gw; grp < MLAT / R; grp += NGW) {
        u32x4 v[R][2];
#pragma unroll
        for (int q = 0; q < R; ++q)
#pragma unroll
            for (int jx = 0; jx < 2; ++jx) v[q][jx] = *(const u32x4*)(xb + (size_t)(grp * R + q) * DM + jx * 512 + lane * 8);
        f32x4 gv0[2], gv1[2];
#pragma unroll
        for (int jx = 0; jx < 2; ++jx) { const int c = jx * 512 + lane * 8; gv0[jx] = *(const f32x4*)(g + c); gv1[jx] = *(const f32x4*)(g + c + 4); }
#pragma unroll
        for (int q = 0; q < R; ++q) { const int row = grp * R + q; const float inv = rsqrtf(rssf[row] * (1.f / DM) + RMS_EPS);
#pragma unroll
            for (int jx = 0; jx < 2; ++jx) { const int c = jx * 512 + lane * 8; const f32x4 g0 = gv0[jx], g1 = gv1[jx]; const u32x4 w = v[q][jx];
                const f32x4 x0 = (f32x4){bf_lo(w.x), bf_hi(w.x), bf_lo(w.y), bf_hi(w.y)}, x1 = (f32x4){bf_lo(w.z), bf_hi(w.z), bf_lo(w.w), bf_hi(w.w)};
                *(f32x4*)(out + (size_t)row * DM + c) = x0 * inv * g0; *(f32x4*)(out + (size_t)row * DM + c + 4) = x1 * inv * g1; } }
    }
}

__device__ __forceinline__ void unpack8(const u32x4 w, float (&f)[8]) { f[0] = bf_lo(w.x); f[1] = bf_hi(w.x); f[2] = bf_lo(w.y); f[3] = bf_hi(w.y); f[4] = bf_lo(w.z); f[5] = bf_hi(w.z); f[6] = bf_lo(w.w); f[7] = bf_hi(w.w); }
__device__ __forceinline__ void unpack4(const u32x2 w, float (&f)[4]) { f[0] = bf_lo(w.x); f[1] = bf_hi(w.x); f[2] = bf_lo(w.y); f[3] = bf_hi(w.y); }
__device__ __forceinline__ void convgate_phase(const bf16_t* U, const bf16_t* Bg, const float* cw, bf16_t* Gout, int gw, int NGW, int lane) {
    constexpr int RC = 8;
    for (int item = gw; item < (MALL / RC) * 4; item += NGW) {
        const int chunk = item >> 2, strip = item & 3, t0 = chunk * RC, ch = strip * 256 + lane * 4;
        const int tl = t0 < MLAT ? (t0 & (SEQ - 1)) : ((t0 - MLAT) & (CTXL - 1)); const int sl = t0 < MLAT ? SEQ : CTXL;
        const bool first = (tl == 0), lastc = (tl + RC == sl);
        const f32x4 w0 = *(const f32x4*)(cw + ch), w1 = *(const f32x4*)(cw + 1024 + ch), w2 = *(const f32x4*)(cw + 2048 + ch);
        const bf16_t* up = U + (size_t)t0 * DM + ch; const bf16_t* bp = Bg + (size_t)t0 * DM + ch; bf16_t* gp = Gout + (size_t)t0 * DM + ch;
        const u32x2 zero = (u32x2){0u, 0u};
        u32x2 uw[RC + 2], bw[RC];
        uw[0] = first ? zero : *(const u32x2*)(up - DM);
#pragma unroll
        for (int t = 0; t < RC; ++t) { uw[t + 1] = *(const u32x2*)(up + (size_t)t * DM); bw[t] = *(const u32x2*)(bp + (size_t)t * DM); }
        uw[RC + 1] = lastc ? zero : *(const u32x2*)(up + (size_t)RC * DM);
#pragma unroll
        for (int t = 0; t < RC; ++t) {
            float pf[4], cf[4], nf[4], bf[4];
            unpack4(uw[t], pf); unpack4(uw[t + 1], cf); unpack4(uw[t + 2], nf); unpack4(bw[t], bf);
            float o[4];
#pragma unroll
            for (int e = 0; e < 4; ++e) o[e] = bf[e] * (w0[e] * pf[e] + w1[e] * cf[e] + w2[e] * nf[e]);
            u32x2 ow; ow.x = pk2(o[0], o[1]); ow.y = pk2(o[2], o[3]);
            *(u32x2*)(gp + (size_t)t * DM) = ow;
        }
    }
}

struct KBuf { bf16x8 k[2][2]; };
struct VBuf { bf16x8 v[4]; };
constexpr int VT_LD = MALL;
struct KVOff { unsigned k0, v0; };
typedef __amdgpu_buffer_rsrc_t rsrc_t;
__device__ __forceinline__ bf16x8 bload(rsrc_t r, unsigned voff, unsigned soff) { return __builtin_bit_cast(bf16x8, __builtin_amdgcn_raw_buffer_load_b128(r, (int)voff, (int)soff, 0)); }
__device__ __forceinline__ void k_load(KBuf& B, rsrc_t rk, const KVOff& f, int kt) {
    const unsigned sk = (unsigned)kt * 4096u;
    B.k[0][0] = bload(rk, f.k0, sk); B.k[0][1] = bload(rk, f.k0 + 64u, sk);
    B.k[1][0] = bload(rk, f.k0, sk + 16384u); B.k[1][1] = bload(rk, f.k0 + 64u, sk + 16384u);
}
__device__ __forceinline__ void v_load(VBuf& B, rsrc_t rv, const KVOff& f, int kt) {
    const unsigned sv = (unsigned)kt * 2u;
#pragma unroll
    for (int d = 0; d < 4; ++d) B.v[d] = bload(rv, f.v0, sv + (unsigned)d * (16u * VT_LD * 2u));
}
__device__ __forceinline__ float red16_max(float x) {
#if __has_builtin(__builtin_amdgcn_permlane16_swap)
    auto r = __builtin_amdgcn_permlane16_swap(__float_as_uint(x), __float_as_uint(x), false, false);
    x = fmaxf(__uint_as_float(r[0]), __uint_as_float(r[1]));
#else
    x = fmaxf(x, __shfl_xor(x, 16));
#endif
    auto q = __builtin_amdgcn_permlane32_swap(__float_as_uint(x), __float_as_uint(x), false, false);
    return fmaxf(__uint_as_float(q[0]), __uint_as_float(q[1]));
}
__device__ __forceinline__ float red16_sum(float x) {
#if __has_builtin(__builtin_amdgcn_permlane16_swap)
    auto r = __builtin_amdgcn_permlane16_swap(__float_as_uint(x), __float_as_uint(x), false, false);
    x = __uint_as_float(r[0]) + __uint_as_float(r[1]);
#else
    x = x + __shfl_xor(x, 16);
#endif
    auto q = __builtin_amdgcn_permlane32_swap(__float_as_uint(x), __float_as_uint(x), false, false);
    return __uint_as_float(q[0]) + __uint_as_float(q[1]);
}
__device__ __forceinline__ void attn_step(const KBuf& B, const VBuf& V, const bf16x8 (&qf)[2], f32x4 c0, f32x4 c1, float& m, float& l, f32x4 (&o)[4]) {
    f32x4 s0 = __builtin_amdgcn_mfma_f32_16x16x32_bf16(B.k[0][0], qf[0], c0, 0, 0, 0);
    f32x4 s1 = __builtin_amdgcn_mfma_f32_16x16x32_bf16(B.k[1][0], qf[0], c1, 0, 0, 0);
    s0 = __builtin_amdgcn_mfma_f32_16x16x32_bf16(B.k[0][1], qf[1], s0, 0, 0, 0);
    s1 = __builtin_amdgcn_mfma_f32_16x16x32_bf16(B.k[1][1], qf[1], s1, 0, 0, 0);
    float mx = fmaxf(fmaxf(fmaxf(s0[0], s0[1]), fmaxf(s0[2], s0[3])), fmaxf(fmaxf(s1[0], s1[1]), fmaxf(s1[2], s1[3])));
    mx = red16_max(mx);
    const float mn = fmaxf(m, mx);
    const float alpha = __builtin_amdgcn_exp2f(m - mn);
    m = mn;
    f32x4 p0, p1;
#pragma unroll
    for (int e = 0; e < 4; ++e) { p0[e] = __builtin_amdgcn_exp2f(s0[e] - mn); p1[e] = __builtin_amdgcn_exp2f(s1[e] - mn); }
    l = l * alpha + ((p0[0] + p0[1]) + (p0[2] + p0[3])) + ((p1[0] + p1[1]) + (p1[2] + p1[3]));
    u32x4 pw; pw.x = pk2(p0[0], p0[1]); pw.y = pk2(p0[2], p0[3]); pw.z = pk2(p1[0], p1[1]); pw.w = pk2(p1[2], p1[3]);
    const bf16x8 pf = __builtin_bit_cast(bf16x8, pw);
#pragma unroll
    for (int d = 0; d < 4; ++d) { o[d] = o[d] * alpha; o[d] = __builtin_amdgcn_mfma_f32_16x16x32_bf16(V.v[d], pf, o[d], 0, 0, 0); }
}

__device__ __forceinline__ void attn_step2(const KBuf& KA, const VBuf& VA, const KBuf& KB, const VBuf& VB, const bf16x8 (&qf)[2], f32x4 c0, f32x4 c1, float& m, float& l, f32x4 (&o)[4]) {
    const f32x4 z4 = (f32x4){0.f, 0.f, 0.f, 0.f};
    f32x4 a0 = __builtin_amdgcn_mfma_f32_16x16x32_bf16(KA.k[0][0], qf[0], z4, 0, 0, 0);
    f32x4 a1 = __builtin_amdgcn_mfma_f32_16x16x32_bf16(KA.k[1][0], qf[0], z4, 0, 0, 0);
    f32x4 b0 = __builtin_amdgcn_mfma_f32_16x16x32_bf16(KB.k[0][0], qf[0], c0, 0, 0, 0);
    f32x4 b1 = __builtin_amdgcn_mfma_f32_16x16x32_bf16(KB.k[1][0], qf[0], c1, 0, 0, 0);
    a0 = __builtin_amdgcn_mfma_f32_16x16x32_bf16(KA.k[0][1], qf[1], a0, 0, 0, 0);
    a1 = __builtin_amdgcn_mfma_f32_16x16x32_bf16(KA.k[1][1], qf[1], a1, 0, 0, 0);
    b0 = __builtin_amdgcn_mfma_f32_16x16x32_bf16(KB.k[0][1], qf[1], b0, 0, 0, 0);
    b1 = __builtin_amdgcn_mfma_f32_16x16x32_bf16(KB.k[1][1], qf[1], b1, 0, 0, 0);
    float mxa = fmaxf(fmaxf(fmaxf(a0[0], a0[1]), fmaxf(a0[2], a0[3])), fmaxf(fmaxf(a1[0], a1[1]), fmaxf(a1[2], a1[3])));
    float mxb = fmaxf(fmaxf(fmaxf(b0[0], b0[1]), fmaxf(b0[2], b0[3])), fmaxf(fmaxf(b1[0], b1[1]), fmaxf(b1[2], b1[3])));
    const float mx = red16_max(fmaxf(mxa, mxb));
    const float mn = fmaxf(m, mx);
    const float alpha = __builtin_amdgcn_exp2f(m - mn);
    m = mn;
    f32x4 pa0, pa1, pb0, pb1;
#pragma unroll
    for (int e = 0; e < 4; ++e) { pa0[e] = __builtin_amdgcn_exp2f(a0[e] - mn); pa1[e] = __builtin_amdgcn_exp2f(a1[e] - mn); pb0[e] = __builtin_amdgcn_exp2f(b0[e] - mn); pb1[e] = __builtin_amdgcn_exp2f(b1[e] - mn); }
    const f32x4 ps = (pa0 + pa1) + (pb0 + pb1);
    l = l * alpha + ((ps[0] + ps[1]) + (ps[2] + ps[3]));
    u32x4 wa, wb; wa.x = pk2(pa0[0], pa0[1]); wa.y = pk2(pa0[2], pa0[3]); wa.z = pk2(pa1[0], pa1[1]); wa.w = pk2(pa1[2], pa1[3]);
    wb.x = pk2(pb0[0], pb0[1]); wb.y = pk2(pb0[2], pb0[3]); wb.z = pk2(pb1[0], pb1[1]); wb.w = pk2(pb1[2], pb1[3]);
    const bf16x8 pfa = __builtin_bit_cast(bf16x8, wa), pfb = __builtin_bit_cast(bf16x8, wb);
#pragma unroll
    for (int d = 0; d < 4; ++d) { o[d] = o[d] * alpha; o[d] = __builtin_amdgcn_mfma_f32_16x16x32_bf16(VA.v[d], pfa, o[d], 0, 0, 0); o[d] = __builtin_amdgcn_mfma_f32_16x16x32_bf16(VB.v[d], pfb, o[d], 0, 0, 0); }
}

constexpr int TAB_LD = 48, TAB_ROWS = 15;
constexpr int CK_STRIDE = 144, CV_STRIDE = 528, RW_STRIDE = 144;
constexpr int LDS_TAB = 0, LDS_CK = 3072, LDS_CV = LDS_CK + CTXL * CK_STRIDE, LDS_RING = LDS_CV + HD * CV_STRIDE;
constexpr int ROWK_BYTES = 64 * RW_STRIDE, SLOT_BYTES = 2 * ROWK_BYTES, LDS_ATT_END = LDS_RING + 3 * SLOT_BYTES;
static_assert(TAB_ROWS * TAB_LD * 4 <= LDS_CK && LDS_ATT_END <= RING_BYTES, "attention LDS map");
__device__ __forceinline__ int rs_of(int r) { int v = r - 4; return v < 0 ? 0 : (v > 24 ? 24 : v); }
__device__ __forceinline__ void attn_phase(const bf16_t* QK, const bf16_t* VT, bf16_t* O, const float* rpb, LAS unsigned char* lds, int tid, int lane, int wave, int bid, int G) {
    LAS float* tab = (LAS float*)(lds + LDS_TAB);
    const int fr = lane & 15, fq = lane >> 4;
    const int j = wave & 3, rw = wave >> 2;
    const int kc0 = (j == 0) ? 0 : (j == 1) ? 8 : (j == 2) ? 24 : 32;
    unsigned bpk0 = 0u, bpk1 = 0u;
    { const int cq = 16 * j + fr; int cs = cq - 8; cs = cs < 0 ? 0 : (cs > 48 ? 48 : cs);
#pragma unroll
      for (int jj = 0; jj < 8; ++jj) { const int ck = kc0 + 8 * fq + jj; const bool valid = (ck >= cs) && (ck < cs + 16); const unsigned col = valid ? (unsigned)(ck - cq + 15) : 31u;
          if (jj < 4) bpk0 |= col << (8 * jj); else bpk1 |= col << (8 * (jj - 4)); } }
    LAS unsigned char* ckl = lds + LDS_CK + fr * CK_STRIDE + fq * 16;
    LAS unsigned char* cvl = lds + LDS_CV + fr * CV_STRIDE + fq * 16;
    const int klo = LDS_RING + (kc0 + 8 * (fr >> 2) + (fr & 3)) * RW_STRIDE + fq * 16;
    const int vlo = LDS_RING + ROWK_BYTES + fr * RW_STRIDE + (kc0 + 8 * fq) * 2;
    const int st_t = tid >> 3, st_ch = tid & 7;
    const int st_off = st_t * RW_STRIDE + st_ch * 16;
    for (int bh = bid; bh < NB * NH; bh += G) {
        const int b = bh >> 4, h = bh & 15;
        const int ctx_kt0 = MLAT + b * CTXL;
        const bf16_t* ksrc = QK + (size_t)(b * SEQ + st_t) * 2048 + 1024 + h * 64 + st_ch * 8;
        const bf16_t* vsrc = VT + (size_t)(h * 64 + st_t) * VT_LD + b * SEQ + st_ch * 8;
        __syncthreads();
        for (int i = tid; i < TAB_ROWS * TAB_LD; i += 512) { const int col = i % TAB_LD, dr = i / TAB_LD; tab[i] = col < 31 ? rpb[(h * TAB_ROWS + dr) * 31 + col] * LOG2E : -1e30f; }
        for (int p = tid; p < CTXL * 8; p += 512) { const int key = p >> 3, ch = p & 7, c = key >> 5, w = key & 31; const int slot = c * 32 + ((w >> 2) & 1) * 16 + (w >> 3) * 4 + (w & 3);
            *(LAS u32x4*)(lds + LDS_CK + slot * CK_STRIDE + ch * 16) = *(const u32x4*)(QK + (size_t)(ctx_kt0 + key) * 2048 + 1024 + h * 64 + ch * 8); }
        for (int p = tid; p < HD * 32; p += 512) { const int d = p >> 5, ch = p & 31;
            *(LAS u32x4*)(lds + LDS_CV + d * CV_STRIDE + ch * 16) = *(const u32x4*)(VT + (size_t)(h * 64 + d) * VT_LD + ctx_kt0 + ch * 8); }
#pragma unroll
        for (int s0 = 0; s0 < 2; ++s0) {
            *(LAS u32x4*)(lds + LDS_RING + s0 * SLOT_BYTES + st_off) = *(const u32x4*)(ksrc + (size_t)s0 * 64 * 2048);
            *(LAS u32x4*)(lds + LDS_RING + s0 * SLOT_BYTES + ROWK_BYTES + st_off) = *(const u32x4*)(vsrc + s0 * 64); }
        u32x4 kr0, vr0, kr1, vr1, kr2, vr2;
        kr2 = *(const u32x4*)(ksrc + (size_t)2 * 64 * 2048); vr2 = *(const u32x4*)(vsrc + 2 * 64);
        kr0 = *(const u32x4*)(ksrc + (size_t)3 * 64 * 2048); vr0 = *(const u32x4*)(vsrc + 3 * 64);
        kr1 = kr0; vr1 = vr0;
        asm volatile("s_waitcnt lgkmcnt(0)" ::: "memory"); __builtin_amdgcn_s_barrier(); asm volatile("" ::: "memory");
        int gslot = 0;
        int it = 0, sc = 0, n_cur = 8, rs_lo = 0;
        int r_ = rw, rsw_ = 0, tq0_ = b * SEQ + rw * 64 + j * 16;
        int itp = 0, sp = 4, np = 8, prow = 4;
        bf16x8 qf[2], qn[2]; float m = -1e30f, l = 0.f; f32x4 o[4];
        qf[0] = qf[1] = (bf16x8){0, 0, 0, 0, 0, 0, 0, 0};
#pragma unroll
        for (int ks = 0; ks < 2; ++ks) qn[ks] = *(const bf16x8*)(QK + (size_t)(b * SEQ + rw * 64 + j * 16 + fr) * 2048 + h * 64 + ks * 32 + fq * 8);
#pragma unroll
        for (int d = 0; d < 4; ++d) o[d] = (f32x4){0.f, 0.f, 0.f, 0.f};
#define ATT_STEP(KI, VI, KW, VW) do { \
            { const int row_ = itp < 16 ? prow : 0; KI = *(const u32x4*)(ksrc + (size_t)row_ * 64 * 2048); VI = *(const u32x4*)(vsrc + row_ * 64); } \
            ++prow; if (++sp >= np) { sp = 0; ++itp; prow = rs_of(2 * itp); np = 8 + rs_of(2 * itp + 1) - prow; } \
            if (it < 16) { \
                if (sc == 0) { qf[0] = qn[0]; qf[1] = qn[1]; \
                    m = -1e30f; l = 0.f; _Pragma("unroll") for (int d = 0; d < 4; ++d) o[d] = (f32x4){0.f, 0.f, 0.f, 0.f}; } \
                if (sc == n_cur - 2) { const int tqn_ = tq0_ + (it < 15 ? 128 : 0);        \
                    _Pragma("unroll") for (int ks = 0; ks < 2; ++ks) qn[ks] = *(const bf16x8*)(QK + (size_t)(tqn_ + fr) * 2048 + h * 64 + ks * 32 + fq * 8); } \
                const int c_ = rs_lo + sc - rsw_; \
                if (c_ >= 0 && c_ < 8) { \
                    KBuf kc_, kl_; VBuf vc_, vl_; \
                    const LAS unsigned char* cks = ckl + c_ * 32 * CK_STRIDE; const LAS unsigned char* cvs = cvl + c_ * 64; \
                    const LAS unsigned char* lk = lds + klo + gslot * SLOT_BYTES; const LAS unsigned char* lv = lds + vlo + gslot * SLOT_BYTES; \
                    _Pragma("unroll") for (int T = 0; T < 2; ++T) _Pragma("unroll") for (int ks = 0; ks < 2; ++ks) { \
                        kc_.k[T][ks] = *(const LAS bf16x8*)(cks + T * 16 * CK_STRIDE + ks * 64); kl_.k[T][ks] = *(const LAS bf16x8*)(lk + T * 4 * RW_STRIDE + ks * 64); } \
                    _Pragma("unroll") for (int d = 0; d < 4; ++d) { vc_.v[d] = *(const LAS bf16x8*)(cvs + d * 16 * CV_STRIDE); vl_.v[d] = *(const LAS bf16x8*)(lv + d * 16 * RW_STRIDE); } \
                    const int tb_ = (rsw_ - r_ + 7 + c_) * TAB_LD; f32x4 c0_, c1_; \
                    _Pragma("unroll") for (int e = 0; e < 4; ++e) { c0_[e] = tab[tb_ + (int)((bpk0 >> (8 * e)) & 255u)]; c1_[e] = tab[tb_ + (int)((bpk1 >> (8 * e)) & 255u)]; } \
                    attn_step2(kc_, vc_, kl_, vl_, qf, c0_, c1_, m, l, o); } \
                if (sc == n_cur - 1) { \
                    const float lt = red16_sum(l); const float rl = 1.0f / lt; \
                    bf16_t* op = O + (size_t)(tq0_ + fr) * DM + h * 64 + 4 * fq; \
                    _Pragma("unroll") for (int d = 0; d < 4; ++d) { const f32x4 v = o[d] * rl; u32x2 w; w.x = pk2(v[0], v[1]); w.y = pk2(v[2], v[3]); *(u32x2*)(op + d * 16) = w; } } \
                if (++sc >= n_cur) { sc = 0; ++it; rs_lo = rs_of(2 * it); const int rs_hi_ = rs_of(2 * it + 1); n_cur = 8 + rs_hi_ - rs_lo; \
                    r_ = 2 * it + rw; rsw_ = rw ? rs_hi_ : rs_lo; tq0_ = b * SEQ + r_ * 64 + j * 16; } } \
            { int wslot = gslot + 2; wslot = wslot >= 3 ? wslot - 3 : wslot; \
              *(LAS u32x4*)(lds + LDS_RING + wslot * SLOT_BYTES + st_off) = KW; *(LAS u32x4*)(lds + LDS_RING + wslot * SLOT_BYTES + ROWK_BYTES + st_off) = VW; } \
            asm volatile("s_waitcnt lgkmcnt(0)" ::: "memory"); __builtin_amdgcn_s_barrier(); asm volatile("" ::: "memory"); \
            gslot = gslot == 2 ? 0 : gslot + 1; } while (0)
#pragma unroll 1
        for (int g = 0; g < 141; g += 3) {
            ATT_STEP(kr1, vr1, kr2, vr2);
            ATT_STEP(kr2, vr2, kr0, vr0);
            ATT_STEP(kr0, vr0, kr1, vr1);
        }
#undef ATT_STEP
    }
}

#define XB_TMO      128
#define XB_XCNT(j)  (256  + 64 * (j))
#define XB_XSUB(j)  (1280 + 64 * (j))
#define XB_XGEN(j)  (2304 + 64 * (j))
#define XB_TOP      3328
#define XB_TOPGEN   3392
#define XCD_BAR_WORDS 3456
#define XB_SPIN_CAP (1u << 18)

__device__ __forceinline__ unsigned xb_ld(unsigned* p)              { return __hip_atomic_load(p, __ATOMIC_RELAXED, __HIP_MEMORY_SCOPE_AGENT); }
__device__ __forceinline__ unsigned xb_add(unsigned* p, unsigned v) { return __hip_atomic_fetch_add(p, v, __ATOMIC_RELAXED, __HIP_MEMORY_SCOPE_AGENT); }
__device__ __forceinline__ unsigned xb_xcc_id() { return (unsigned)__builtin_amdgcn_s_getreg((3 << 11) | 20) & 0xFu; }
#define XB_SPIN(cond, bar) do { unsigned _sp = 0; while (cond) { __builtin_amdgcn_s_sleep(1); \
    if ((++_sp & 255u) == 0u) { if (xb_ld(&(bar)[XB_TMO])) break; if (_sp > XB_SPIN_CAP) { atomicAdd(&(bar)[XB_TMO], 1u); break; } } } } while (0)

struct XcdBarrier {
    unsigned* bar; unsigned x;
    volatile LAS unsigned* st;
};

__device__ __forceinline__ XcdBarrier xcd_barrier_post(unsigned* bar, volatile LAS unsigned* st) {
    XcdBarrier b; b.bar = bar; b.x = xb_xcc_id(); b.st = st;
    if (threadIdx.x == 0) (void)xb_add(&bar[XB_XCNT(b.x)], 1u);
    return b;
}
__device__ __forceinline__ void xcd_barrier_complete(unsigned* bar, unsigned x, unsigned& nloc, unsigned& nx) {
    const unsigned G = gridDim.x * gridDim.y * gridDim.z;
    unsigned sum, cnt, mine, sp = 0u;
    for (;;) {
        sum = 0u; cnt = 0u; mine = 0u;
#pragma unroll
        for (unsigned j = 0; j < 16; ++j) { const unsigned c = xb_ld(&bar[XB_XCNT(j)]); sum += c; cnt += (c > 0u) ? 1u : 0u; mine = (j == x) ? c : mine; }
        if (sum == G) break;
        __builtin_amdgcn_s_sleep(1);
        if ((++sp & 255u) == 0u) { if (xb_ld(&bar[XB_TMO])) break; if (sp > XB_SPIN_CAP) { atomicAdd(&bar[XB_TMO], 1u); break; } }
    }
    nloc = mine > 0u ? mine : 1u; nx = cnt > 0u ? cnt : 1u;
}

__device__ __forceinline__ void xcd_barrier(const XcdBarrier& b) {
    asm volatile("s_waitcnt vmcnt(0)" ::: "memory");
    __syncthreads();
    if (threadIdx.x == 0) {
        unsigned* bar = b.bar;
        __builtin_amdgcn_s_waitcnt(0);
        unsigned nloc = b.st[0], nx = b.st[1];
        if (nloc == 0u) { xcd_barrier_complete(bar, b.x, nloc, nx); b.st[0] = nloc; b.st[1] = nx; }
        const unsigned old = xb_add(&bar[XB_XSUB(b.x)], 1u);
        const unsigned gen = old / nloc;
        if (old + 1u == (gen + 1u) * nloc) {
            __builtin_amdgcn_fence(__ATOMIC_RELEASE, "agent");
            asm volatile("s_waitcnt vmcnt(0)" ::: "memory");
            const unsigned og = xb_add(&bar[XB_TOP], 1u);
            const unsigned tg = og / nx;
            if (og + 1u == (tg + 1u) * nx) xb_add(&bar[XB_TOPGEN], 1u);
            else XB_SPIN(xb_ld(&bar[XB_TOPGEN]) == tg, bar);
            __builtin_amdgcn_fence(__ATOMIC_ACQUIRE, "agent");
            xb_add(&bar[XB_XGEN(b.x)], 1u);
            asm volatile("s_waitcnt vmcnt(0)" ::: "memory");
        } else {
            XB_SPIN(xb_ld(&bar[XB_XGEN(b.x)]) == gen, bar);
            __builtin_amdgcn_fence(__ATOMIC_ACQUIRE, "agent");
            asm volatile("s_waitcnt vmcnt(0)" ::: "memory");
        }
    }
    __syncthreads();
}


constexpr int NPHASE = 14;
__global__ void __launch_bounds__(512, 2) fwd_mega(Args args) {
    extern __shared__ __attribute__((aligned(16))) unsigned char lds_raw[];
    LAS unsigned char* lds = (LAS unsigned char*)lds_raw;
    cg::grid_group grid = cg::this_grid();
    const int G = gridDim.x, bid = blockIdx.x, NGW = G * 8;
    unsigned char* ws = args.ws;
    const float* x = args.in[0]; const float* ctx = args.in[2];
    const float* norm1_g = args.in[4]; const float* norm2_g = args.in[5];
    const float* conv_w = args.in[9]; const float* rpb = args.in[12]; const float* final_g = args.in[16];
    float* mod = (float*)(ws + WS_MOD);
    bf16_t* SHA = (bf16_t*)(ws + WS_SHA);
    bf16_t* H = (bf16_t*)(ws + WS_H); bf16_t* H2 = (bf16_t*)(ws + WS_H2); float* rss = (float*)(ws + WS_RSS); float* shw = (float*)(ws + WS_SHW);
    bf16_t* Xctx = (bf16_t*)(ws + WS_XCTX);
    bf16_t* Xlat = (bf16_t*)args.out;
    bf16_t* BIG = (bf16_t*)(ws + WS_BIG);
    bf16_t* U = BIG; bf16_t* Bg = BIG + (size_t)MALL * 1024;
    bf16_t* HID = BIG;
    bf16_t* QK = BIG; bf16_t* VT = BIG + (size_t)MALL * 2048;
    bf16_t* Wcin = (bf16_t*)(ws + WS_WCIN); bf16_t* Wcout = (bf16_t*)(ws + WS_WCOUT); bf16_t* Wqkv = (bf16_t*)(ws + WS_WQKV); bf16_t* Wao = (bf16_t*)(ws + WS_WAO);
    bf16_t* W1 = (bf16_t*)(ws + WS_W1); bf16_t* W2 = (bf16_t*)(ws + WS_W2);

#ifndef PROBE_PH
#define PROBE_PH -1
#endif
#ifndef PROBE_PH2
#define PROBE_PH2 -1
#endif
    if (threadIdx.x < 32) ((volatile LAS unsigned*)(lds + MISC_OFF))[threadIdx.x] = 0u;
    __syncthreads();
    const XcdBarrier xbar = xcd_barrier_post((unsigned*)(ws + WS_CTL), (volatile LAS unsigned*)(lds + MISC_OFF) + 8);
    if (args.ph_lo < 0) grid.sync();
    for (int ph = args.ph_lo; ph < args.ph_hi; ++ph) {
      for (int rep = 0; rep < ((ph == PROBE_PH || ph == PROBE_PH2) ? 2 : 1); ++rep) {
        if (rep) xcd_barrier(xbar);
        int tid = threadIdx.x; asm volatile("" : "+v"(tid));
        const int lane = tid & 63, wave = __builtin_amdgcn_readfirstlane(tid >> 6), gw = bid * 8 + wave;
        int kind = 0;
        bool sync_after = true;
        pg8::Gemm g{nullptr, nullptr, 0, 0, 0}; int cidx = bid;
        pg8::EpiU E{}; E.mode = 0; E.O = nullptr; E.O2 = nullptr; E.ldc = 0; E.scale_tiles = 0; E.sc = 1.f; E.rss = nullptr; E.shw = nullptr; E.shw_ld = 0; E.inLat = nullptr; E.inCtx = nullptr; E.inbLat = nullptr; E.inbCtx = nullptr; E.outLat = nullptr; E.outCtx = nullptr; E.gate = nullptr;
        E.An = nullptr; E.gn = nullptr; E.scn = nullptr; E.rssn = nullptr; E.outf5 = nullptr;
        switch (ph) {
        case 0: p0_phase(args, lds, tid, lane, wave, bid, G); break;
        case 1: norm_phase(x, ctx, MALL, norm1_g, mod, 0, 1, H, nullptr, nullptr, gw, NGW, lane);
                for (int i = bid * 512 + tid; i < 3 * 17 * 1024; i += G * 512) { const int jb = i / (17 * 1024), rr = (i / 1024) % 17, k = i & 1023;
                    const float* shp = mod + (jb == 0 ? 3 * 1024 : jb == 1 ? 17 * 6144 : 17 * 6144 + 3 * 1024) + (size_t)rr * 6144;
                    SHA[(size_t)(jb * 256 + rr) * 1024 + k] = (bf16_t)f2bf(shp[k]); }
                break;
        case 2: kind = 1; g = pg8::Gemm{H, Wcin, MALL, 3072, 1024}; E.mode = 2; E.O = U; E.O2 = Bg; break;
        case 3: convgate_phase(U, Bg, conv_w, H, gw, NGW, lane); break;
        case 4: kind = 1; g = pg8::Gemm{H, Wcout, MALL, 1024, 1024}; E.mode = 3; E.inLat = x; E.inCtx = ctx; E.outLat = Xlat; E.outCtx = Xctx; E.gate = mod + 2 * 1024;
                E.An = H2; E.gn = norm2_g; E.scn = mod + 4 * 1024; E.rssn = rss; break;
        case 5: kind = 1; g = pg8::Gemm{H2, W1, MALL, 4096, 1024}; E.mode = 1; E.O = HID; E.ldc = 4096; E.rss = rss; E.shw = shw; E.shw_ld = 4096; break;
        case 6: case 7:
                kind = 1; g = pg8::Gemm{HID, W2, MLAT, 1024, 4096}; E.mode = 3; E.inbLat = Xlat; E.inbCtx = Xctx; E.outLat = Xlat; E.outCtx = Xctx; E.gate = mod + 5 * 1024;
                E.An = H; E.gn = norm1_g + 1024; E.scn = mod + 17 * 6144 + 1 * 1024; E.rssn = rss + MALL; break;
        case 8: kind = 1; break;
        case 9: attn_phase(QK, VT, H2, rpb, lds, tid, lane, wave, bid, G); break;
        case 10: kind = 1; g = pg8::Gemm{H2, Wao, MLAT, 1024, 1024}; E.mode = 3; E.inbLat = Xlat; E.inbCtx = Xctx; E.outLat = Xlat; E.outCtx = Xctx; E.gate = mod + 17 * 6144 + 2 * 1024;
                E.An = H; E.gn = norm2_g + 1024; E.scn = mod + 17 * 6144 + 4 * 1024; E.rssn = rss + 2 * MALL; break;
        case 11: kind = 1; g = pg8::Gemm{H, W1 + (size_t)4096 * 1024, MLAT, 4096, 1024}; E.mode = 1; E.O = HID; E.ldc = 4096; E.rss = rss + 2 * MALL; E.shw = shw + 17 * 4096 + 17 * 3072; E.shw_ld = 4096; break;
        case 12: kind = 1; g = pg8::Gemm{HID, W2 + (size_t)4096 * 1024, MLAT, 1024, 4096}; E.mode = 3; E.inbLat = Xlat; E.inbCtx = Xctx; E.outLat = H2; E.outCtx = Xctx; E.gate = mod + 17 * 6144 + 5 * 1024;
                E.rssn = rss + 3 * MALL; break;
        case 13: final_phase(H2, rss + 3 * MALL, final_g, args.out, gw, NGW, lane); break;
        default: break;
        }
#ifndef NO_GEMM
        if (kind == 1) {
            const int qk_done = (G > 64) ? ((4 * (G - 64) < 1024) ? 4 * (G - 64) : 1024) : 0;
            const int nsub = (ph == 4) ? 4 : (ph == 8) ? 3 : 1;
            for (int sub = 0; sub < nsub; ++sub) {
                int Gs = G, pm0 = 0, lbeg = 0, lend = -1;
                if (ph == 4 && sub > 0) {
                    const int jb = sub - 1;
                    const int N5 = (jb == 1) ? 3072 : 4096;
                    g = pg8::Gemm{SHA + (size_t)jb * 256 * 1024, jb == 0 ? W1 : jb == 1 ? Wqkv : W1 + (size_t)4096 * 1024, 256, N5, 1024};
                    E.mode = 5; E.ldc = N5; E.outf5 = shw + (jb == 0 ? 0 : jb == 1 ? 17 * 4096 : 17 * 4096 + 17 * 3072); E.rss = nullptr; E.shw = nullptr;
                    cidx = (bid + G - ((G > 112) ? 64 + 16 * jb : 0)) % G;
                }
                const bool qk_role = (ph == 7 && G > 64 && bid >= 64) || (ph == 8 && sub < 2);
                if (ph == 7 && !qk_role) { g.M = MCTX; pm0 = MLAT / 256; Gs = (G > 64) ? 64 : G; cidx = bid; }
                if (qk_role) {
                    g = pg8::Gemm{H, Wqkv, MLAT, 2048, 1024}; E.mode = 0; E.O = QK; E.ldc = 2048; E.scale_tiles = 4; E.sc = QSCALE; E.rss = rss + MALL; E.shw = shw + 17 * 4096; E.shw_ld = 3072;
                    E.An = nullptr; E.rssn = nullptr;
                    if (ph == 7) { Gs = G - 64; cidx = bid - 64; lend = qk_done; }
                    else if (sub == 0) { lbeg = qk_done; }
                    else { g.M = MCTX; pm0 = MLAT / 256; cidx = (bid + G - G / 2) % G; }
                }
                if (ph == 8 && sub == 2) { g = pg8::Gemm{Wqkv + (size_t)2048 * 1024, H, 1024, MALL, 1024}; E.mode = 4; E.O = VT; E.ldc = VT_LD; E.rss = rss + MALL; E.shw = shw + 17 * 4096; E.shw_ld = 3072; cidx = bid; }
                pg8::StaticOrder S; S.init(g.M, g.N, Gs, cidx, pm0, lbeg, lend);
                pg8::gemm_phase<pg8::EpiU, pg8::StaticOrder, true, true>(lds, g, S, E);
            }
        } else
#endif
        {}
      }
        if (ph + 1 < args.ph_hi) xcd_barrier(xbar);
    }
}

extern "C" void kernel_launch(void* const* d_in, const int* in_sizes, int n_in, void* d_out, int out_size, void* d_ws, size_t ws_size, hipStream_t stream) {
    static int grid = 0;
    if (grid == 0) {
        if (n_in != 17 || ws_size < WS_END) { fprintf(stderr, "kernel_launch: unexpected n_in %d / ws_size %zu\n", n_in, ws_size); grid = -1; return; }
        int dev = 0, cus = 0, per_cu = 0;
        hipGetDevice(&dev); hipDeviceGetAttribute(&cus, hipDeviceAttributeMultiprocessorCount, dev);
        if (hipFuncSetAttribute((const void*)fwd_mega, hipFuncAttributeMaxDynamicSharedMemorySize, LDS_BYTES) != hipSuccess) { fprintf(stderr, "kernel_launch: hipFuncSetAttribute failed\n"); grid = -1; return; }
        if (hipOccupancyMaxActiveBlocksPerMultiprocessor(&per_cu, (const void*)fwd_mega, 512, LDS_BYTES) != hipSuccess || per_cu < 1) { fprintf(stderr, "kernel_launch: occupancy query says %d\n", per_cu); per_cu = 1; }
        (void)hipGetLastError();
        grid = cus * (per_cu > 1 ? 1 : per_cu);
        if (grid <= 0) grid = 256;
    }
    if (grid < 0) return;
    if (hipMemsetAsync((char*)d_ws + WS_CTL, 0, CTL_BYTES, stream) != hipSuccess) { fprintf(stderr, "kernel_launch: memset failed\n"); return; }
    Args a{};
    for (int i = 0; i < 17; ++i) a.in[i] = (const float*)d_in[i];
    a.out = (float*)d_out; a.ws = (unsigned char*)d_ws;
#if MK_N_LAUNCHES == 1
    a.ph_lo = 0; a.ph_hi = NPHASE;
    void* kargs[] = {&a};
    hipError_t e = hipLaunchCooperativeKernel((const void*)fwd_mega, dim3(grid), dim3(512), kargs, LDS_BYTES, stream);
    if (e != hipSuccess) fprintf(stderr, "kernel_launch: cooperative launch failed: %s (grid %d)\n", hipGetErrorString(e), grid);
#else
    for (int ph = 0; ph < NPHASE; ++ph) {
        a.ph_lo = ph; a.ph_hi = ph + 1;
        hipLaunchKernelGGL(fwd_mega, dim3(grid), dim3(512), LDS_BYTES, stream, a);
    }
#endif
}
```

```cpp
#include <hip/hip_runtime.h>
#include <hip/hip_cooperative_groups.h>
#include <cstdio>
#include <cstdint>
namespace cg = cooperative_groups;

#ifndef MK_N_LAUNCHES
#define MK_N_LAUNCHES 1
#endif

#define LAS __attribute__((address_space(3)))
typedef unsigned short bf16_t;
typedef short bf16x8 __attribute__((ext_vector_type(8)));
typedef float f32x4 __attribute__((ext_vector_type(4)));
typedef unsigned u32x4 __attribute__((ext_vector_type(4)));
typedef unsigned u32x2 __attribute__((ext_vector_type(2)));

constexpr int DM = 1024, NB = 16, SEQ = 2048, CTXL = 256, NH = 16, HD = 64, FF = 4096;
constexpr int MLAT = NB * SEQ;
constexpr int MCTX = NB * CTXL;
constexpr int MALL = MLAT + MCTX;
constexpr float RMS_EPS = 1e-6f;
constexpr float LOG2E = 1.4426950408889634f;
constexpr float QSCALE = 0.125f * LOG2E;

constexpr size_t MiB = 1u << 20;
constexpr size_t WS_SHW = 0;
constexpr size_t WS_MOD = 1 * MiB;
constexpr size_t WS_WCIN = 2 * MiB;
constexpr size_t WS_WCOUT = 8 * MiB;
constexpr size_t WS_WQKV = 10 * MiB;
constexpr size_t WS_WAO = 16 * MiB;
constexpr size_t WS_W1 = 18 * MiB;
constexpr size_t WS_W2 = 34 * MiB;
constexpr size_t WS_H = 50 * MiB;
constexpr size_t WS_XCTX = 122 * MiB;
constexpr size_t WS_BIG = 138 * MiB;
constexpr size_t WS_H2 = 426 * MiB;
constexpr size_t WS_RSS = 498 * MiB;
constexpr size_t WS_CTL = 498 * MiB + 640 * 1024;
constexpr size_t CTL_BYTES = 16384;
constexpr size_t WS_SHA = 500 * MiB;
constexpr size_t WS_END = 502 * MiB;

constexpr int RING_BYTES = 131072;
constexpr int LDS_BYTES = 147456;
constexpr int MISC_OFF = RING_BYTES + 320;

namespace pg8 {
constexpr int BM = 256, BK = 64, HALF = 128, HTB = HALF * BK * 2, STAGE_BYTES = 8 * HTB, NXCD = 8, WGM = 8;
__host__ __device__ __forceinline__ int lds_byte(int r, int c) { const int st = (r >> 4) * 2 + (c >> 5), rr = r & 15, cc = c & 31, ob = rr * 64 + cc * 2; return st * 1024 + (ob ^ (((ob >> 9) & 1) << 5)); }
__host__ __device__ __forceinline__ void stage_rc(int b, int& R, int& C) { const int st = b / 1024, sb = b % 1024, swz = sb ^ (((sb >> 9) & 1) << 5); R = (st >> 1) * 16 + swz / 64; C = (st & 1) * 32 + (swz % 64) / 2; }
__host__ __device__ __forceinline__ int perm32(int rho) { const int n = rho >> 4, i = rho & 15; return 8 * (i >> 2) + 4 * n + (i & 3); }

struct Unit { int pm, pn; };
struct Gemm { const bf16_t* A; const bf16_t* Bt; int M, N, K; };

struct StaticOrder {
    int nM, nN, nwg, G, c, pm0, lbeg, lend;
    __host__ __device__ void init(int M, int N, int G_, int c_, int pm0_ = 0, int lbeg_ = 0, int lend_ = -1) { nM = M / BM; nN = N / BM; nwg = nM * nN; G = G_; c = c_; pm0 = pm0_; lbeg = lbeg_; lend = lend_ < 0 ? nwg : lend_; }
    __host__ __device__ bool next(int i, Unit& u) const {
        const long L = (long)lbeg + (long)i * G + c; if (L >= lend) return false;
        int wgid = (int)L; { const int q = nwg / NXCD, r = nwg % NXCD, xcd = wgid % NXCD, off = wgid / NXCD; wgid = (xcd < r ? xcd * (q + 1) : r * (q + 1) + (xcd - r) * q) + off; }
        const int nig = WGM * nN, gid = wgid / nig, fm = gid * WGM, gsz = (nM - fm) < WGM ? (nM - fm) : WGM;
        u.pm = pm0 + fm + ((wgid % nig) % gsz); u.pn = (wgid % nig) / gsz; return true;
    }
};

__device__ __forceinline__ unsigned cvt_pk_bf16(float lo, float hi) { unsigned r; asm volatile("v_cvt_pk_bf16_f32 %0, %1, %2" : "=v"(r) : "v"(lo), "v"(hi)); return r; }

__device__ __forceinline__ float xsum16(float x) {
    auto r = __builtin_amdgcn_permlane16_swap(__float_as_uint(x), __float_as_uint(x), false, false);
    x = __uint_as_float(r[0]) + __uint_as_float(r[1]);
    auto q = __builtin_amdgcn_permlane32_swap(__float_as_uint(x), __float_as_uint(x), false, false);
    return __uint_as_float(q[0]) + __uint_as_float(q[1]);
}
struct EpiU {
    int mode;
    bf16_t* O; bf16_t* O2; int ldc; int scale_tiles; float sc;
    const float* rss; const float* shw; int shw_ld;
    const float* inLat; const float* inCtx; const bf16_t* inbLat; const bf16_t* inbCtx; bf16_t* outLat; bf16_t* outCtx; const float* gate;
    float* outf5;
    bf16_t* An; const float* gn; const float* scn; float* rssn;
    __device__ __forceinline__ bool has_aux() const { return (mode <= 1 || mode == 4) && rss != nullptr; }
    __device__ __forceinline__ const float* aux_src(const Unit& u, int wid, int lane) const {
        const int i = (wid & 3) * 64 + lane;
        if (mode == 4) { const float* shp = shw + (size_t)(u.pn < (MLAT / BM) ? (u.pn >> 3) : 16) * shw_ld + 2048; return wid < 4 ? shp + u.pm * BM + i : rss + u.pn * BM + i; }
        return wid < 4 ? rss + u.pm * BM + i : shw + (size_t)(u.pm < (MLAT / BM) ? (u.pm >> 3) : 16) * shw_ld + u.pn * BM + i;
    }
    __device__ __forceinline__ void operator()(const f32x4 (&acc)[2][2][4][2], const Unit& u, int wr, int wc, int fr, int fq, const LAS float* aux) const {
        const int row0 = u.pm * BM + wr * 64 + fr;
        if (mode == 5) {
            if (wr == 0) {
#pragma unroll
                for (int m = 0; m < 2; ++m) { const int row = m * 16 + fr;
                    if (row < 17) {
#pragma unroll
                        for (int bj = 0; bj < 2; ++bj)
#pragma unroll
                            for (int n = 0; n < 2; ++n) *(f32x4*)(outf5 + (size_t)row * ldc + u.pn * BM + bj * HALF + wc * 32 + 8 * fq + 4 * n) = acc[0][bj][m][n]; } }
            }
            return;
        }
        if (mode <= 1) {
            const float s = (u.pn < scale_tiles) ? sc : 1.f;
            const int col0 = u.pn * BM + wc * 32 + 8 * fq;
            f32x4 bv[2][2];
#pragma unroll
            for (int bj = 0; bj < 2; ++bj)
#pragma unroll
                for (int n = 0; n < 2; ++n) bv[bj][n] = rss ? *(const LAS f32x4*)(aux + 256 + wc * 32 + 8 * fq + bj * HALF + 4 * n) : (f32x4){0.f, 0.f, 0.f, 0.f};
#pragma unroll
            for (int ai = 0; ai < 2; ++ai)
#pragma unroll
                for (int m = 0; m < 4; ++m) { const int row = row0 + ai * HALF + m * 16; bf16_t* rowp = O + (size_t)row * ldc + col0;
                    const float rinv = rss ? __builtin_amdgcn_rsqf(aux[wr * 64 + fr + ai * HALF + m * 16] * (1.f / DM) + RMS_EPS) : 1.f;
#pragma unroll
                    for (int bj = 0; bj < 2; ++bj) { f32x4 v0 = acc[ai][bj][m][0] * rinv + bv[bj][0], v1 = acc[ai][bj][m][1] * rinv + bv[bj][1];
                        if (mode == 1) { v0 = __builtin_elementwise_max(v0, (f32x4){0.f, 0.f, 0.f, 0.f}); v1 = __builtin_elementwise_max(v1, (f32x4){0.f, 0.f, 0.f, 0.f}); v0 = v0 * v0; v1 = v1 * v1; }
                        v0 = v0 * s; v1 = v1 * s;
                        u32x4 w; w.x = cvt_pk_bf16(v0[0], v0[1]); w.y = cvt_pk_bf16(v0[2], v0[3]); w.z = cvt_pk_bf16(v1[0], v1[1]); w.w = cvt_pk_bf16(v1[2], v1[3]);
                        *(u32x4*)(rowp + bj * HALF) = w; } }
        } else if (mode == 4) {
            const int col0 = u.pn * BM + wc * 32 + 8 * fq;
            f32x4 cinv[2][2];
#pragma unroll
            for (int bj = 0; bj < 2; ++bj)
#pragma unroll
                for (int n = 0; n < 2; ++n) { const f32x4 q = *(const LAS f32x4*)(aux + 256 + wc * 32 + 8 * fq + bj * HALF + 4 * n);
#pragma unroll
                    for (int e = 0; e < 4; ++e) cinv[bj][n][e] = __builtin_amdgcn_rsqf(q[e] * (1.f / DM) + RMS_EPS); }
#pragma unroll
            for (int ai = 0; ai < 2; ++ai)
#pragma unroll
                for (int m = 0; m < 4; ++m) { const int row = row0 + ai * HALF + m * 16; bf16_t* rowp = O + (size_t)row * ldc + col0; const float bias = aux[wr * 64 + fr + ai * HALF + m * 16];
#pragma unroll
                    for (int bj = 0; bj < 2; ++bj) { const f32x4 v0 = acc[ai][bj][m][0] * cinv[bj][0] + bias, v1 = acc[ai][bj][m][1] * cinv[bj][1] + bias;
                        u32x4 w; w.x = cvt_pk_bf16(v0[0], v0[1]); w.y = cvt_pk_bf16(v0[2], v0[3]); w.z = cvt_pk_bf16(v1[0], v1[1]); w.w = cvt_pk_bf16(v1[2], v1[3]);
                        *(u32x4*)(rowp + bj * HALF) = w; } }
        } else if (mode == 2) {
            if (u.pn < 8) {
                const int col0 = u.pn * HALF + wc * 32 + 8 * fq;
#pragma unroll
                for (int ai = 0; ai < 2; ++ai)
#pragma unroll
                    for (int m = 0; m < 4; ++m) { bf16_t* rowp = O + (size_t)(row0 + ai * HALF + m * 16) * 1024 + col0;
                        const f32x4 v0 = acc[ai][0][m][0] * acc[ai][1][m][0], v1 = acc[ai][0][m][1] * acc[ai][1][m][1];
                        u32x4 w; w.x = cvt_pk_bf16(v0[0], v0[1]); w.y = cvt_pk_bf16(v0[2], v0[3]); w.z = cvt_pk_bf16(v1[0], v1[1]); w.w = cvt_pk_bf16(v1[2], v1[3]);
                        *(u32x4*)rowp = w; }
            } else {
                const int col0 = (u.pn - 8) * BM + wc * 32 + 8 * fq;
#pragma unroll
                for (int ai = 0; ai < 2; ++ai)
#pragma unroll
                    for (int m = 0; m < 4; ++m) { bf16_t* rowp = O2 + (size_t)(row0 + ai * HALF + m * 16) * 1024 + col0;
#pragma unroll
                        for (int bj = 0; bj < 2; ++bj) { const f32x4 v0 = acc[ai][bj][m][0], v1 = acc[ai][bj][m][1];
                            u32x4 w; w.x = cvt_pk_bf16(v0[0], v0[1]); w.y = cvt_pk_bf16(v0[2], v0[3]); w.z = cvt_pk_bf16(v1[0], v1[1]); w.w = cvt_pk_bf16(v1[2], v1[3]);
                            *(u32x4*)(rowp + bj * HALF) = w; } }
            }
        } else {
            const bool lat = u.pm < (MLAT / BM);
            const int prow = (lat ? u.pm : u.pm - MLAT / BM) * BM + wr * 64 + fr;
            const float* in = lat ? inLat : inCtx; const bf16_t* inb = lat ? inbLat : inbCtx; bf16_t* out = lat ? outLat : outCtx;
            const int brow = lat ? (u.pm >> 3) : 16;
            const float* gp = gate + (size_t)brow * 6144;
            const int col0 = u.pn * BM + wc * 32 + 8 * fq;
            f32x4 gv[2][2], gm[2][2];
#pragma unroll
            for (int bj = 0; bj < 2; ++bj)
#pragma unroll
                for (int n = 0; n < 2; ++n) { gv[bj][n] = *(const f32x4*)(gp + col0 + bj * HALF + 4 * n);
                    gm[bj][n] = An ? *(const f32x4*)(gn + col0 + bj * HALF + 4 * n) * (*(const f32x4*)(scn + (size_t)brow * 6144 + col0 + bj * HALF + 4 * n) + 1.0f) : (f32x4){0.f, 0.f, 0.f, 0.f}; }
#pragma unroll
            for (int ai = 0; ai < 2; ++ai)
#pragma unroll
                for (int m = 0; m < 4; ++m) { const size_t off = (size_t)(prow + ai * HALF + m * 16) * 1024 + col0; float ss = 0.f;
#pragma unroll
                    for (int bj = 0; bj < 2; ++bj) { f32x4 xo[2];
                        if (in) { xo[0] = *(const f32x4*)(in + off + bj * HALF); xo[1] = *(const f32x4*)(in + off + bj * HALF + 4); }
                        else { const u32x4 xw = *(const u32x4*)(inb + off + bj * HALF);
                            xo[0] = (f32x4){__builtin_bit_cast(float, xw.x << 16), __builtin_bit_cast(float, xw.x & 0xffff0000u), __builtin_bit_cast(float, xw.y << 16), __builtin_bit_cast(float, xw.y & 0xffff0000u)};
                            xo[1] = (f32x4){__builtin_bit_cast(float, xw.z << 16), __builtin_bit_cast(float, xw.z & 0xffff0000u), __builtin_bit_cast(float, xw.w << 16), __builtin_bit_cast(float, xw.w & 0xffff0000u)}; }
#pragma unroll
                        for (int n = 0; n < 2; ++n) { xo[n] = xo[n] + gv[bj][n] * acc[ai][bj][m][n];
                            ss += (xo[n][0] * xo[n][0] + xo[n][1] * xo[n][1]) + (xo[n][2] * xo[n][2] + xo[n][3] * xo[n][3]); }
                        { u32x4 w; w.x = cvt_pk_bf16(xo[0][0], xo[0][1]); w.y = cvt_pk_bf16(xo[0][2], xo[0][3]); w.z = cvt_pk_bf16(xo[1][0], xo[1][1]); w.w = cvt_pk_bf16(xo[1][2], xo[1][3]);
                          *(u32x4*)(out + off + bj * HALF) = w; }
                        if (An) { const f32x4 a0 = xo[0] * gm[bj][0], a1 = xo[1] * gm[bj][1];
                            u32x4 w; w.x = cvt_pk_bf16(a0[0], a0[1]); w.y = cvt_pk_bf16(a0[2], a0[3]); w.z = cvt_pk_bf16(a1[0], a1[1]); w.w = cvt_pk_bf16(a1[2], a1[3]);
                            *(u32x4*)(An + (size_t)(row0 + ai * HALF + m * 16) * 1024 + col0 + bj * HALF) = w; } }
                    if (rssn) { ss = xsum16(ss); if (fq == 0) atomicAdd(rssn + row0 + ai * HALF + m * 16, ss); }
                    if (m == 3) asm volatile("" ::: "memory"); }
        }
    }
};

template <class Epi, class Sched, bool ALIGN_EPI = false, bool SP2 = false>
__device__ __forceinline__ void gemm_phase(LAS unsigned char* lds, const Gemm g, const Sched& S, const Epi& E) {
    int tid = threadIdx.x; asm volatile("" : "+v"(tid));
    const int wid = __builtin_amdgcn_readfirstlane(tid >> 6), lane = tid & 63, wr = wid >> 2, wc = wid & 3, fr = lane & 15, fq = lane >> 4;
    const int K = g.K, nt = K / BK;
    unsigned voffA[2], voffB[2];
#pragma unroll
    for (int i = 0; i < 2; ++i) { int R, C; stage_rc(tid * 16 + i * 8192, R, C); const int Rb = (R & ~31) + perm32(R & 31);
        voffA[i] = (unsigned)(R * K + C) * 2u; voffB[i] = (unsigned)(Rb * K + C) * 2u; }
    const size_t kstep = (size_t)(BK * 2);
    const size_t hstep = (size_t)HALF * K * 2;
    const size_t tstep = 2 * hstep;
    const unsigned ldsw = (unsigned)wid * 1024u;
    const int aoff = lds_byte(wr * 64 + fr, fq * 8), boff = lds_byte(wc * 32 + fr, fq * 8);
#define PG8_SA(b, h) (((b) * 2 + (h)) * HTB)
#define PG8_SB(b, h) ((4 + (b) * 2 + (h)) * HTB)
#define PG8_STAGE(bufoff, gbase, voff) do { _Pragma("unroll") for (int _i = 0; _i < 2; ++_i) \
        __builtin_amdgcn_global_load_lds((const unsigned*)((const char*)(gbase) + (voff)[_i]), (LAS unsigned*)(lds + (bufoff) + ldsw + _i * 8192), 16, 0, 0); } while (0)
#define PG8_LDA(dst, b, h) do { _Pragma("unroll") for (int m = 0; m < 4; ++m) _Pragma("unroll") for (int k = 0; k < 2; ++k) dst[m][k] = *(const LAS bf16x8*)(lds + PG8_SA(b, h) + aoff + m * 2048 + k * 1024); } while (0)
#define PG8_LDB(dst, b, h) do { _Pragma("unroll") for (int n = 0; n < 2; ++n) _Pragma("unroll") for (int k = 0; k < 2; ++k) dst[n][k] = *(const LAS bf16x8*)(lds + PG8_SB(b, h) + boff + n * 2048 + k * 1024); } while (0)
#define PG8_MMA(ai, bj, At, Bt) do { __builtin_amdgcn_s_setprio(1); _Pragma("unroll") for (int m = 0; m < 4; ++m) _Pragma("unroll") for (int n = 0; n < 2; ++n) _Pragma("unroll") for (int k = 0; k < 2; ++k) \
        acc[ai][bj][m][n] = __builtin_amdgcn_mfma_f32_16x16x32_bf16(Bt[n][k], At[m][k], acc[ai][bj][m][n], 0, 0, 0); __builtin_amdgcn_s_setprio(0); } while (0)
#define PG8_WAIT_V(n) asm volatile("s_waitcnt vmcnt(" #n ")" ::: "memory")
#define PG8_WAIT_L(n) asm volatile("s_waitcnt lgkmcnt(" #n ")" ::: "memory")
#define PG8_BAR __builtin_amdgcn_s_barrier()
#define PG8_SCHED __builtin_amdgcn_sched_barrier(0)
    Unit cur, nxt; int ui = 0;
    if (!S.next(0, cur)) return;
    constexpr int AUX_OFF = STAGE_BYTES + 1024;
    const bool use_aux = E.has_aux();
    if (use_aux) __builtin_amdgcn_global_load_lds((const unsigned*)E.aux_src(cur, wid, lane), (LAS unsigned*)(lds + AUX_OFF + wid * 256), 4, 0, 0);
    f32x4 acc[2][2][4][2];
#pragma unroll
    for (int a = 0; a < 2; ++a)
#pragma unroll
        for (int b = 0; b < 2; ++b)
#pragma unroll
            for (int m = 0; m < 4; ++m)
#pragma unroll
                for (int n = 0; n < 2; ++n) acc[a][b][m][n] = (f32x4){0.f, 0.f, 0.f, 0.f};
    bf16x8 At[4][2], B0[2][2], B1[2][2];
    const char* cA = (const char*)g.A + (size_t)cur.pm * tstep; const char* cB = (const char*)g.Bt + (size_t)cur.pn * tstep;
    if constexpr (SP2) {
        PG8_STAGE(PG8_SB(0, 0), cB, voffB); PG8_STAGE(PG8_SB(0, 1), cB + hstep, voffB); PG8_STAGE(PG8_SA(0, 0), cA, voffA); PG8_STAGE(PG8_SA(0, 1), cA + hstep, voffA);
        if (wr == 1) PG8_BAR;
        PG8_WAIT_V(2); PG8_BAR;
        PG8_STAGE(PG8_SB(1, 0), cB + kstep, voffB); PG8_STAGE(PG8_SA(1, 0), cA + kstep, voffA); PG8_STAGE(PG8_SB(1, 1), cB + hstep + kstep, voffB);
        PG8_WAIT_V(6); PG8_BAR;
    } else {
        PG8_STAGE(PG8_SB(0, 0), cB, voffB); PG8_STAGE(PG8_SA(0, 0), cA, voffA); PG8_STAGE(PG8_SB(0, 1), cB + hstep, voffB); PG8_STAGE(PG8_SA(0, 1), cA + hstep, voffA);
        if (wr == 1) PG8_BAR;
        PG8_WAIT_V(4); PG8_BAR;
        PG8_STAGE(PG8_SB(1, 0), cB + kstep, voffB); PG8_STAGE(PG8_SA(1, 0), cA + kstep, voffA); PG8_STAGE(PG8_SB(1, 1), cB + hstep + kstep, voffB);
        PG8_WAIT_V(6); PG8_BAR;
    }
    for (;;) {
        const bool has_next = S.next(ui + 1, nxt);
        const char* nA = has_next ? (const char*)g.A + (size_t)nxt.pm * tstep : cA; const char* nB = has_next ? (const char*)g.Bt + (size_t)nxt.pn * tstep : cB;
        for (int t = 0; t < nt; t += 2) {
            const bool last = (t == nt - 2);
            const char* a1 = cA + (size_t)(t + 1) * kstep;
            const char* a2 = last ? nA : cA + (size_t)(t + 2) * kstep; const char* b2 = last ? nB : cB + (size_t)(t + 2) * kstep;
            const char* a3 = a2 + kstep; const char* b3 = b2 + kstep;
            if constexpr (SP2) {
            PG8_LDB(B0, 0, 0); PG8_LDB(B1, 0, 1); PG8_SCHED; PG8_LDA(At, 0, 0); PG8_STAGE(PG8_SA(1, 1), a1 + hstep, voffA);
            PG8_WAIT_V(8); PG8_WAIT_L(0); PG8_BAR; PG8_MMA(0, 0, At, B0); PG8_MMA(0, 1, At, B1); PG8_BAR; PG8_SCHED;
            PG8_LDA(At, 0, 1); PG8_STAGE(PG8_SB(0, 0), b2, voffB); PG8_STAGE(PG8_SB(0, 1), b2 + hstep, voffB); PG8_STAGE(PG8_SA(0, 0), a2, voffA);
            PG8_WAIT_V(8); PG8_WAIT_L(0); PG8_BAR; PG8_MMA(1, 0, At, B0); PG8_MMA(1, 1, At, B1); PG8_BAR; PG8_SCHED;
            PG8_LDB(B0, 1, 0); PG8_LDB(B1, 1, 1); PG8_SCHED; PG8_LDA(At, 1, 0); PG8_STAGE(PG8_SA(0, 1), a2 + hstep, voffA);
            PG8_WAIT_V(8); PG8_WAIT_L(0); PG8_BAR; PG8_MMA(0, 0, At, B0); PG8_MMA(0, 1, At, B1); PG8_BAR; PG8_SCHED;
            PG8_LDA(At, 1, 1); PG8_STAGE(PG8_SB(1, 0), b3, voffB); PG8_STAGE(PG8_SB(1, 1), b3 + hstep, voffB); PG8_STAGE(PG8_SA(1, 0), a3, voffA);
            PG8_WAIT_V(8); PG8_WAIT_L(0); PG8_BAR; PG8_MMA(1, 0, At, B0); PG8_MMA(1, 1, At, B1); PG8_BAR; PG8_SCHED;
            } else {
            PG8_LDB(B0, 0, 0); PG8_SCHED; PG8_LDA(At, 0, 0); PG8_STAGE(PG8_SA(1, 1), a1 + hstep, voffA);
            PG8_WAIT_L(8); PG8_BAR; PG8_WAIT_L(0); PG8_MMA(0, 0, At, B0); PG8_BAR; PG8_SCHED;
            PG8_LDB(B1, 0, 1); PG8_STAGE(PG8_SB(0, 0), b2, voffB);
            PG8_BAR; PG8_WAIT_L(0); PG8_MMA(0, 1, At, B1); PG8_BAR;
            PG8_LDA(At, 0, 1); PG8_STAGE(PG8_SA(0, 0), a2, voffA);
            PG8_BAR; PG8_WAIT_L(0); PG8_MMA(1, 0, At, B0); PG8_BAR; PG8_SCHED;
            PG8_STAGE(PG8_SB(0, 1), b2 + hstep, voffB);
            PG8_WAIT_V(6); PG8_BAR; PG8_MMA(1, 1, At, B1); PG8_BAR;
            PG8_LDB(B0, 1, 0); PG8_SCHED; PG8_LDA(At, 1, 0); PG8_STAGE(PG8_SA(0, 1), a2 + hstep, voffA);
            PG8_WAIT_L(8); PG8_BAR; PG8_WAIT_L(0); PG8_MMA(0, 0, At, B0); PG8_BAR; PG8_SCHED;
            PG8_LDB(B1, 1, 1); PG8_STAGE(PG8_SB(1, 0), b3, voffB);
            PG8_BAR; PG8_WAIT_L(0); PG8_MMA(0, 1, At, B1); PG8_BAR;
            PG8_LDA(At, 1, 1); PG8_STAGE(PG8_SA(1, 0), a3, voffA);
            PG8_BAR; PG8_WAIT_L(0); PG8_MMA(1, 0, At, B0); PG8_BAR; PG8_SCHED;
            PG8_STAGE(PG8_SB(1, 1), b3 + hstep, voffB);
            PG8_WAIT_V(6); PG8_BAR; PG8_MMA(1, 1, At, B1); PG8_BAR;
            }
        }
        if constexpr (ALIGN_EPI) { if (wr == 0) PG8_BAR; }
        E(acc, cur, wr, wc, fr, fq, (const LAS float*)(lds + AUX_OFF + (ui & 1) * 2048));
        if (use_aux && has_next) __builtin_amdgcn_global_load_lds((const unsigned*)E.aux_src(nxt, wid, lane), (LAS unsigned*)(lds + AUX_OFF + ((ui + 1) & 1) * 2048 + wid * 256), 4, 0, 0);
        if (!has_next) break;
#pragma unroll
        for (int a = 0; a < 2; ++a)
#pragma unroll
            for (int b = 0; b < 2; ++b)
#pragma unroll
                for (int m = 0; m < 4; ++m)
#pragma unroll
                    for (int n = 0; n < 2; ++n) acc[a][b][m][n] = (f32x4){0.f, 0.f, 0.f, 0.f};
        cur = nxt; cA = nA; cB = nB; ++ui;
        if constexpr (ALIGN_EPI) { if (wr == 1) PG8_BAR; }
    }
    PG8_WAIT_V(0);
    if constexpr (!ALIGN_EPI) { if (wr == 0) PG8_BAR; }
    PG8_BAR;
#undef PG8_SA
#undef PG8_SB
#undef PG8_STAGE
#undef PG8_LDA
#undef PG8_LDB
#undef PG8_MMA
#undef PG8_WAIT_V
#undef PG8_WAIT_L
#undef PG8_BAR
#undef PG8_SCHED
}
}

__device__ __forceinline__ unsigned f2bf(float f) { unsigned u = __builtin_bit_cast(unsigned, f); return (u + 0x7fffu + ((u >> 16) & 1u)) >> 16; }
__device__ __forceinline__ unsigned pk2(float lo, float hi) { return pg8::cvt_pk_bf16(lo, hi); }
__device__ __forceinline__ float bf_lo(unsigned w) { return __builtin_bit_cast(float, w << 16); }
__device__ __forceinline__ float bf_hi(unsigned w) { return __builtin_bit_cast(float, w & 0xffff0000u); }
__device__ __forceinline__ float wave_sum(float v) {
#pragma unroll
    for (int o = 1; o < 64; o <<= 1) v += __shfl_xor(v, o);
    return v;
}
#define LDS_WAIT() asm volatile("s_waitcnt lgkmcnt(0)" ::: "memory")

struct Args {
    const float* in[17];
    float* out; unsigned char* ws;
    int ph_lo, ph_hi;
};

struct TrDesc { const float* W; bf16_t* WT; int K, N, cinmap, item; };
__device__ __forceinline__ void tr_load(const TrDesc& d, float (&wv)[32], int lane) {
    const int nblk = d.N / 32, kb = d.item / nblk, nb = d.item % nblk, k0 = 64 * kb, n0 = 32 * nb;
#pragma unroll
    for (int i = 0; i < 32; ++i) { const int kk = 2 * i + (lane >> 5); wv[i] = d.W[(size_t)(k0 + kk) * d.N + n0 + (lane & 31)]; }
}
__device__ __forceinline__ void tr_store(const TrDesc& d, const float (&wv)[32], LAS float* scr, int lane) {
    const int K = d.K, nblk = d.N / 32, kb = d.item / nblk, nb = d.item % nblk, k0 = 64 * kb, n0 = 32 * nb;
#pragma unroll
    for (int i = 0; i < 32; ++i) { const int kk = 2 * i + (lane >> 5); scr[kk * 33 + (lane & 31)] = wv[i]; }
    LDS_WAIT(); asm volatile("" ::: "memory");
    int d0 = n0;
    if (d.cinmap) { if (n0 < 1024) d0 = 2048 + n0; else if (n0 < 2048) { const int ch = n0 - 1024; d0 = (ch >> 7) * 256 + (ch & 127); } else { const int ch = n0 - 2048; d0 = (ch >> 7) * 256 + 128 + (ch & 127); } }
    const int c = lane & 7;
#pragma unroll
    for (int j = 0; j < 4; ++j) { const int n = (lane >> 3) + 8 * j; const LAS float* sp = scr + (8 * c) * 33 + n;
        u32x4 o; o.x = pk2(sp[0 * 33], sp[1 * 33]); o.y = pk2(sp[2 * 33], sp[3 * 33]); o.z = pk2(sp[4 * 33], sp[5 * 33]); o.w = pk2(sp[6 * 33], sp[7 * 33]);
        *(u32x4*)(d.WT + (size_t)(d0 + n) * K + k0 + 8 * c) = o; }
    LDS_WAIT(); asm volatile("" ::: "memory");
}

__device__ __forceinline__ void gemv17_unit(const LAS float* S, LAS float* red, const float* W, int ldw, int n0, const float* bias, float* out, int ldo, int tid, int lane, int wave) {
    const float* Wp = W + n0 + (lane & 31);
    const int kbase = wave * 128 + (lane >> 5);
    float acc[17];
#pragma unroll
    for (int r = 0; r < 17; ++r) acc[r] = 0.f;
#pragma unroll 1
    for (int ib = 0; ib < 64; ib += 32) {
        float wv[32];
#pragma unroll
        for (int i = 0; i < 32; ++i) wv[i] = Wp[(size_t)(kbase + 2 * (ib + i)) * ldw];
#pragma unroll
        for (int i = 0; i < 32; ++i) { const int k = kbase + 2 * (ib + i);
#pragma unroll
            for (int r = 0; r < 17; ++r) acc[r] += S[r * 1024 + k] * wv[i]; }
    }
#pragma unroll
    for (int r = 0; r < 17; ++r) acc[r] += __shfl_xor(acc[r], 32);
    if (lane < 32) {
#pragma unroll
        for (int r = 0; r < 17; ++r) red[(wave * 17 + r) * 32 + lane] = acc[r]; }
    __syncthreads();
    for (int o = tid; o < 17 * 32; o += 512) { const int r = o >> 5, c2 = o & 31; float s = bias ? bias[n0 + c2] : 0.f;
#pragma unroll
        for (int w = 0; w < 8; ++w) s += red[(w * 17 + r) * 32 + c2];
        out[(size_t)r * ldo + n0 + c2] = s; }
    __syncthreads();
}

__device__ __forceinline__ void p0_phase(const Args& a, LAS unsigned char* lds, int tid, int lane, int wave, int bid, int G) {
    { float* rss = (float*)(a.ws + WS_RSS); for (int i = bid * 512 + tid; i < 4 * MALL; i += G * 512) rss[i] = 0.f; }
    {
        LAS float* S = (LAS float*)lds;
        LAS float* red = (LAS float*)(lds + 17 * 1024 * 4);
        const float* c = a.in[1]; const float* cc = a.in[3]; const float* ada_w = a.in[6]; const float* ada_b = a.in[7];
        float* mod = (float*)(a.ws + WS_MOD);
        for (int i = tid; i < 17 * 1024; i += 512) { const float v = i < 16384 ? c[i] : cc[i - 16384]; S[i] = v / (1.f + __expf(-v)); }
        __syncthreads();
        for (int unit = bid; unit < 384; unit += G) {
            const int l = unit / 192, n0 = (unit % 192) * 32;
            gemv17_unit(S, red, ada_w + (size_t)l * 1024 * 6144, 6144, n0, ada_b + l * 6144, mod + (size_t)l * 17 * 6144, 6144, tid, lane, wave);
        }
    }
    {
        LAS float* scr = (LAS float*)(lds + wave * 16384);
        const int gw = bid * 8 + wave, NGW = G * 8;
        constexpr int I_CIN = 16 * 96, I_SQ = 16 * 32, I_UP = 16 * 128, I_DN = 64 * 32;
        constexpr int NITEMS = 2 * I_CIN + 2 * I_SQ + 2 * I_UP + 2 * I_DN;
        bf16_t* ws16 = (bf16_t*)a.ws;
        auto desc = [&](int it) -> TrDesc {
            int r = it;
            if (r < I_CIN) return TrDesc{a.in[8], (bf16_t*)(a.ws + WS_WCIN), 1024, 3072, 1, r}; r -= I_CIN;
            if (r < I_CIN) return TrDesc{a.in[11], (bf16_t*)(a.ws + WS_WQKV), 1024, 3072, 0, r}; r -= I_CIN;
            if (r < I_SQ) return TrDesc{a.in[10], (bf16_t*)(a.ws + WS_WCOUT), 1024, 1024, 0, r}; r -= I_SQ;
            if (r < I_SQ) return TrDesc{a.in[13], (bf16_t*)(a.ws + WS_WAO), 1024, 1024, 0, r}; r -= I_SQ;
            if (r < 2 * I_UP) { const int l = r / I_UP; return TrDesc{a.in[14] + (size_t)l * 1024 * 4096, (bf16_t*)(a.ws + WS_W1) + (size_t)l * 4096 * 1024, 1024, 4096, 0, r % I_UP}; } r -= 2 * I_UP;
            { const int l = r / I_DN; return TrDesc{a.in[15] + (size_t)l * 4096 * 1024, (bf16_t*)(a.ws + WS_W2) + (size_t)l * 1024 * 4096, 4096, 1024, 0, r % I_DN}; }
        };
        float wA[32], wB[32]; TrDesc dA = desc(0), dB = dA;
        int it = gw; bool hA = it < NITEMS;
        if (hA) { dA = desc(it); tr_load(dA, wA, lane); }
        while (hA) {
            const int itB = it + NGW; const bool hB = itB < NITEMS;
            if (hB) { dB = desc(itB); tr_load(dB, wB, lane); }
            tr_store(dA, wA, scr, lane);
            if (!hB) break;
            it = itB + NGW; hA = it < NITEMS;
            if (hA) { dA = desc(it); tr_load(dA, wA, lane); }
            tr_store(dB, wB, scr, lane);
        }
        (void)ws16;
    }
}

__device__ __forceinline__ void shw_jobs(const Args& a, LAS unsigned char* lds, int tid, int lane, int wave, int bid, int G) {
    LAS float* S = (LAS float*)lds; LAS float* red = (LAS float*)(lds + 17 * 1024 * 4);
    const float* mod = (const float*)(a.ws + WS_MOD); float* shw = (float*)(a.ws + WS_SHW);
    __syncthreads();
#pragma unroll 1
    for (int job = 0; job < 3; ++job) {
        const int N = (job == 1) ? 3072 : 4096, nunits = N / 32, off = (job == 0) ? 0 : (job == 1) ? 128 : 224;
        const float* W = (job == 0) ? a.in[14] : (job == 1) ? a.in[11] : a.in[14] + (size_t)1024 * 4096;
        const float* sh = mod + (job == 0 ? 3 * 1024 : job == 1 ? 17 * 6144 : 17 * 6144 + 3 * 1024);
        float* out = shw + (job == 0 ? 0 : job == 1 ? 17 * 4096 : 17 * 4096 + 17 * 3072);
        int unit = bid - off; if (unit < 0) unit += G;
        if (unit < nunits) {
            for (int i = tid; i < 17 * 1024; i += 512) S[i] = sh[(size_t)(i >> 10) * 6144 + (i & 1023)];
            __syncthreads();
            for (; unit < nunits; unit += G) gemv17_unit(S, red, W, N, unit * 32, nullptr, out, N, tid, lane, wave);
        }
    }
}

__device__ __forceinline__ void norm_phase(const float* xlat, const float* xctx, int nrows, const float* g, const float* modl, int sh_chunk, int sc_chunk,
                                           bf16_t* H, float* outf, const float* rssf, int gw, int NGW, int lane) {
    constexpr int R = 4;
    const int ngroups = nrows / R;
    for (int grp = gw; grp < ngroups; grp += NGW) {
        f32x4 v[R][4]; float inv[R];
#pragma unroll
        for (int q = 0; q < R; ++q) { const int row = grp * R + q; const bool lat = row < MLAT;
            const f32x4* xr = (const f32x4*)(lat ? xlat + (size_t)row * DM : xctx + (size_t)(row - MLAT) * DM) + lane;
#pragma unroll
            for (int jx = 0; jx < 4; ++jx) v[q][jx] = xr[64 * jx]; }
        if (rssf) {
#pragma unroll
            for (int q = 0; q < R; ++q) inv[q] = rsqrtf(rssf[grp * R + q] * (1.f / DM) + RMS_EPS);
        } else {
            float s[R];
#pragma unroll
            for (int q = 0; q < R; ++q) { s[q] = 0.f;
#pragma unroll
                for (int jx = 0; jx < 4; ++jx) s[q] += (v[q][jx].x * v[q][jx].x + v[q][jx].y * v[q][jx].y) + (v[q][jx].z * v[q][jx].z + v[q][jx].w * v[q][jx].w); }
#pragma unroll
            for (int o = 1; o < 64; o <<= 1) {
#pragma unroll
                for (int q = 0; q < R; ++q) s[q] += __shfl_xor(s[q], o); }
#pragma unroll
            for (int q = 0; q < R; ++q) inv[q] = rsqrtf(s[q] * (1.f / DM) + RMS_EPS);
        }
        f32x4 mg[4], ms[4];
        if (modl) { const int row0_ = grp * R; const float* mr = modl + (size_t)(row0_ < MLAT ? (row0_ >> 11) : 16) * 6144;
#pragma unroll
            for (int jx = 0; jx < 4; ++jx) { const int c = 4 * lane + 256 * jx;
                mg[jx] = *(const f32x4*)(g + c) * (*(const f32x4*)(mr + sc_chunk * 1024 + c) + 1.0f); ms[jx] = *(const f32x4*)(mr + sh_chunk * 1024 + c); } }
#pragma unroll
        for (int q = 0; q < R; ++q) { const int row = grp * R + q;
            if (modl) {
                unsigned long long* o8 = (unsigned long long*)(H + (size_t)row * DM) + lane;
#pragma unroll
                for (int jx = 0; jx < 4; ++jx) {
                    const f32x4 o = (v[q][jx] * inv[q]) * mg[jx] + ms[jx];
                    o8[64 * jx] = (unsigned long long)pk2(o.x, o.y) | ((unsigned long long)pk2(o.z, o.w) << 32); }
            } else {
                f32x4* orow = (f32x4*)(outf + (size_t)row * DM) + lane;
#pragma unroll
                for (int jx = 0; jx < 4; ++jx) { const int c = 4 * lane + 256 * jx; const f32x4 gg = *(const f32x4*)(g + c); orow[64 * jx] = v[q][jx] * inv[q] * gg; }
            }
        }
    }
}

__device__ __forceinline__ void final_phase(const bf16_t* xb, const float* rssf, const float* g, float* out, int gw, int NGW, int lane) {
    constexpr int R = 4;
    for (int grp = gw; grp < MLAT / R; grp += NGW) {
        u32x4 v[R][2];
#pragma unroll
        for (int q = 0; q < R; ++q)
#pragma unroll
            for (int jx = 0; jx < 2; ++jx) v[q][jx] = *(const u32x4*)(xb + (size_t)(grp * R + q) * DM + jx * 512 + lane * 8);
        f32x4 gv0[2], gv1[2];
#pragma unroll
        for (int jx = 0; jx < 2; ++jx) { const int c = jx * 512 + lane * 8; gv0[jx] = *(const f32x4*)(g + c); gv1[jx] = *(const f32x4*)(g + c + 4); }
#pragma unroll
        for (int q = 0; q < R; ++q) { const int row = grp * R + q; const float inv = rsqrtf(rssf[row] * (1.f / DM) + RMS_EPS);
#pragma unroll
            for (int jx = 0; jx < 2; ++jx) { const int c = jx * 512 + lane * 8; const f32x4 g0 = gv0[jx], g1 = gv1[jx]; const u32x4 w = v[q][jx];
                const f32x4 x0 = (f32x4){bf_lo(w.x), bf_hi(w.x), bf_lo(w.y), bf_hi(w.y)}, x1 = (f32x4){bf_lo(w.z), bf_hi(w.z), bf_lo(w.w), bf_hi(w.w)};
                *(f32x4*)(out + (size_t)row * DM + c) = x0 * inv * g0; *(f32x4*)(out + (size_t)row * DM + c + 4) = x1 * inv * g1; } }
    }
}

__device__ __forceinline__ void unpack8(const u32x4 w, float (&f)[8]) { f[0] = bf_lo(w.x); f[1] = bf_hi(w.x); f[2] = bf_lo(w.y); f[3] = bf_hi(w.y); f[4] = bf_lo(w.z); f[5] = bf_hi(w.z); f[6] = bf_lo(w.w); f[7] = bf_hi(w.w); }
__device__ __forceinline__ void unpack4(const u32x2 w, float (&f)[4]) { f[0] = bf_lo(w.x); f[1] = bf_hi(w.x); f[2] = bf_lo(w.y); f[3] = bf_hi(w.y); }
__device__ __forceinline__ void convgate_phase(const bf16_t* U, const bf16_t* Bg, const float* cw, bf16_t* Gout, int gw, int NGW, int lane) {
    constexpr int RC = 8;
    for (int item = gw; item < (MALL / RC) * 4; item += NGW) {
        const int chunk = item >> 2, strip = item & 3, t0 = chunk * RC, ch = strip * 256 + lane * 4;
        const int tl = t0 < MLAT ? (t0 & (SEQ - 1)) : ((t0 - MLAT) & (CTXL - 1)); const int sl = t0 < MLAT ? SEQ : CTXL;
        const bool first = (tl == 0), lastc = (tl + RC == sl);
        const f32x4 w0 = *(const f32x4*)(cw + ch), w1 = *(const f32x4*)(cw + 1024 + ch), w2 = *(const f32x4*)(cw + 2048 + ch);
        const bf16_t* up = U + (size_t)t0 * DM + ch; const bf16_t* bp = Bg + (size_t)t0 * DM + ch; bf16_t* gp = Gout + (size_t)t0 * DM + ch;
        const u32x2 zero = (u32x2){0u, 0u};
        u32x2 uw[RC + 2], bw[RC];
        uw[0] = first ? zero : *(const u32x2*)(up - DM);
#pragma unroll
        for (int t = 0; t < RC; ++t) { uw[t + 1] = *(const u32x2*)(up + (size_t)t * DM); bw[t] = *(const u32x2*)(bp + (size_t)t * DM); }
        uw[RC + 1] = lastc ? zero : *(const u32x2*)(up + (size_t)RC * DM);
#pragma unroll
        for (int t = 0; t < RC; ++t) {
            float pf[4], cf[4], nf[4], bf[4];
            unpack4(uw[t], pf); unpack4(uw[t + 1], cf); unpack4(uw[t + 2], nf); unpack4(bw[t], bf);
            float o[4];
#pragma unroll
            for (int e = 0; e < 4; ++e) o[e] = bf[e] * (w0[e] * pf[e] + w1[e] * cf[e] + w2[e] * nf[e]);
            u32x2 ow; ow.x = pk2(o[0], o[1]); ow.y = pk2(o[2], o[3]);
            *(u32x2*)(gp + (size_t)t * DM) = ow;
        }
    }
}

struct KBuf { bf16x8 k[2][2]; };
struct VBuf { bf16x8 v[4]; };
constexpr int VT_LD = MALL;
struct KVOff { unsigned k0, v0; };
typedef __amdgpu_buffer_rsrc_t rsrc_t;
__device__ __forceinline__ bf16x8 bload(rsrc_t r, unsigned voff, unsigned soff) { return __builtin_bit_cast(bf16x8, __builtin_amdgcn_raw_buffer_load_b128(r, (int)voff, (int)soff, 0)); }
__device__ __forceinline__ void k_load(KBuf& B, rsrc_t rk, const KVOff& f, int kt) {
    const unsigned sk = (unsigned)kt * 4096u;
    B.k[0][0] = bload(rk, f.k0, sk); B.k[0][1] = bload(rk, f.k0 + 64u, sk);
    B.k[1][0] = bload(rk, f.k0, sk + 16384u); B.k[1][1] = bload(rk, f.k0 + 64u, sk + 16384u);
}
__device__ __forceinline__ void v_load(VBuf& B, rsrc_t rv, const KVOff& f, int kt) {
    const unsigned sv = (unsigned)kt * 2u;
#pragma unroll
    for (int d = 0; d < 4; ++d) B.v[d] = bload(rv, f.v0, sv + (unsigned)d * (16u * VT_LD * 2u));
}
__device__ __forceinline__ float red16_max(float x) {
#if __has_builtin(__builtin_amdgcn_permlane16_swap)
    auto r = __builtin_amdgcn_permlane16_swap(__float_as_uint(x), __float_as_uint(x), false, false);
    x = fmaxf(__uint_as_float(r[0]), __uint_as_float(r[1]));
#else
    x = fmaxf(x, __shfl_xor(x, 16));
#endif
    auto q = __builtin_amdgcn_permlane32_swap(__float_as_uint(x), __float_as_uint(x), false, false);
    return fmaxf(__uint_as_float(q[0]), __uint_as_float(q[1]));
}
__device__ __forceinline__ float red16_sum(float x) {
#if __has_builtin(__builtin_amdgcn_permlane16_swap)
    auto r = __builtin_amdgcn_permlane16_swap(__float_as_uint(x), __float_as_uint(x), false, false);
    x = __uint_as_float(r[0]) + __uint_as_float(r[1]);
#else
    x = x + __shfl_xor(x, 16);
#endif
    auto q = __builtin_amdgcn_permlane32_swap(__float_as_uint(x), __float_as_uint(x), false, false);
    return __uint_as_float(q[0]) + __uint_as_float(q[1]);
}
__device__ __forceinline__ void attn_step(const KBuf& B, const VBuf& V, const bf16x8 (&qf)[2], f32x4 c0, f32x4 c1, float& m, float& l, f32x4 (&o)[4]) {
    f32x4 s0 = __builtin_amdgcn_mfma_f32_16x16x32_bf16(B.k[0][0], qf[0], c0, 0, 0, 0);
    f32x4 s1 = __builtin_amdgcn_mfma_f32_16x16x32_bf16(B.k[1][0], qf[0], c1, 0, 0, 0);
    s0 = __builtin_amdgcn_mfma_f32_16x16x32_bf16(B.k[0][1], qf[1], s0, 0, 0, 0);
    s1 = __builtin_amdgcn_mfma_f32_16x16x32_bf16(B.k[1][1], qf[1], s1, 0, 0, 0);
    float mx = fmaxf(fmaxf(fmaxf(s0[0], s0[1]), fmaxf(s0[2], s0[3])), fmaxf(fmaxf(s1[0], s1[1]), fmaxf(s1[2], s1[3])));
    mx = red16_max(mx);
    const float mn = fmaxf(m, mx);
    const float alpha = __builtin_amdgcn_exp2f(m - mn);
    m = mn;
    f32x4 p0, p1;
#pragma unroll
    for (int e = 0; e < 4; ++e) { p0[e] = __builtin_amdgcn_exp2f(s0[e] - mn); p1[e] = __builtin_amdgcn_exp2f(s1[e] - mn); }
    l = l * alpha + ((p0[0] + p0[1]) + (p0[2] + p0[3])) + ((p1[0] + p1[1]) + (p1[2] + p1[3]));
    u32x4 pw; pw.x = pk2(p0[0], p0[1]); pw.y = pk2(p0[2], p0[3]); pw.z = pk2(p1[0], p1[1]); pw.w = pk2(p1[2], p1[3]);
    const bf16x8 pf = __builtin_bit_cast(bf16x8, pw);
#pragma unroll
    for (int d = 0; d < 4; ++d) { o[d] = o[d] * alpha; o[d] = __builtin_amdgcn_mfma_f32_16x16x32_bf16(V.v[d], pf, o[d], 0, 0, 0); }
}

__device__ __forceinline__ void attn_step2(const KBuf& KA, const VBuf& VA, const KBuf& KB, const VBuf& VB, const bf16x8 (&qf)[2], f32x4 c0, f32x4 c1, float& m, float& l, f32x4 (&o)[4]) {
    const f32x4 z4 = (f32x4){0.f, 0.f, 0.f, 0.f};
    f32x4 a0 = __builtin_amdgcn_mfma_f32_16x16x32_bf16(KA.k[0][0], qf[0], z4, 0, 0, 0);
    f32x4 a1 = __builtin_amdgcn_mfma_f32_16x16x32_bf16(KA.k[1][0], qf[0], z4, 0, 0, 0);
    f32x4 b0 = __builtin_amdgcn_mfma_f32_16x16x32_bf16(KB.k[0][0], qf[0], c0, 0, 0, 0);
    f32x4 b1 = __builtin_amdgcn_mfma_f32_16x16x32_bf16(KB.k[1][0], qf[0], c1, 0, 0, 0);
    a0 = __builtin_amdgcn_mfma_f32_16x16x32_bf16(KA.k[0][1], qf[1], a0, 0, 0, 0);
    a1 = __builtin_amdgcn_mfma_f32_16x16x32_bf16(KA.k[1][1], qf[1], a1, 0, 0, 0);
    b0 = __builtin_amdgcn_mfma_f32_16x16x32_bf16(KB.k[0][1], qf[1], b0, 0, 0, 0);
    b1 = __builtin_amdgcn_mfma_f32_16x16x32_bf16(KB.k[1][1], qf[1], b1, 0, 0, 0);
    float mxa = fmaxf(fmaxf(fmaxf(a0[0], a0[1]), fmaxf(a0[2], a0[3])), fmaxf(fmaxf(a1[0], a1[1]), fmaxf(a1[2], a1[3])));
    float mxb = fmaxf(fmaxf(fmaxf(b0[0], b0[1]), fmaxf(b0[2], b0[3])), fmaxf(fmaxf(b1[0], b1[1]), fmaxf(b1[2], b1[3])));
    const float mx = red16_max(fmaxf(mxa, mxb));
    const float mn = fmaxf(m, mx);
    const float alpha = __builtin_amdgcn_exp2f(m - mn);
    m = mn;
    f32x4 pa0, pa1, pb0, pb1;
#pragma unroll
    for (int e = 0; e < 4; ++e) { pa0[e] = __builtin_amdgcn_exp2f(a0[e] - mn); pa1[e] = __builtin_amdgcn_exp2f(a1[e] - mn); pb0[e] = __builtin_amdgcn_exp2f(b0[e] - mn); pb1[e] = __builtin_amdgcn_exp2f(b1[e] - mn); }
    const f32x4 ps = (pa0 + pa1) + (pb0 + pb1);
    l = l * alpha + ((ps[0] + ps[1]) + (ps[2] + ps[3]));
    u32x4 wa, wb; wa.x = pk2(pa0[0], pa0[1]); wa.y = pk2(pa0[2], pa0[3]); wa.z = pk2(pa1[0], pa1[1]); wa.w = pk2(pa1[2], pa1[3]);
    wb.x = pk2(pb0[0], pb0[1]); wb.y = pk2(pb0[2], pb0[3]); wb.z = pk2(pb1[0], pb1[1]); wb.w = pk2(pb1[2], pb1[3]);
    const bf16x8 pfa = __builtin_bit_cast(bf16x8, wa), pfb = __builtin_bit_cast(bf16x8, wb);
#pragma unroll
    for (int d = 0; d < 4; ++d) { o[d] = o[d] * alpha; o[d] = __builtin_amdgcn_mfma_f32_16x16x32_bf16(VA.v[d], pfa, o[d], 0, 0, 0); o[d] = __builtin_amdgcn_mfma_f32_16x16x32_bf16(VB.v[d], pfb, o[d], 0, 0, 0); }
}

constexpr int TAB_LD = 48, TAB_ROWS = 15;
constexpr int CK_STRIDE = 144, CV_STRIDE = 528, RW_STRIDE = 144;
constexpr int LDS_TAB = 0, LDS_CK = 3072, LDS_CV = LDS_CK + CTXL * CK_STRIDE, LDS_RING = LDS_CV + HD * CV_STRIDE;
constexpr int ROWK_BYTES = 64 * RW_STRIDE, SLOT_BYTES = 2 * ROWK_BYTES, LDS_ATT_END = LDS_RING + 3 * SLOT_BYTES;
static_assert(TAB_ROWS * TAB_LD * 4 <= LDS_CK && LDS_ATT_END <= RING_BYTES, "attention LDS map");
__device__ __forceinline__ int rs_of(int r) { int v = r - 4; return v < 0 ? 0 : (v > 24 ? 24 : v); }
__device__ __forceinline__ void attn_phase(const bf16_t* QK, const bf16_t* VT, bf16_t* O, const float* rpb, LAS unsigned char* lds, int tid, int lane, int wave, int bid, int G) {
    LAS float* tab = (LAS float*)(lds + LDS_TAB);
    const int fr = lane & 15, fq = lane >> 4;
    const int j = wave & 3, rw = wave >> 2;
    const int kc0 = (j == 0) ? 0 : (j == 1) ? 8 : (j == 2) ? 24 : 32;
    unsigned bpk0 = 0u, bpk1 = 0u;
    { const int cq = 16 * j + fr; int cs = cq - 8; cs = cs < 0 ? 0 : (cs > 48 ? 48 : cs);
#pragma unroll
      for (int jj = 0; jj < 8; ++jj) { const int ck = kc0 + 8 * fq + jj; const bool valid = (ck >= cs) && (ck < cs + 16); const unsigned col = valid ? (unsigned)(ck - cq + 15) : 31u;
          if (jj < 4) bpk0 |= col << (8 * jj); else bpk1 |= col << (8 * (jj - 4)); } }
    LAS unsigned char* ckl = lds + LDS_CK + fr * CK_STRIDE + fq * 16;
    LAS unsigned char* cvl = lds + LDS_CV + fr * CV_STRIDE + fq * 16;
    const int klo = LDS_RING + (kc0 + 8 * (fr >> 2) + (fr & 3)) * RW_STRIDE + fq * 16;
    const int vlo = LDS_RING + ROWK_BYTES + fr * RW_STRIDE + (kc0 + 8 * fq) * 2;
    const int st_t = tid >> 3, st_ch = tid & 7;
    const int st_off = st_t * RW_STRIDE + st_ch * 16;
    for (int bh = bid; bh < NB * NH; bh += G) {
        const int b = bh >> 4, h = bh & 15;
        const int ctx_kt0 = MLAT + b * CTXL;
        const bf16_t* ksrc = QK + (size_t)(b * SEQ + st_t) * 2048 + 1024 + h * 64 + st_ch * 8;
        const bf16_t* vsrc = VT + (size_t)(h * 64 + st_t) * VT_LD + b * SEQ + st_ch * 8;
        __syncthreads();
        for (int i = tid; i < TAB_ROWS * TAB_LD; i += 512) { const int col = i % TAB_LD, dr = i / TAB_LD; tab[i] = col < 31 ? rpb[(h * TAB_ROWS + dr) * 31 + col] * LOG2E : -1e30f; }
        for (int p = tid; p < CTXL * 8; p += 512) { const int key = p >> 3, ch = p & 7, c = key >> 5, w = key & 31; const int slot = c * 32 + ((w >> 2) & 1) * 16 + (w >> 3) * 4 + (w & 3);
            *(LAS u32x4*)(lds + LDS_CK + slot * CK_STRIDE + ch * 16) = *(const u32x4*)(QK + (size_t)(ctx_kt0 + key) * 2048 + 1024 + h * 64 + ch * 8); }
        for (int p = tid; p < HD * 32; p += 512) { const int d = p >> 5, ch = p & 31;
            *(LAS u32x4*)(lds + LDS_CV + d * CV_STRIDE + ch * 16) = *(const u32x4*)(VT + (size_t)(h * 64 + d) * VT_LD + ctx_kt0 + ch * 8); }
#pragma unroll
        for (int s0 = 0; s0 < 2; ++s0) {
            *(LAS u32x4*)(lds + LDS_RING + s0 * SLOT_BYTES + st_off) = *(const u32x4*)(ksrc + (size_t)s0 * 64 * 2048);
            *(LAS u32x4*)(lds + LDS_RING + s0 * SLOT_BYTES + ROWK_BYTES + st_off) = *(const u32x4*)(vsrc + s0 * 64); }
        u32x4 kr0, vr0, kr1, vr1, kr2, vr2;
        kr2 = *(const u32x4*)(ksrc + (size_t)2 * 64 * 2048); vr2 = *(const u32x4*)(vsrc + 2 * 64);
        kr0 = *(const u32x4*)(ksrc + (size_t)3 * 64 * 2048); vr0 = *(const u32x4*)(vsrc + 3 * 64);
        kr1 = kr0; vr1 = vr0;
        asm volatile("s_waitcnt lgkmcnt(0)" ::: "memory"); __builtin_amdgcn_s_barrier(); asm volatile("" ::: "memory");
        int gslot = 0;
        int it = 0, sc = 0, n_cur = 8, rs_lo = 0;
        int r_ = rw, rsw_ = 0, tq0_ = b * SEQ + rw * 64 + j * 16;
        int itp = 0, sp = 4, np = 8, prow = 4;
        bf16x8 qf[2], qn[2]; float m = -1e30f, l = 0.f; f32x4 o[4];
        qf[0] = qf[1] = (bf16x8){0, 0, 0, 0, 0, 0, 0, 0};
#pragma unroll
        for (int ks = 0; ks < 2; ++ks) qn[ks] = *(const bf16x8*)(QK + (size_t)(b * SEQ + rw * 64 + j * 16 + fr) * 2048 + h * 64 + ks * 32 + fq * 8);
#pragma unroll
        for (int d = 0; d < 4; ++d) o[d] = (f32x4){0.f, 0.f, 0.f, 0.f};
#define ATT_STEP(KI, VI, KW, VW) do { \
            { const int row_ = itp < 16 ? prow : 0; KI = *(const u32x4*)(ksrc + (size_t)row_ * 64 * 2048); VI = *(const u32x4*)(vsrc + row_ * 64); } \
            ++prow; if (++sp >= np) { sp = 0; ++itp; prow = rs_of(2 * itp); np = 8 + rs_of(2 * itp + 1) - prow; } \
            if (it < 16) { \
                if (sc == 0) { qf[0] = qn[0]; qf[1] = qn[1]; \
                    m = -1e30f; l = 0.f; _Pragma("unroll") for (int d = 0; d < 4; ++d) o[d] = (f32x4){0.f, 0.f, 0.f, 0.f}; } \
                if (sc == n_cur - 2) { const int tqn_ = tq0_ + (it < 15 ? 128 : 0);        \
                    _Pragma("unroll") for (int ks = 0; ks < 2; ++ks) qn[ks] = *(const bf16x8*)(QK + (size_t)(tqn_ + fr) * 2048 + h * 64 + ks * 32 + fq * 8); } \
                const int c_ = rs_lo + sc - rsw_; \
                if (c_ >= 0 && c_ < 8) { \
                    KBuf kc_, kl_; VBuf vc_, vl_; \
                    const LAS unsigned char* cks = ckl + c_ * 32 * CK_STRIDE; const LAS unsigned char* cvs = cvl + c_ * 64; \
                    const LAS unsigned char* lk = lds + klo + gslot * SLOT_BYTES; const LAS unsigned char* lv = lds + vlo + gslot * SLOT_BYTES; \
                    _Pragma("unroll") for (int T = 0; T < 2; ++T) _Pragma("unroll") for (int ks = 0; ks < 2; ++ks) { \
                        kc_.k[T][ks] = *(const LAS bf16x8*)(cks + T * 16 * CK_STRIDE + ks * 64); kl_.k[T][ks] = *(const LAS bf16x8*)(lk + T * 4 * RW_STRIDE + ks * 64); } \
                    _Pragma("unroll") for (int d = 0; d < 4; ++d) { vc_.v[d] = *(const LAS bf16x8*)(cvs + d * 16 * CV_STRIDE); vl_.v[d] = *(const LAS bf16x8*)(lv + d * 16 * RW_STRIDE); } \
                    const int tb_ = (rsw_ - r_ + 7 + c_) * TAB_LD; f32x4 c0_, c1_; \
                    _Pragma("unroll") for (int e = 0; e < 4; ++e) { c0_[e] = tab[tb_ + (int)((bpk0 >> (8 * e)) & 255u)]; c1_[e] = tab[tb_ + (int)((bpk1 >> (8 * e)) & 255u)]; } \
                    attn_step2(kc_, vc_, kl_, vl_, qf, c0_, c1_, m, l, o); } \
                if (sc == n_cur - 1) { \
                    const float lt = red16_sum(l); const float rl = 1.0f / lt; \
                    bf16_t* op = O + (size_t)(tq0_ + fr) * DM + h * 64 + 4 * fq; \
                    _Pragma("unroll") for (int d = 0; d < 4; ++d) { const f32x4 v = o[d] * rl; u32x2 w; w.x = pk2(v[0], v[1]); w.y = pk2(v[2], v[3]); *(u32x2*)(op + d * 16) = w; } } \
                if (++sc >= n_cur) { sc = 0; ++it; rs_lo = rs_of(2 * it); const int rs_hi_ = rs_of(2 * it + 1); n_cur = 8 + rs_hi_ - rs_lo; \
                    r_ = 2 * it + rw; rsw_ = rw ? rs_hi_ : rs_lo; tq0_ = b * SEQ + r_ * 64 + j * 16; } } \
            { int wslot = gslot + 2; wslot = wslot >= 3 ? wslot - 3 : wslot; \
              *(LAS u32x4*)(lds + LDS_RING + wslot * SLOT_BYTES + st_off) = KW; *(LAS u32x4*)(lds + LDS_RING + wslot * SLOT_BYTES + ROWK_BYTES + st_off) = VW; } \
            asm volatile("s_waitcnt lgkmcnt(0)" ::: "memory"); __builtin_amdgcn_s_barrier(); asm volatile("" ::: "memory"); \
            gslot = gslot == 2 ? 0 : gslot + 1; } while (0)
#pragma unroll 1
        for (int g = 0; g < 141; g += 3) {
            ATT_STEP(kr1, vr1, kr2, vr2);
            ATT_STEP(kr2, vr2, kr0, vr0);
            ATT_STEP(kr0, vr0, kr1, vr1);
        }
#undef ATT_STEP
    }
}

#define XB_TMO      128
#define XB_XCNT(j)  (256  + 64 * (j))
#define XB_XSUB(j)  (1280 + 64 * (j))
#define XB_XGEN(j)  (2304 + 64 * (j))
#define XB_TOP      3328
#define XB_TOPGEN   3392
#define XCD_BAR_WORDS 3456
#define XB_SPIN_CAP (1u << 18)

__device__ __forceinline__ unsigned xb_ld(unsigned* p)              { return __hip_atomic_load(p, __ATOMIC_RELAXED, __HIP_MEMORY_SCOPE_AGENT); }
__device__ __forceinline__ unsigned xb_add(unsigned* p, unsigned v) { return __hip_atomic_fetch_add(p, v, __ATOMIC_RELAXED, __HIP_MEMORY_SCOPE_AGENT); }
__device__ __forceinline__ unsigned xb_xcc_id() { return (unsigned)__builtin_amdgcn_s_getreg((3 << 11) | 20) & 0xFu; }
#define XB_SPIN(cond, bar) do { unsigned _sp = 0; while (cond) { __builtin_amdgcn_s_sleep(1); \
    if ((++_sp & 255u) == 0u) { if (xb_ld(&(bar)[XB_TMO])) break; if (_sp > XB_SPIN_CAP) { atomicAdd(&(bar)[XB_TMO], 1u); break; } } } } while (0)

struct XcdBarrier {
    unsigned* bar; unsigned x;
    volatile LAS unsigned* st;
};

__device__ __forceinline__ XcdBarrier xcd_barrier_post(unsigned* bar, volatile LAS unsigned* st) {
    XcdBarrier b; b.bar = bar; b.x = xb_xcc_id(); b.st = st;
    if (threadIdx.x == 0) (void)xb_add(&bar[XB_XCNT(b.x)], 1u);
    return b;
}
__device__ __forceinline__ void xcd_barrier_complete(unsigned* bar, unsigned x, unsigned& nloc, unsigned& nx) {
    const unsigned G = gridDim.x * gridDim.y * gridDim.z;
    unsigned sum, cnt, mine, sp = 0u;
    for (;;) {
        sum = 0u; cnt = 0u; mine = 0u;
#pragma unroll
        for (unsigned j = 0; j < 16; ++j) { const unsigned c = xb_ld(&bar[XB_XCNT(j)]); sum += c; cnt += (c > 0u) ? 1u : 0u; mine = (j == x) ? c : mine; }
        if (sum == G) break;
        __builtin_amdgcn_s_sleep(1);
        if ((++sp & 255u) == 0u) { if (xb_ld(&bar[XB_TMO])) break; if (sp > XB_SPIN_CAP) { atomicAdd(&bar[XB_TMO], 1u); break; } }
    }
    nloc = mine > 0u ? mine : 1u; nx = cnt > 0u ? cnt : 1u;
}

__device__ __forceinline__ void xcd_barrier(const XcdBarrier& b) {
    asm volatile("s_waitcnt vmcnt(0)" ::: "memory");
    __syncthreads();
    if (threadIdx.x == 0) {
        unsigned* bar = b.bar;
        __builtin_amdgcn_s_waitcnt(0);
        unsigned nloc = b.st[0], nx = b.st[1];
        if (nloc == 0u) { xcd_barrier_complete(bar, b.x, nloc, nx); b.st[0] = nloc; b.st[1] = nx; }
        const unsigned old = xb_add(&bar[XB_XSUB(b.x)], 1u);
        const unsigned gen = old / nloc;
        if (old + 1u == (gen + 1u) * nloc) {
            __builtin_amdgcn_fence(__ATOMIC_RELEASE, "agent");
            asm volatile("s_waitcnt vmcnt(0)" ::: "memory");
            const unsigned og = xb_add(&bar[XB_TOP], 1u);
            const unsigned tg = og / nx;
            if (og + 1u == (tg + 1u) * nx) xb_add(&bar[XB_TOPGEN], 1u);
            else XB_SPIN(xb_ld(&bar[XB_TOPGEN]) == tg, bar);
            __builtin_amdgcn_fence(__ATOMIC_ACQUIRE, "agent");
            xb_add(&bar[XB_XGEN(b.x)], 1u);
            asm volatile("s_waitcnt vmcnt(0)" ::: "memory");
        } else {
            XB_SPIN(xb_ld(&bar[XB_XGEN(b.x)]) == gen, bar);
            __builtin_amdgcn_fence(__ATOMIC_ACQUIRE, "agent");
            asm volatile("s_waitcnt vmcnt(0)" ::: "memory");
        }
    }
    __syncthreads();
}


constexpr int NPHASE = 14;
__global__ void __launch_bounds__(512, 2) fwd_mega(Args args) {
    extern __shared__ __attribute__((aligned(16))) unsigned char lds_raw[];
    LAS unsigned char* lds = (LAS unsigned char*)lds_raw;
    cg::grid_group grid = cg::this_grid();
    const int G = gridDim.x, bid = blockIdx.x, NGW = G * 8;
    unsigned char* ws = args.ws;
    const float* x = args.in[0]; const float* ctx = args.in[2];
    const float* norm1_g = args.in[4]; const float* norm2_g = args.in[5];
    const float* conv_w = args.in[9]; const float* rpb = args.in[12]; const float* final_g = args.in[16];
    float* mod = (float*)(ws + WS_MOD);
    bf16_t* SHA = (bf16_t*)(ws + WS_SHA);
    bf16_t* H = (bf16_t*)(ws + WS_H); bf16_t* H2 = (bf16_t*)(ws + WS_H2); float* rss = (float*)(ws + WS_RSS); float* shw = (float*)(ws + WS_SHW);
    bf16_t* Xctx = (bf16_t*)(ws + WS_XCTX);
    bf16_t* Xlat = (bf16_t*)args.out;
    bf16_t* BIG = (bf16_t*)(ws + WS_BIG);
    bf16_t* U = BIG; bf16_t* Bg = BIG + (size_t)MALL * 1024;
    bf16_t* HID = BIG;
    bf16_t* QK = BIG; bf16_t* VT = BIG + (size_t)MALL * 2048;
    bf16_t* Wcin = (bf16_t*)(ws + WS_WCIN); bf16_t* Wcout = (bf16_t*)(ws + WS_WCOUT); bf16_t* Wqkv = (bf16_t*)(ws + WS_WQKV); bf16_t* Wao = (bf16_t*)(ws + WS_WAO);
    bf16_t* W1 = (bf16_t*)(ws + WS_W1); bf16_t* W2 = (bf16_t*)(ws + WS_W2);

#ifndef PROBE_PH
#define PROBE_PH -1
#endif
#ifndef PROBE_PH2
#define PROBE_PH2 -1
#endif
    if (threadIdx.x < 32) ((volatile LAS unsigned*)(lds + MISC_OFF))[threadIdx.x] = 0u;
    __syncthreads();
    const XcdBarrier xbar = xcd_barrier_post((unsigned*)(ws + WS_CTL), (volatile LAS unsigned*)(lds + MISC_OFF) + 8);
    if (args.ph_lo < 0) grid.sync();
    for (int ph = args.ph_lo; ph < args.ph_hi; ++ph) {
      for (int rep = 0; rep < ((ph == PROBE_PH || ph == PROBE_PH2) ? 2 : 1); ++rep) {
        if (rep) xcd_barrier(xbar);
        int tid = threadIdx.x; asm volatile("" : "+v"(tid));
        const int lane = tid & 63, wave = __builtin_amdgcn_readfirstlane(tid >> 6), gw = bid * 8 + wave;
        int kind = 0;
        bool sync_after = true;
        pg8::Gemm g{nullptr, nullptr, 0, 0, 0}; int cidx = bid;
        pg8::EpiU E{}; E.mode = 0; E.O = nullptr; E.O2 = nullptr; E.ldc = 0; E.scale_tiles = 0; E.sc = 1.f; E.rss = nullptr; E.shw = nullptr; E.shw_ld = 0; E.inLat = nullptr; E.inCtx = nullptr; E.inbLat = nullptr; E.inbCtx = nullptr; E.outLat = nullptr; E.outCtx = nullptr; E.gate = nullptr;
        E.An = nullptr; E.gn = nullptr; E.scn = nullptr; E.rssn = nullptr; E.outf5 = nullptr;
        switch (ph) {
        case 0: p0_phase(args, lds, tid, lane, wave, bid, G); break;
        case 1: norm_phase(x, ctx, MALL, norm1_g, mod, 0, 1, H, nullptr, nullptr, gw, NGW, lane);
                for (int i = bid * 512 + tid; i < 3 * 17 * 1024; i += G * 512) { const int jb = i / (17 * 1024), rr = (i / 1024) % 17, k = i & 1023;
                    const float* shp = mod + (jb == 0 ? 3 * 1024 : jb == 1 ? 17 * 6144 : 17 * 6144 + 3 * 1024) + (size_t)rr * 6144;
                    SHA[(size_t)(jb * 256 + rr) * 1024 + k] = (bf16_t)f2bf(shp[k]); }
                break;
        case 2: kind = 1; g = pg8::Gemm{H, Wcin, MALL, 3072, 1024}; E.mode = 2; E.O = U; E.O2 = Bg; break;
        case 3: convgate_phase(U, Bg, conv_w, H, gw, NGW, lane); break;
        case 4: kind = 1; g = pg8::Gemm{H, Wcout, MALL, 1024, 1024}; E.mode = 3; E.inLat = x; E.inCtx = ctx; E.outLat = Xlat; E.outCtx = Xctx; E.gate = mod + 2 * 1024;
                E.An = H2; E.gn = norm2_g; E.scn = mod + 4 * 1024; E.rssn = rss; break;
        case 5: kind = 1; g = pg8::Gemm{H2, W1, MALL, 4096, 1024}; E.mode = 1; E.O = HID; E.ldc = 4096; E.rss = rss; E.shw = shw; E.shw_ld = 4096; break;
        case 6: case 7:
                kind = 1; g = pg8::Gemm{HID, W2, MLAT, 1024, 4096}; E.mode = 3; E.inbLat = Xlat; E.inbCtx = Xctx; E.outLat = Xlat; E.outCtx = Xctx; E.gate = mod + 5 * 1024;
                E.An = H; E.gn = norm1_g + 1024; E.scn = mod + 17 * 6144 + 1 * 1024; E.rssn = rss + MALL; break;
        case 8: kind = 1; break;
        case 9: attn_phase(QK, VT, H2, rpb, lds, tid, lane, wave, bid, G); break;
        case 10: kind = 1; g = pg8::Gemm{H2, Wao, MLAT, 1024, 1024}; E.mode = 3; E.inbLat = Xlat; E.inbCtx = Xctx; E.outLat = Xlat; E.outCtx = Xctx; E.gate = mod + 17 * 6144 + 2 * 1024;
                E.An = H; E.gn = norm2_g + 1024; E.scn = mod + 17 * 6144 + 4 * 1024; E.rssn = rss + 2 * MALL; break;
        case 11: kind = 1; g = pg8::Gemm{H, W1 + (size_t)4096 * 1024, MLAT, 4096, 1024}; E.mode = 1; E.O = HID; E.ldc = 4096; E.rss = rss + 2 * MALL; E.shw = shw + 17 * 4096 + 17 * 3072; E.shw_ld = 4096; break;
        case 12: kind = 1; g = pg8::Gemm{HID, W2 + (size_t)4096 * 1024, MLAT, 1024, 4096}; E.mode = 3; E.inbLat = Xlat; E.inbCtx = Xctx; E.outLat = H2; E.outCtx = Xctx; E.gate = mod + 17 * 6144 + 5 * 1024;
                E.rssn = rss + 3 * MALL; break;
        case 13: final_phase(H2, rss + 3 * MALL, final_g, args.out, gw, NGW, lane); break;
        default: break;
        }
#ifndef NO_GEMM
        if (kind == 1) {
            const int qk_done = (G > 64) ? ((4 * (G - 64) < 1024) ? 4 * (G - 64) : 1024) : 0;
            const int nsub = (ph == 4) ? 4 : (ph == 8) ? 3 : 1;
            for (int sub = 0; sub < nsub; ++sub) {
                int Gs = G, pm0 = 0, lbeg = 0, lend = -1;
                if (ph == 4 && sub > 0) {
                    const int jb = sub - 1;
                    const int N5 = (jb == 1) ? 3072 : 4096;
                    g = pg8::Gemm{SHA + (size_t)jb * 256 * 1024, jb == 0 ? W1 : jb == 1 ? Wqkv : W1 + (size_t)4096 * 1024, 256, N5, 1024};
                    E.mode = 5; E.ldc = N5; E.outf5 = shw + (jb == 0 ? 0 : jb == 1 ? 17 * 4096 : 17 * 4096 + 17 * 3072); E.rss = nullptr; E.shw = nullptr;
                    cidx = (bid + G - ((G > 112) ? 64 + 16 * jb : 0)) % G;
                }
                const bool qk_role = (ph == 7 && G > 64 && bid >= 64) || (ph == 8 && sub < 2);
                if (ph == 7 && !qk_role) { g.M = MCTX; pm0 = MLAT / 256; Gs = (G > 64) ? 64 : G; cidx = bid; }
                if (qk_role) {
                    g = pg8::Gemm{H, Wqkv, MLAT, 2048, 1024}; E.mode = 0; E.O = QK; E.ldc = 2048; E.scale_tiles = 4; E.sc = QSCALE; E.rss = rss + MALL; E.shw = shw + 17 * 4096; E.shw_ld = 3072;
                    E.An = nullptr; E.rssn = nullptr;
                    if (ph == 7) { Gs = G - 64; cidx = bid - 64; lend = qk_done; }
                    else if (sub == 0) { lbeg = qk_done; }
                    else { g.M = MCTX; pm0 = MLAT / 256; cidx = (bid + G - G / 2) % G; }
                }
                if (ph == 8 && sub == 2) { g = pg8::Gemm{Wqkv + (size_t)2048 * 1024, H, 1024, MALL, 1024}; E.mode = 4; E.O = VT; E.ldc = VT_LD; E.rss = rss + MALL; E.shw = shw + 17 * 4096; E.shw_ld = 3072; cidx = bid; }
                pg8::StaticOrder S; S.init(g.M, g.N, Gs, cidx, pm0, lbeg, lend);
                pg8::gemm_phase<pg8::EpiU, pg8::StaticOrder, true, true>(lds, g, S, E);
            }
        } else
#endif
        {}
      }
        if (ph + 1 < args.ph_hi) xcd_barrier(xbar);
    }
}

extern "C" void kernel_launch(void* const* d_in, const int* in_sizes, int n_in, void* d_out, int out_size, void* d_ws, size_t ws_size, hipStream_t stream) {
    static int grid = 0;
    if (grid == 0) {
        if (n_in != 17 || ws_size < WS_END) { fprintf(stderr, "kernel_launch: unexpected n_in %d / ws_size %zu\n", n_in, ws_size); grid = -1; return; }
        int dev = 0, cus = 0, per_cu = 0;
        hipGetDevice(&dev); hipDeviceGetAttribute(&cus, hipDeviceAttributeMultiprocessorCount, dev);
        if (hipFuncSetAttribute((const void*)fwd_mega, hipFuncAttributeMaxDynamicSharedMemorySize, LDS_BYTES) != hipSuccess) { fprintf(stderr, "kernel_launch: hipFuncSetAttribute failed\n"); grid = -1; return; }
        if (hipOccupancyMaxActiveBlocksPerMultiprocessor(&per_cu, (const void*)fwd_mega, 512, LDS_BYTES) != hipSuccess || per_cu < 1) { fprintf(stderr, "kernel_launch: occupancy query says %d\n", per_cu); per_cu = 1; }
        (void)hipGetLastError();
        grid = cus * (per_cu > 1 ? 1 : per_cu);
        if (grid <= 0) grid = 256;
    }
    if (grid < 0) return;
    if (hipMemsetAsync((char*)d_ws + WS_CTL, 0, CTL_BYTES, stream) != hipSuccess) { fprintf(stderr, "kernel_launch: memset failed\n"); return; }
    Args a{};
    for (int i = 0; i < 17; ++i) a.in[i] = (const float*)d_in[i];
    a.out = (float*)d_out; a.ws = (unsigned char*)d_ws;
#if MK_N_LAUNCHES == 1
    a.ph_lo = 0; a.ph_hi = NPHASE;
    void* kargs[] = {&a};
    hipError_t e = hipLaunchCooperativeKernel((const void*)fwd_mega, dim3(grid), dim3(512), kargs, LDS_BYTES, stream);
    if (e != hipSuccess) fprintf(stderr, "kernel_launch: cooperative launch failed: %s (grid %d)\n", hipGetErrorString(e), grid);
#else
    for (int ph = 0; ph < NPHASE; ++ph) {
        a.ph_lo = ph; a.ph_hi = ph + 1;
        hipLaunchKernelGGL(fwd_mega, dim3(grid), dim3(512), LDS_BYTES, stream, a);
    }
#endif
}
```

```cpp
#include <hip/hip_runtime.h>
#include <hip/hip_cooperative_groups.h>
#include <cstdio>
#include <cstdint>
namespace cg = cooperative_groups;

#ifndef MK_N_LAUNCHES
#define MK_N_LAUNCHES 1
#endif

#define LAS __attribute__((address_space(3)))
typedef unsigned short bf16_t;
typedef short bf16x8 __attribute__((ext_vector_type(8)));
typedef float f32x4 __attribute__((ext_vector_type(4)));
typedef unsigned u32x4 __attribute__((ext_vector_type(4)));
typedef unsigned u32x2 __attribute__((ext_vector_type(2)));

constexpr int DM = 1024, NB = 16, SEQ = 2048, CTXL = 256, NH = 16, HD = 64, FF = 4096;
constexpr int MLAT = NB * SEQ;
constexpr int MCTX = NB * CTXL;
constexpr int MALL = MLAT + MCTX;
constexpr float RMS_EPS = 1e-6f;
constexpr float LOG2E = 1.4426950408889634f;
constexpr float QSCALE = 0.125f * LOG2E;

constexpr size_t MiB = 1u << 20;
constexpr size_t WS_SHW = 0;
constexpr size_t WS_MOD = 1 * MiB;
constexpr size_t WS_WCIN = 2 * MiB;
constexpr size_t WS_WCOUT = 8 * MiB;
constexpr size_t WS_WQKV = 10 * MiB;
constexpr size_t WS_WAO = 16 * MiB;
constexpr size_t WS_W1 = 18 * MiB;
constexpr size_t WS_W2 = 34 * MiB;
constexpr size_t WS_H = 50 * MiB;
constexpr size_t WS_XCTX = 122 * MiB;
constexpr size_t WS_BIG = 138 * MiB;
constexpr size_t WS_H2 = 426 * MiB;
constexpr size_t WS_RSS = 498 * MiB;
constexpr size_t WS_CTL = 498 * MiB + 640 * 1024;
constexpr size_t CTL_BYTES = 16384;
constexpr size_t WS_SHA = 500 * MiB;
constexpr size_t WS_END = 502 * MiB;

constexpr int RING_BYTES = 131072;
constexpr int LDS_BYTES = 147456;
constexpr int MISC_OFF = RING_BYTES + 320;

namespace pg8 {
constexpr int BM = 256, BK = 64, HALF = 128, HTB = HALF * BK * 2, STAGE_BYTES = 8 * HTB, NXCD = 8, WGM = 8;
__host__ __device__ __forceinline__ int lds_byte(int r, int c) { const int st = (r >> 4) * 2 + (c >> 5), rr = r & 15, cc = c & 31, ob = rr * 64 + cc * 2; return st * 1024 + (ob ^ (((ob >> 9) & 1) << 5)); }
__host__ __device__ __forceinline__ void stage_rc(int b, int& R, int& C) { const int st = b / 1024, sb = b % 1024, swz = sb ^ (((sb >> 9) & 1) << 5); R = (st >> 1) * 16 + swz / 64; C = (st & 1) * 32 + (swz % 64) / 2; }
__host__ __device__ __forceinline__ int perm32(int rho) { const int n = rho >> 4, i = rho & 15; return 8 * (i >> 2) + 4 * n + (i & 3); }

struct Unit { int pm, pn; };
struct Gemm { const bf16_t* A; const bf16_t* Bt; int M, N, K; };

struct StaticOrder {
    int nM, nN, nwg, G, c, pm0, lbeg, lend;
    __host__ __device__ void init(int M, int N, int G_, int c_, int pm0_ = 0, int lbeg_ = 0, int lend_ = -1) { nM = M / BM; nN = N / BM; nwg = nM * nN; G = G_; c = c_; pm0 = pm0_; lbeg = lbeg_; lend = lend_ < 0 ? nwg : lend_; }
    __host__ __device__ bool next(int i, Unit& u) const {
        const long L = (long)lbeg + (long)i * G + c; if (L >= lend) return false;
        int wgid = (int)L; { const int q = nwg / NXCD, r = nwg % NXCD, xcd = wgid % NXCD, off = wgid / NXCD; wgid = (xcd < r ? xcd * (q + 1) : r * (q + 1) + (xcd - r) * q) + off; }
        const int nig = WGM * nN, gid = wgid / nig, fm = gid * WGM, gsz = (nM - fm) < WGM ? (nM - fm) : WGM;
        u.pm = pm0 + fm + ((wgid % nig) % gsz); u.pn = (wgid % nig) / gsz; return true;
    }
};

__device__ __forceinline__ unsigned cvt_pk_bf16(float lo, float hi) { unsigned r; asm volatile("v_cvt_pk_bf16_f32 %0, %1, %2" : "=v"(r) : "v"(lo), "v"(hi)); return r; }

__device__ __forceinline__ float xsum16(float x) {
    auto r = __builtin_amdgcn_permlane16_swap(__float_as_uint(x), __float_as_uint(x), false, false);
    x = __uint_as_float(r[0]) + __uint_as_float(r[1]);
    auto q = __builtin_amdgcn_permlane32_swap(__float_as_uint(x), __float_as_uint(x), false, false);
    return __uint_as_float(q[0]) + __uint_as_float(q[1]);
}
struct EpiU {
    int mode;
    bf16_t* O; bf16_t* O2; int ldc; int scale_tiles; float sc;
    const float* rss; const float* shw; int shw_ld;
    const float* inLat; const float* inCtx; const bf16_t* inbLat; const bf16_t* inbCtx; bf16_t* outLat; bf16_t* outCtx; const float* gate;
    float* outf5;
    bf16_t* An; const float* gn; const float* scn; float* rssn;
    __device__ __forceinline__ bool has_aux() const { return (mode <= 1 || mode == 4) && rss != nullptr; }
    __device__ __forceinline__ const float* aux_src(const Unit& u, int wid, int lane) const {
        const int i = (wid & 3) * 64 + lane;
        if (mode == 4) { const float* shp = shw + (size_t)(u.pn < (MLAT / BM) ? (u.pn >> 3) : 16) * shw_ld + 2048; return wid < 4 ? shp + u.pm * BM + i : rss + u.pn * BM + i; }
        return wid < 4 ? rss + u.pm * BM + i : shw + (size_t)(u.pm < (MLAT / BM) ? (u.pm >> 3) : 16) * shw_ld + u.pn * BM + i;
    }
    __device__ __forceinline__ void operator()(const f32x4 (&acc)[2][2][4][2], const Unit& u, int wr, int wc, int fr, int fq, const LAS float* aux) const {
        const int row0 = u.pm * BM + wr * 64 + fr;
        if (mode == 5) {
            if (wr == 0) {
#pragma unroll
                for (int m = 0; m < 2; ++m) { const int row = m * 16 + fr;
                    if (row < 17) {
#pragma unroll
                        for (int bj = 0; bj < 2; ++bj)
#pragma unroll
                            for (int n = 0; n < 2; ++n) *(f32x4*)(outf5 + (size_t)row * ldc + u.pn * BM + bj * HALF + wc * 32 + 8 * fq + 4 * n) = acc[0][bj][m][n]; } }
            }
            return;
        }
        if (mode <= 1) {
            const float s = (u.pn < scale_tiles) ? sc : 1.f;
            const int col0 = u.pn * BM + wc * 32 + 8 * fq;
            f32x4 bv[2][2];
#pragma unroll
            for (int bj = 0; bj < 2; ++bj)
#pragma unroll
                for (int n = 0; n < 2; ++n) bv[bj][n] = rss ? *(const LAS f32x4*)(aux + 256 + wc * 32 + 8 * fq + bj * HALF + 4 * n) : (f32x4){0.f, 0.f, 0.f, 0.f};
#pragma unroll
            for (int ai = 0; ai < 2; ++ai)
#pragma unroll
                for (int m = 0; m < 4; ++m) { const int row = row0 + ai * HALF + m * 16; bf16_t* rowp = O + (size_t)row * ldc + col0;
                    const float rinv = rss ? __builtin_amdgcn_rsqf(aux[wr * 64 + fr + ai * HALF + m * 16] * (1.f / DM) + RMS_EPS) : 1.f;
#pragma unroll
                    for (int bj = 0; bj < 2; ++bj) { f32x4 v0 = acc[ai][bj][m][0] * rinv + bv[bj][0], v1 = acc[ai][bj][m][1] * rinv + bv[bj][1];
                        if (mode == 1) { v0 = __builtin_elementwise_max(v0, (f32x4){0.f, 0.f, 0.f, 0.f}); v1 = __builtin_elementwise_max(v1, (f32x4){0.f, 0.f, 0.f, 0.f}); v0 = v0 * v0; v1 = v1 * v1; }
                        v0 = v0 * s; v1 = v1 * s;
                        u32x4 w; w.x = cvt_pk_bf16(v0[0], v0[1]); w.y = cvt_pk_bf16(v0[2], v0[3]); w.z = cvt_pk_bf16(v1[0], v1[1]); w.w = cvt_pk_bf16(v1[2], v1[3]);
                        *(u32x4*)(rowp + bj * HALF) = w; } }
        } else if (mode == 4) {
            const int col0 = u.pn * BM + wc * 32 + 8 * fq;
            f32x4 cinv[2][2];
#pragma unroll
            for (int bj = 0; bj < 2; ++bj)
#pragma unroll
                for (int n = 0; n < 2; ++n) { const f32x4 q = *(const LAS f32x4*)(aux + 256 + wc * 32 + 8 * fq + bj * HALF + 4 * n);
#pragma unroll
                    for (int e = 0; e < 4; ++e) cinv[bj][n][e] = __builtin_amdgcn_rsqf(q[e] * (1.f / DM) + RMS_EPS); }
#pragma unroll
            for (int ai = 0; ai < 2; ++ai)
#pragma unroll
                for (int m = 0; m < 4; ++m) { const int row = row0 + ai * HALF + m * 16; bf16_t* rowp = O + (size_t)row * ldc + col0; const float bias = aux[wr * 64 + fr + ai * HALF + m * 16];
#pragma unroll
                    for (int bj = 0; bj < 2; ++bj) { const f32x4 v0 = acc[ai][bj][m][0] * cinv[bj][0] + bias, v1 = acc[ai][bj][m][1] * cinv[bj][1] + bias;
                        u32x4 w; w.x = cvt_pk_bf16(v0[0], v0[1]); w.y = cvt_pk_bf16(v0[2], v0[3]); w.z = cvt_pk_bf16(v1[0], v1[1]); w.w = cvt_pk_bf16(v1[2], v1[3]);
                        *(u32x4*)(rowp + bj * HALF) = w; } }
        } else if (mode == 2) {
            if (u.pn < 8) {
                const int col0 = u.pn * HALF + wc * 32 + 8 * fq;
#pragma unroll
                for (int ai = 0; ai < 2; ++ai)
#pragma unroll
                    for (int m = 0; m < 4; ++m) { bf16_t* rowp = O + (size_t)(row0 + ai * HALF + m * 16) * 1024 + col0;
                        const f32x4 v0 = acc[ai][0][m][0] * acc[ai][1][m][0], v1 = acc[ai][0][m][1] * acc[ai][1][m][1];
                        u32x4 w; w.x = cvt_pk_bf16(v0[0], v0[1]); w.y = cvt_pk_bf16(v0[2], v0[3]); w.z = cvt_pk_bf16(v1[0], v1[1]); w.w = cvt_pk_bf16(v1[2], v1[3]);
                        *(u32x4*)rowp = w; }
            } else {
                const int col0 = (u.pn - 8) * BM + wc * 32 + 8 * fq;
#pragma unroll
                for (int ai = 0; ai < 2; ++ai)
#pragma unroll
                    for (int m = 0; m < 4; ++m) { bf16_t* rowp = O2 + (size_t)(row0 + ai * HALF + m * 16) * 1024 + col0;
#pragma unroll
                        for (int bj = 0; bj < 2; ++bj) { const f32x4 v0 = acc[ai][bj][m][0], v1 = acc[ai][bj][m][1];
                            u32x4 w; w.x = cvt_pk_bf16(v0[0], v0[1]); w.y = cvt_pk_bf16(v0[2], v0[3]); w.z = cvt_pk_bf16(v1[0], v1[1]); w.w = cvt_pk_bf16(v1[2], v1[3]);
                            *(u32x4*)(rowp + bj * HALF) = w; } }
            }
        } else {
            const bool lat = u.pm < (MLAT / BM);
            const int prow = (lat ? u.pm : u.pm - MLAT / BM) * BM + wr * 64 + fr;
            const float* in = lat ? inLat : inCtx; const bf16_t* inb = lat ? inbLat : inbCtx; bf16_t* out = lat ? outLat : outCtx;
            const int brow = lat ? (u.pm >> 3) : 16;
            const float* gp = gate + (size_t)brow * 6144;
            const int col0 = u.pn * BM + wc * 32 + 8 * fq;
            f32x4 gv[2][2], gm[2][2];
#pragma unroll
            for (int bj = 0; bj < 2; ++bj)
#pragma unroll
                for (int n = 0; n < 2; ++n) { gv[bj][n] = *(const f32x4*)(gp + col0 + bj * HALF + 4 * n);
                    gm[bj][n] = An ? *(const f32x4*)(gn + col0 + bj * HALF + 4 * n) * (*(const f32x4*)(scn + (size_t)brow * 6144 + col0 + bj * HALF + 4 * n) + 1.0f) : (f32x4){0.f, 0.f, 0.f, 0.f}; }
#pragma unroll
            for (int ai = 0; ai < 2; ++ai)
#pragma unroll
                for (int m = 0; m < 4; ++m) { const size_t off = (size_t)(prow + ai * HALF + m * 16) * 1024 + col0; float ss = 0.f;
#pragma unroll
                    for (int bj = 0; bj < 2; ++bj) { f32x4 xo[2];
                        if (in) { xo[0] = *(const f32x4*)(in + off + bj * HALF); xo[1] = *(const f32x4*)(in + off + bj * HALF + 4); }
                        else { const u32x4 xw = *(const u32x4*)(inb + off + bj * HALF);
                            xo[0] = (f32x4){__builtin_bit_cast(float, xw.x << 16), __builtin_bit_cast(float, xw.x & 0xffff0000u), __builtin_bit_cast(float, xw.y << 16), __builtin_bit_cast(float, xw.y & 0xffff0000u)};
                            xo[1] = (f32x4){__builtin_bit_cast(float, xw.z << 16), __builtin_bit_cast(float, xw.z & 0xffff0000u), __builtin_bit_cast(float, xw.w << 16), __builtin_bit_cast(float, xw.w & 0xffff0000u)}; }
#pragma unroll
                        for (int n = 0; n < 2; ++n) { xo[n] = xo[n] + gv[bj][n] * acc[ai][bj][m][n];
                            ss += (xo[n][0] * xo[n][0] + xo[n][1] * xo[n][1]) + (xo[n][2] * xo[n][2] + xo[n][3] * xo[n][3]); }
                        { u32x4 w; w.x = cvt_pk_bf16(xo[0][0], xo[0][1]); w.y = cvt_pk_bf16(xo[0][2], xo[0][3]); w.z = cvt_pk_bf16(xo[1][0], xo[1][1]); w.w = cvt_pk_bf16(xo[1][2], xo[1][3]);
                          *(u32x4*)(out + off + bj * HALF) = w; }
                        if (An) { const f32x4 a0 = xo[0] * gm[bj][0], a1 = xo[1] * gm[bj][1];
                            u32x4 w; w.x = cvt_pk_bf16(a0[0], a0[1]); w.y = cvt_pk_bf16(a0[2], a0[3]); w.z = cvt_pk_bf16(a1[0], a1[1]); w.w = cvt_pk_bf16(a1[2], a1[3]);
                            *(u32x4*)(An + (size_t)(row0 + ai * HALF + m * 16) * 1024 + col0 + bj * HALF) = w; } }
                    if (rssn) { ss = xsum16(ss); if (fq == 0) atomicAdd(rssn + row0 + ai * HALF + m * 16, ss); }
                    if (m == 3) asm volatile("" ::: "memory"); }
        }
    }
};

template <class Epi, class Sched, bool ALIGN_EPI = false, bool SP2 = false>
__device__ __forceinline__ void gemm_phase(LAS unsigned char* lds, const Gemm g, const Sched& S, const Epi& E) {
    int tid = threadIdx.x; asm volatile("" : "+v"(tid));
    const int wid = __builtin_amdgcn_readfirstlane(tid >> 6), lane = tid & 63, wr = wid >> 2, wc = wid & 3, fr = lane & 15, fq = lane >> 4;
    const int K = g.K, nt = K / BK;
    unsigned voffA[2], voffB[2];
#pragma unroll
    for (int i = 0; i < 2; ++i) { int R, C; stage_rc(tid * 16 + i * 8192, R, C); const int Rb = (R & ~31) + perm32(R & 31);
        voffA[i] = (unsigned)(R * K + C) * 2u; voffB[i] = (unsigned)(Rb * K + C) * 2u; }
    const size_t kstep = (size_t)(BK * 2);
    const size_t hstep = (size_t)HALF * K * 2;
    const size_t tstep = 2 * hstep;
    const unsigned ldsw = (unsigned)wid * 1024u;
    const int aoff = lds_byte(wr * 64 + fr, fq * 8), boff = lds_byte(wc * 32 + fr, fq * 8);
#define PG8_SA(b, h) (((b) * 2 + (h)) * HTB)
#define PG8_SB(b, h) ((4 + (b) * 2 + (h)) * HTB)
#define PG8_STAGE(bufoff, gbase, voff) do { _Pragma("unroll") for (int _i = 0; _i < 2; ++_i) \
        __builtin_amdgcn_global_load_lds((const unsigned*)((const char*)(gbase) + (voff)[_i]), (LAS unsigned*)(lds + (bufoff) + ldsw + _i * 8192), 16, 0, 0); } while (0)
#define PG8_LDA(dst, b, h) do { _Pragma("unroll") for (int m = 0; m < 4; ++m) _Pragma("unroll") for (int k = 0; k < 2; ++k) dst[m][k] = *(const LAS bf16x8*)(lds + PG8_SA(b, h) + aoff + m * 2048 + k * 1024); } while (0)
#define PG8_LDB(dst, b, h) do { _Pragma("unroll") for (int n = 0; n < 2; ++n) _Pragma("unroll") for (int k = 0; k < 2; ++k) dst[n][k] = *(const LAS bf16x8*)(lds + PG8_SB(b, h) + boff + n * 2048 + k * 1024); } while (0)
#define PG8_MMA(ai, bj, At, Bt) do { __builtin_amdgcn_s_setprio(1); _Pragma("unroll") for (int m = 0; m < 4; ++m) _Pragma("unroll") for (int n = 0; n < 2; ++n) _Pragma("unroll") for (int k = 0; k < 2; ++k) \
        acc[ai][bj][m][n] = __builtin_amdgcn_mfma_f32_16x16x32_bf16(Bt[n][k], At[m][k], acc[ai][bj][m][n], 0, 0, 0); __builtin_amdgcn_s_setprio(0); } while (0)
#define PG8_WAIT_V(n) asm volatile("s_waitcnt vmcnt(" #n ")" ::: "memory")
#define PG8_WAIT_L(n) asm volatile("s_waitcnt lgkmcnt(" #n ")" ::: "memory")
#define PG8_BAR __builtin_amdgcn_s_barrier()
#define PG8_SCHED __builtin_amdgcn_sched_barrier(0)
    Unit cur, nxt; int ui = 0;
    if (!S.next(0, cur)) return;
    constexpr int AUX_OFF = STAGE_BYTES + 1024;
    const bool use_aux = E.has_aux();
    if (use_aux) __builtin_amdgcn_global_load_lds((const unsigned*)E.aux_src(cur, wid, lane), (LAS unsigned*)(lds + AUX_OFF + wid * 256), 4, 0, 0);
    f32x4 acc[2][2][4][2];
#pragma unroll
    for (int a = 0; a < 2; ++a)
#pragma unroll
        for (int b = 0; b < 2; ++b)
#pragma unroll
            for (int m = 0; m < 4; ++m)
#pragma unroll
                for (int n = 0; n < 2; ++n) acc[a][b][m][n] = (f32x4){0.f, 0.f, 0.f, 0.f};
    bf16x8 At[4][2], B0[2][2], B1[2][2];
    const char* cA = (const char*)g.A + (size_t)cur.pm * tstep; const char* cB = (const char*)g.Bt + (size_t)cur.pn * tstep;
    if constexpr (SP2) {
        PG8_STAGE(PG8_SB(0, 0), cB, voffB); PG8_STAGE(PG8_SB(0, 1), cB + hstep, voffB); PG8_STAGE(PG8_SA(0, 0), cA, voffA); PG8_STAGE(PG8_SA(0, 1), cA + hstep, voffA);
        if (wr == 1) PG8_BAR;
        PG8_WAIT_V(2); PG8_BAR;
        PG8_STAGE(PG8_SB(1, 0), cB + kstep, voffB); PG8_STAGE(PG8_SA(1, 0), cA + kstep, voffA); PG8_STAGE(PG8_SB(1, 1), cB + hstep + kstep, voffB);
        PG8_WAIT_V(6); PG8_BAR;
    } else {
        PG8_STAGE(PG8_SB(0, 0), cB, voffB); PG8_STAGE(PG8_SA(0, 0), cA, voffA); PG8_STAGE(PG8_SB(0, 1), cB + hstep, voffB); PG8_STAGE(PG8_SA(0, 1), cA + hstep, voffA);
        if (wr == 1) PG8_BAR;
        PG8_WAIT_V(4); PG8_BAR;
        PG8_STAGE(PG8_SB(1, 0), cB + kstep, voffB); PG8_STAGE(PG8_SA(1, 0), cA + kstep, voffA); PG8_STAGE(PG8_SB(1, 1), cB + hstep + kstep, voffB);
        PG8_WAIT_V(6); PG8_BAR;
    }
    for (;;) {
        const bool has_next = S.next(ui + 1, nxt);
        const char* nA = has_next ? (const char*)g.A + (size_t)nxt.pm * tstep : cA; const char* nB = has_next ? (const char*)g.Bt + (size_t)nxt.pn * tstep : cB;
        for (int t = 0; t < nt; t += 2) {
            const bool last = (t == nt - 2);
            const char* a1 = cA + (size_t)(t + 1) * kstep;
            const char* a2 = last ? nA : cA + (size_t)(t + 2) * kstep; const char* b2 = last ? nB : cB + (size_t)(t + 2) * kstep;
            const char* a3 = a2 + kstep; const char* b3 = b2 + kstep;
            if constexpr (SP2) {
            PG8_LDB(B0, 0, 0); PG8_LDB(B1, 0, 1); PG8_SCHED; PG8_LDA(At, 0, 0); PG8_STAGE(PG8_SA(1, 1), a1 + hstep, voffA);
            PG8_WAIT_V(8); PG8_WAIT_L(0); PG8_BAR; PG8_MMA(0, 0, At, B0); PG8_MMA(0, 1, At, B1); PG8_BAR; PG8_SCHED;
            PG8_LDA(At, 0, 1); PG8_STAGE(PG8_SB(0, 0), b2, voffB); PG8_STAGE(PG8_SB(0, 1), b2 + hstep, voffB); PG8_STAGE(PG8_SA(0, 0), a2, voffA);
            PG8_WAIT_V(8); PG8_WAIT_L(0); PG8_BAR; PG8_MMA(1, 0, At, B0); PG8_MMA(1, 1, At, B1); PG8_BAR; PG8_SCHED;
            PG8_LDB(B0, 1, 0); PG8_LDB(B1, 1, 1); PG8_SCHED; PG8_LDA(At, 1, 0); PG8_STAGE(PG8_SA(0, 1), a2 + hstep, voffA);
            PG8_WAIT_V(8); PG8_WAIT_L(0); PG8_BAR; PG8_MMA(0, 0, At, B0); PG8_MMA(0, 1, At, B1); PG8_BAR; PG8_SCHED;
            PG8_LDA(At, 1, 1); PG8_STAGE(PG8_SB(1, 0), b3, voffB); PG8_STAGE(PG8_SB(1, 1), b3 + hstep, voffB); PG8_STAGE(PG8_SA(1, 0), a3, voffA);
            PG8_WAIT_V(8); PG8_WAIT_L(0); PG8_BAR; PG8_MMA(1, 0, At, B0); PG8_MMA(1, 1, At, B1); PG8_BAR; PG8_SCHED;
            } else {
            PG8_LDB(B0, 0, 0); PG8_SCHED; PG8_LDA(At, 0, 0); PG8_STAGE(PG8_SA(1, 1), a1 + hstep, voffA);
            PG8_WAIT_L(8); PG8_BAR; PG8_WAIT_L(0); PG8_MMA(0, 0, At, B0); PG8_BAR; PG8_SCHED;
            PG8_LDB(B1, 0, 1); PG8_STAGE(PG8_SB(0, 0), b2, voffB);
            PG8_BAR; PG8_WAIT_L(0); PG8_MMA(0, 1, At, B1); PG8_BAR;
            PG8_LDA(At, 0, 1); PG8_STAGE(PG8_SA(0, 0), a2, voffA);
            PG8_BAR; PG8_WAIT_L(0); PG8_MMA(1, 0, At, B0); PG8_BAR; PG8_SCHED;
            PG8_STAGE(PG8_SB(0, 1), b2 + hstep, voffB);
            PG8_WAIT_V(6); PG8_BAR; PG8_MMA(1, 1, At, B1); PG8_BAR;
            PG8_LDB(B0, 1, 0); PG8_SCHED; PG8_LDA(At, 1, 0); PG8_STAGE(PG8_SA(0, 1), a2 + hstep, voffA);
            PG8_WAIT_L(8); PG8_BAR; PG8_WAIT_L(0); PG8_MMA(0, 0, At, B0); PG8_BAR; PG8_SCHED;
            PG8_LDB(B1, 1, 1); PG8_STAGE(PG8_SB(1, 0), b3, voffB);
            PG8_BAR; PG8_WAIT_L(0); PG8_MMA(0, 1, At, B1); PG8_BAR;
            PG8_LDA(At, 1, 1); PG8_STAGE(PG8_SA(1, 0), a3, voffA);
            PG8_BAR; PG8_WAIT_L(0); PG8_MMA(1, 0, At, B0); PG8_BAR; PG8_SCHED;
            PG8_STAGE(PG8_SB(1, 1), b3 + hstep, voffB);
            PG8_WAIT_V(6); PG8_BAR; PG8_MMA(1, 1, At, B1); PG8_BAR;
            }
        }
        if constexpr (ALIGN_EPI) { if (wr == 0) PG8_BAR; }
        E(acc, cur, wr, wc, fr, fq, (const LAS float*)(lds + AUX_OFF + (ui & 1) * 2048));
        if (use_aux && has_next) __builtin_amdgcn_global_load_lds((const unsigned*)E.aux_src(nxt, wid, lane), (LAS unsigned*)(lds + AUX_OFF + ((ui + 1) & 1) * 2048 + wid * 256), 4, 0, 0);
        if (!has_next) break;
#pragma unroll
        for (int a = 0; a < 2; ++a)
#pragma unroll
            for (int b = 0; b < 2; ++b)
#pragma unroll
                for (int m = 0; m < 4; ++m)
#pragma unroll
                    for (int n = 0; n < 2; ++n) acc[a][b][m][n] = (f32x4){0.f, 0.f, 0.f, 0.f};
        cur = nxt; cA = nA; cB = nB; ++ui;
        if constexpr (ALIGN_EPI) { if (wr == 1) PG8_BAR; }
    }
    PG8_WAIT_V(0);
    if constexpr (!ALIGN_EPI) { if (wr == 0) PG8_BAR; }
    PG8_BAR;
#undef PG8_SA
#undef PG8_SB
#undef PG8_STAGE
#undef PG8_LDA
#undef PG8_LDB
#undef PG8_MMA
#undef PG8_WAIT_V
#undef PG8_WAIT_L
#undef PG8_BAR
#undef PG8_SCHED
}
}

__device__ __forceinline__ unsigned f2bf(float f) { unsigned u = __builtin_bit_cast(unsigned, f); return (u + 0x7fffu + ((u >> 16) & 1u)) >> 16; }
__device__ __forceinline__ unsigned pk2(float lo, float hi) { return pg8::cvt_pk_bf16(lo, hi); }
__device__ __forceinline__ float bf_lo(unsigned w) { return __builtin_bit_cast(float, w << 16); }
__device__ __forceinline__ float bf_hi(unsigned w) { return __builtin_bit_cast(float, w & 0xffff0000u); }
__device__ __forceinline__ float wave_sum(float v) {
#pragma unroll
    for (int o = 1; o < 64; o <<= 1) v += __shfl_xor(v, o);
    return v;
}
#define LDS_WAIT() asm volatile("s_waitcnt lgkmcnt(0)" ::: "memory")

struct Args {
    const float* in[17];
    float* out; unsigned char* ws;
    int ph_lo, ph_hi;
};

struct TrDesc { const float* W; bf16_t* WT; int K, N, cinmap, item; };
__device__ __forceinline__ void tr_load(const TrDesc& d, float (&wv)[32], int lane) {
    const int nblk = d.N / 32, kb = d.item / nblk, nb = d.item % nblk, k0 = 64 * kb, n0 = 32 * nb;
#pragma unroll
    for (int i = 0; i < 32; ++i) { const int kk = 2 * i + (lane >> 5); wv[i] = d.W[(size_t)(k0 + kk) * d.N + n0 + (lane & 31)]; }
}
__device__ __forceinline__ void tr_store(const TrDesc& d, const float (&wv)[32], LAS float* scr, int lane) {
    const int K = d.K, nblk = d.N / 32, kb = d.item / nblk, nb = d.item % nblk, k0 = 64 * kb, n0 = 32 * nb;
#pragma unroll
    for (int i = 0; i < 32; ++i) { const int kk = 2 * i + (lane >> 5); scr[kk * 33 + (lane & 31)] = wv[i]; }
    LDS_WAIT(); asm volatile("" ::: "memory");
    int d0 = n0;
    if (d.cinmap) { if (n0 < 1024) d0 = 2048 + n0; else if (n0 < 2048) { const int ch = n0 - 1024; d0 = (ch >> 7) * 256 + (ch & 127); } else { const int ch = n0 - 2048; d0 = (ch >> 7) * 256 + 128 + (ch & 127); } }
    const int c = lane & 7;
#pragma unroll
    for (int j = 0; j < 4; ++j) { const int n = (lane >> 3) + 8 * j; const LAS float* sp = scr + (8 * c) * 33 + n;
        u32x4 o; o.x = pk2(sp[0 * 33], sp[1 * 33]); o.y = pk2(sp[2 * 33], sp[3 * 33]); o.z = pk2(sp[4 * 33], sp[5 * 33]); o.w = pk2(sp[6 * 33], sp[7 * 33]);
        *(u32x4*)(d.WT + (size_t)(d0 + n) * K + k0 + 8 * c) = o; }
    LDS_WAIT(); asm volatile("" ::: "memory");
}

__device__ __forceinline__ void gemv17_unit(const LAS float* S, LAS float* red, const float* W, int ldw, int n0, const float* bias, float* out, int ldo, int tid, int lane, int wave) {
    const float* Wp = W + n0 + (lane & 31);
    const int kbase = wave * 128 + (lane >> 5);
    float acc[17];
#pragma unroll
    for (int r = 0; r < 17; ++r) acc[r] = 0.f;
#pragma unroll 1
    for (int ib = 0; ib < 64; ib += 32) {
        float wv[32];
#pragma unroll
        for (int i = 0; i < 32; ++i) wv[i] = Wp[(size_t)(kbase + 2 * (ib + i)) * ldw];
#pragma unroll
        for (int i = 0; i < 32; ++i) { const int k = kbase + 2 * (ib + i);
#pragma unroll
            for (int r = 0; r < 17; ++r) acc[r] += S[r * 1024 + k] * wv[i]; }
    }
#pragma unroll
    for (int r = 0; r < 17; ++r) acc[r] += __shfl_xor(acc[r], 32);
    if (lane < 32) {
#pragma unroll
        for (int r = 0; r < 17; ++r) red[(wave * 17 + r) * 32 + lane] = acc[r]; }
    __syncthreads();
    for (int o = tid; o < 17 * 32; o += 512) { const int r = o >> 5, c2 = o & 31; float s = bias ? bias[n0 + c2] : 0.f;
#pragma unroll
        for (int w = 0; w < 8; ++w) s += red[(w * 17 + r) * 32 + c2];
        out[(size_t)r * ldo + n0 + c2] = s; }
    __syncthreads();
}

__device__ __forceinline__ void p0_phase(const Args& a, LAS unsigned char* lds, int tid, int lane, int wave, int bid, int G) {
    { float* rss = (float*)(a.ws + WS_RSS); for (int i = bid * 512 + tid; i < 4 * MALL; i += G * 512) rss[i] = 0.f; }
    {
        LAS float* S = (LAS float*)lds;
        LAS float* red = (LAS float*)(lds + 17 * 1024 * 4);
        const float* c = a.in[1]; const float* cc = a.in[3]; const float* ada_w = a.in[6]; const float* ada_b = a.in[7];
        float* mod = (float*)(a.ws + WS_MOD);
        for (int i = tid; i < 17 * 1024; i += 512) { const float v = i < 16384 ? c[i] : cc[i - 16384]; S[i] = v / (1.f + __expf(-v)); }
        __syncthreads();
        for (int unit = bid; unit < 384; unit += G) {
            const int l = unit / 192, n0 = (unit % 192) * 32;
            gemv17_unit(S, red, ada_w + (size_t)l * 1024 * 6144, 6144, n0, ada_b + l * 6144, mod + (size_t)l * 17 * 6144, 6144, tid, lane, wave);
        }
    }
    {
        LAS float* scr = (LAS float*)(lds + wave * 16384);
        const int gw = bid * 8 + wave, NGW = G * 8;
        constexpr int I_CIN = 16 * 96, I_SQ = 16 * 32, I_UP = 16 * 128, I_DN = 64 * 32;
        constexpr int NITEMS = 2 * I_CIN + 2 * I_SQ + 2 * I_UP + 2 * I_DN;
        bf16_t* ws16 = (bf16_t*)a.ws;
        auto desc = [&](int it) -> TrDesc {
            int r = it;
            if (r < I_CIN) return TrDesc{a.in[8], (bf16_t*)(a.ws + WS_WCIN), 1024, 3072, 1, r}; r -= I_CIN;
            if (r < I_CIN) return TrDesc{a.in[11], (bf16_t*)(a.ws + WS_WQKV), 1024, 3072, 0, r}; r -= I_CIN;
            if (r < I_SQ) return TrDesc{a.in[10], (bf16_t*)(a.ws + WS_WCOUT), 1024, 1024, 0, r}; r -= I_SQ;
            if (r < I_SQ) return TrDesc{a.in[13], (bf16_t*)(a.ws + WS_WAO), 1024, 1024, 0, r}; r -= I_SQ;
            if (r < 2 * I_UP) { const int l = r / I_UP; return TrDesc{a.in[14] + (size_t)l * 1024 * 4096, (bf16_t*)(a.ws + WS_W1) + (size_t)l * 4096 * 1024, 1024, 4096, 0, r % I_UP}; } r -= 2 * I_UP;
            { const int l = r / I_DN; return TrDesc{a.in[15] + (size_t)l * 4096 * 1024, (bf16_t*)(a.ws + WS_W2) + (size_t)l * 1024 * 4096, 4096, 1024, 0, r % I_DN}; }
        };
        float wA[32], wB[32]; TrDesc dA = desc(0), dB = dA;
        int it = gw; bool hA = it < NITEMS;
        if (hA) { dA = desc(it); tr_load(dA, wA, lane); }
        while (hA) {
            const int itB = it + NGW; const bool hB = itB < NITEMS;
            if (hB) { dB = desc(itB); tr_load(dB, wB, lane); }
            tr_store(dA, wA, scr, lane);
            if (!hB) break;
            it = itB + NGW; hA = it < NITEMS;
            if (hA) { dA = desc(it); tr_load(dA, wA, lane); }
            tr_store(dB, wB, scr, lane);
        }
        (void)ws16;
    }
}

__device__ __forceinline__ void shw_jobs(const Args& a, LAS unsigned char* lds, int tid, int lane, int wave, int bid, int G) {
    LAS float* S = (LAS float*)lds; LAS float* red = (LAS float*)(lds + 17 * 1024 * 4);
    const float* mod = (const float*)(a.ws + WS_MOD); float* shw = (float*)(a.ws + WS_SHW);
    __syncthreads();
#pragma unroll 1
    for (int job = 0; job < 3; ++job) {
        const int N = (job == 1) ? 3072 : 4096, nunits = N / 32, off = (job == 0) ? 0 : (job == 1) ? 128 : 224;
        const float* W = (job == 0) ? a.in[14] : (job == 1) ? a.in[11] : a.in[14] + (size_t)1024 * 4096;
        const float* sh = mod + (job == 0 ? 3 * 1024 : job == 1 ? 17 * 6144 : 17 * 6144 + 3 * 1024);
        float* out = shw + (job == 0 ? 0 : job == 1 ? 17 * 4096 : 17 * 4096 + 17 * 3072);
        int unit = bid - off; if (unit < 0) unit += G;
        if (unit < nunits) {
            for (int i = tid; i < 17 * 1024; i += 512) S[i] = sh[(size_t)(i >> 10) * 6144 + (i & 1023)];
            __syncthreads();
            for (; unit < nunits; unit += G) gemv17_unit(S, red, W, N, unit * 32, nullptr, out, N, tid, lane, wave);
        }
    }
}

__device__ __forceinline__ void norm_phase(const float* xlat, const float* xctx, int nrows, const float* g, const float* modl, int sh_chunk, int sc_chunk,
                                           bf16_t* H, float* outf, const float* rssf, int gw, int NGW, int lane) {
    constexpr int R = 4;
    const int ngroups = nrows / R;
    auto load = [&](int grp, f32x4 (&v)[R][4]) {
#pragma unroll
        for (int q = 0; q < R; ++q) { const int row = grp * R + q; const bool lat = row < MLAT;
            const f32x4* xr = (const f32x4*)(lat ? xlat + (size_t)row * DM : xctx + (size_t)(row - MLAT) * DM) + lane;
#pragma unroll
            for (int jx = 0; jx < 4; ++jx) v[q][jx] = xr[64 * jx]; }
    };
    auto finish = [&](int grp, const f32x4 (&v)[R][4]) {
        float inv[R];
        if (rssf) {
#pragma unroll
            for (int q = 0; q < R; ++q) inv[q] = rsqrtf(rssf[grp * R + q] * (1.f / DM) + RMS_EPS);
        } else {
            float s[R];
#pragma unroll
            for (int q = 0; q < R; ++q) { s[q] = 0.f;
#pragma unroll
                for (int jx = 0; jx < 4; ++jx) s[q] += (v[q][jx].x * v[q][jx].x + v[q][jx].y * v[q][jx].y) + (v[q][jx].z * v[q][jx].z + v[q][jx].w * v[q][jx].w); }
#pragma unroll
            for (int o = 1; o < 64; o <<= 1) {
#pragma unroll
                for (int q = 0; q < R; ++q) s[q] += __shfl_xor(s[q], o); }
#pragma unroll
            for (int q = 0; q < R; ++q) inv[q] = rsqrtf(s[q] * (1.f / DM) + RMS_EPS);
        }
        f32x4 mg[4], ms[4];
        if (modl) { const int row0_ = grp * R; const float* mr = modl + (size_t)(row0_ < MLAT ? (row0_ >> 11) : 16) * 6144;
#pragma unroll
            for (int jx = 0; jx < 4; ++jx) { const int c = 4 * lane + 256 * jx;
                mg[jx] = *(const f32x4*)(g + c) * (*(const f32x4*)(mr + sc_chunk * 1024 + c) + 1.0f); ms[jx] = *(const f32x4*)(mr + sh_chunk * 1024 + c); } }
#pragma unroll
        for (int q = 0; q < R; ++q) { const int row = grp * R + q;
            if (modl) {
                unsigned long long* o8 = (unsigned long long*)(H + (size_t)row * DM) + lane;
#pragma unroll
                for (int jx = 0; jx < 4; ++jx) {
                    const f32x4 o = (v[q][jx] * inv[q]) * mg[jx] + ms[jx];
                    o8[64 * jx] = (unsigned long long)pk2(o.x, o.y) | ((unsigned long long)pk2(o.z, o.w) << 32); }
            } else {
                f32x4* orow = (f32x4*)(outf + (size_t)row * DM) + lane;
#pragma unroll
                for (int jx = 0; jx < 4; ++jx) { const int c = 4 * lane + 256 * jx; const f32x4 gg = *(const f32x4*)(g + c); orow[64 * jx] = v[q][jx] * inv[q] * gg; }
            }
        }
    };
    f32x4 vA[R][4], vB[R][4];
    int grp = gw; bool hA = grp < ngroups;
    if (hA) load(grp, vA);
    while (hA) {
        const int gB = grp + NGW; const bool hB = gB < ngroups;
        if (hB) load(gB, vB);
        finish(grp, vA);
        if (!hB) break;
        grp = gB + NGW; hA = grp < ngroups;
        if (hA) load(grp, vA);
        finish(gB, vB);
    }
}

__device__ __forceinline__ void final_phase(const bf16_t* xb, const float* rssf, const float* g, float* out, int gw, int NGW, int lane) {
    constexpr int R = 4;
    for (int grp = gw; grp < MLAT / R; grp += NGW) {
        u32x4 v[R][2];
#pragma unroll
        for (int q = 0; q < R; ++q)
#pragma unroll
            for (int jx = 0; jx < 2; ++jx) v[q][jx] = *(const u32x4*)(xb + (size_t)(grp * R + q) * DM + jx * 512 + lane * 8);
        f32x4 gv0[2], gv1[2];
#pragma unroll
        for (int jx = 0; jx < 2; ++jx) { const int c = jx * 512 + lane * 8; gv0[jx] = *(const f32x4*)(g + c); gv1[jx] = *(const f32x4*)(g + c + 4); }
#pragma unroll
        for (int q = 0; q < R; ++q) { const int row = grp * R + q; const float inv = rsqrtf(rssf[row] * (1.f / DM) + RMS_EPS);
#pragma unroll
            for (int jx = 0; jx < 2; ++jx) { const int c = jx * 512 + lane * 8; const f32x4 g0 = gv0[jx], g1 = gv1[jx]; const u32x4 w = v[q][jx];
                const f32x4 x0 = (f32x4){bf_lo(w.x), bf_hi(w.x), bf_lo(w.y), bf_hi(w.y)}, x1 = (f32x4){bf_lo(w.z), bf_hi(w.z), bf_lo(w.w), bf_hi(w.w)};
                *(f32x4*)(out + (size_t)row * DM + c) = x0 * inv * g0; *(f32x4*)(out + (size_t)row * DM + c + 4) = x1 * inv * g1; } }
    }
}

__device__ __forceinline__ void unpack8(const u32x4 w, float (&f)[8]) { f[0] = bf_lo(w.x); f[1] = bf_hi(w.x); f[2] = bf_lo(w.y); f[3] = bf_hi(w.y); f[4] = bf_lo(w.z); f[5] = bf_hi(w.z); f[6] = bf_lo(w.w); f[7] = bf_hi(w.w); }
__device__ __forceinline__ void unpack4(const u32x2 w, float (&f)[4]) { f[0] = bf_lo(w.x); f[1] = bf_hi(w.x); f[2] = bf_lo(w.y); f[3] = bf_hi(w.y); }
__device__ __forceinline__ void convgate_phase(const bf16_t* U, const bf16_t* Bg, const float* cw, bf16_t* Gout, int gw, int NGW, int lane) {
    constexpr int RC = 8;
    for (int item = gw; item < (MALL / RC) * 4; item += NGW) {
        const int chunk = item >> 2, strip = item & 3, t0 = chunk * RC, ch = strip * 256 + lane * 4;
        const int tl = t0 < MLAT ? (t0 & (SEQ - 1)) : ((t0 - MLAT) & (CTXL - 1)); const int sl = t0 < MLAT ? SEQ : CTXL;
        const bool first = (tl == 0), lastc = (tl + RC == sl);
        const f32x4 w0 = *(const f32x4*)(cw + ch), w1 = *(const f32x4*)(cw + 1024 + ch), w2 = *(const f32x4*)(cw + 2048 + ch);
        const bf16_t* up = U + (size_t)t0 * DM + ch; const bf16_t* bp = Bg + (size_t)t0 * DM + ch; bf16_t* gp = Gout + (size_t)t0 * DM + ch;
        const u32x2 zero = (u32x2){0u, 0u};
        u32x2 uw[RC + 2], bw[RC];
        uw[0] = first ? zero : *(const u32x2*)(up - DM);
#pragma unroll
        for (int t = 0; t < RC; ++t) { uw[t + 1] = *(const u32x2*)(up + (size_t)t * DM); bw[t] = *(const u32x2*)(bp + (size_t)t * DM); }
        uw[RC + 1] = lastc ? zero : *(const u32x2*)(up + (size_t)RC * DM);
#pragma unroll
        for (int t = 0; t < RC; ++t) {
            float pf[4], cf[4], nf[4], bf[4];
            unpack4(uw[t], pf); unpack4(uw[t + 1], cf); unpack4(uw[t + 2], nf); unpack4(bw[t], bf);
            float o[4];
#pragma unroll
            for (int e = 0; e < 4; ++e) o[e] = bf[e] * (w0[e] * pf[e] + w1[e] * cf[e] + w2[e] * nf[e]);
            u32x2 ow; ow.x = pk2(o[0], o[1]); ow.y = pk2(o[2], o[3]);
            *(u32x2*)(gp + (size_t)t * DM) = ow;
        }
    }
}

struct KBuf { bf16x8 k[2][2]; };
struct VBuf { bf16x8 v[4]; };
constexpr int VT_LD = MALL;
struct KVOff { unsigned k0, v0; };
typedef __amdgpu_buffer_rsrc_t rsrc_t;
__device__ __forceinline__ bf16x8 bload(rsrc_t r, unsigned voff, unsigned soff) { return __builtin_bit_cast(bf16x8, __builtin_amdgcn_raw_buffer_load_b128(r, (int)voff, (int)soff, 0)); }
__device__ __forceinline__ void k_load(KBuf& B, rsrc_t rk, const KVOff& f, int kt) {
    const unsigned sk = (unsigned)kt * 4096u;
    B.k[0][0] = bload(rk, f.k0, sk); B.k[0][1] = bload(rk, f.k0 + 64u, sk);
    B.k[1][0] = bload(rk, f.k0, sk + 16384u); B.k[1][1] = bload(rk, f.k0 + 64u, sk + 16384u);
}
__device__ __forceinline__ void v_load(VBuf& B, rsrc_t rv, const KVOff& f, int kt) {
    const unsigned sv = (unsigned)kt * 2u;
#pragma unroll
    for (int d = 0; d < 4; ++d) B.v[d] = bload(rv, f.v0, sv + (unsigned)d * (16u * VT_LD * 2u));
}
__device__ __forceinline__ float red16_max(float x) {
#if __has_builtin(__builtin_amdgcn_permlane16_swap)
    auto r = __builtin_amdgcn_permlane16_swap(__float_as_uint(x), __float_as_uint(x), false, false);
    x = fmaxf(__uint_as_float(r[0]), __uint_as_float(r[1]));
#else
    x = fmaxf(x, __shfl_xor(x, 16));
#endif
    auto q = __builtin_amdgcn_permlane32_swap(__float_as_uint(x), __float_as_uint(x), false, false);
    return fmaxf(__uint_as_float(q[0]), __uint_as_float(q[1]));
}
__device__ __forceinline__ float red16_sum(float x) {
#if __has_builtin(__builtin_amdgcn_permlane16_swap)
    auto r = __builtin_amdgcn_permlane16_swap(__float_as_uint(x), __float_as_uint(x), false, false);
    x = __uint_as_float(r[0]) + __uint_as_float(r[1]);
#else
    x = x + __shfl_xor(x, 16);
#endif
    auto q = __builtin_amdgcn_permlane32_swap(__float_as_uint(x), __float_as_uint(x), false, false);
    return __uint_as_float(q[0]) + __uint_as_float(q[1]);
}
__device__ __forceinline__ void attn_step(const KBuf& B, const VBuf& V, const bf16x8 (&qf)[2], f32x4 c0, f32x4 c1, float& m, float& l, f32x4 (&o)[4]) {
    f32x4 s0 = __builtin_amdgcn_mfma_f32_16x16x32_bf16(B.k[0][0], qf[0], c0, 0, 0, 0);
    f32x4 s1 = __builtin_amdgcn_mfma_f32_16x16x32_bf16(B.k[1][0], qf[0], c1, 0, 0, 0);
    s0 = __builtin_amdgcn_mfma_f32_16x16x32_bf16(B.k[0][1], qf[1], s0, 0, 0, 0);
    s1 = __builtin_amdgcn_mfma_f32_16x16x32_bf16(B.k[1][1], qf[1], s1, 0, 0, 0);
    float mx = fmaxf(fmaxf(fmaxf(s0[0], s0[1]), fmaxf(s0[2], s0[3])), fmaxf(fmaxf(s1[0], s1[1]), fmaxf(s1[2], s1[3])));
    mx = red16_max(mx);
    const float mn = fmaxf(m, mx);
    const float alpha = __builtin_amdgcn_exp2f(m - mn);
    m = mn;
    f32x4 p0, p1;
#pragma unroll
    for (int e = 0; e < 4; ++e) { p0[e] = __builtin_amdgcn_exp2f(s0[e] - mn); p1[e] = __builtin_amdgcn_exp2f(s1[e] - mn); }
    l = l * alpha + ((p0[0] + p0[1]) + (p0[2] + p0[3])) + ((p1[0] + p1[1]) + (p1[2] + p1[3]));
    u32x4 pw; pw.x = pk2(p0[0], p0[1]); pw.y = pk2(p0[2], p0[3]); pw.z = pk2(p1[0], p1[1]); pw.w = pk2(p1[2], p1[3]);
    const bf16x8 pf = __builtin_bit_cast(bf16x8, pw);
#pragma unroll
    for (int d = 0; d < 4; ++d) { o[d] = o[d] * alpha; o[d] = __builtin_amdgcn_mfma_f32_16x16x32_bf16(V.v[d], pf, o[d], 0, 0, 0); }
}

__device__ __forceinline__ void attn_step2(const KBuf& KA, const VBuf& VA, const KBuf& KB, const VBuf& VB, const bf16x8 (&qf)[2], f32x4 c0, f32x4 c1, float& m, float& l, f32x4 (&o)[4]) {
    const f32x4 z4 = (f32x4){0.f, 0.f, 0.f, 0.f};
    f32x4 a0 = __builtin_amdgcn_mfma_f32_16x16x32_bf16(KA.k[0][0], qf[0], z4, 0, 0, 0);
    f32x4 a1 = __builtin_amdgcn_mfma_f32_16x16x32_bf16(KA.k[1][0], qf[0], z4, 0, 0, 0);
    f32x4 b0 = __builtin_amdgcn_mfma_f32_16x16x32_bf16(KB.k[0][0], qf[0], c0, 0, 0, 0);
    f32x4 b1 = __builtin_amdgcn_mfma_f32_16x16x32_bf16(KB.k[1][0], qf[0], c1, 0, 0, 0);
    a0 = __builtin_amdgcn_mfma_f32_16x16x32_bf16(KA.k[0][1], qf[1], a0, 0, 0, 0);
    a1 = __builtin_amdgcn_mfma_f32_16x16x32_bf16(KA.k[1][1], qf[1], a1, 0, 0, 0);
    b0 = __builtin_amdgcn_mfma_f32_16x16x32_bf16(KB.k[0][1], qf[1], b0, 0, 0, 0);
    b1 = __builtin_amdgcn_mfma_f32_16x16x32_bf16(KB.k[1][1], qf[1], b1, 0, 0, 0);
    float mxa = fmaxf(fmaxf(fmaxf(a0[0], a0[1]), fmaxf(a0[2], a0[3])), fmaxf(fmaxf(a1[0], a1[1]), fmaxf(a1[2], a1[3])));
    float mxb = fmaxf(fmaxf(fmaxf(b0[0], b0[1]), fmaxf(b0[2], b0[3])), fmaxf(fmaxf(b1[0], b1[1]), fmaxf(b1[2], b1[3])));
    const float mx = red16_max(fmaxf(mxa, mxb));
    const float mn = fmaxf(m, mx);
    const float alpha = __builtin_amdgcn_exp2f(m - mn);
    m = mn;
    f32x4 pa0, pa1, pb0, pb1;
#pragma unroll
    for (int e = 0; e < 4; ++e) { pa0[e] = __builtin_amdgcn_exp2f(a0[e] - mn); pa1[e] = __builtin_amdgcn_exp2f(a1[e] - mn); pb0[e] = __builtin_amdgcn_exp2f(b0[e] - mn); pb1[e] = __builtin_amdgcn_exp2f(b1[e] - mn); }
    const f32x4 ps = (pa0 + pa1) + (pb0 + pb1);
    l = l * alpha + ((ps[0] + ps[1]) + (ps[2] + ps[3]));
    u32x4 wa, wb; wa.x = pk2(pa0[0], pa0[1]); wa.y = pk2(pa0[2], pa0[3]); wa.z = pk2(pa1[0], pa1[1]); wa.w = pk2(pa1[2], pa1[3]);
    wb.x = pk2(pb0[0], pb0[1]); wb.y = pk2(pb0[2], pb0[3]); wb.z = pk2(pb1[0], pb1[1]); wb.w = pk2(pb1[2], pb1[3]);
    const bf16x8 pfa = __builtin_bit_cast(bf16x8, wa), pfb = __builtin_bit_cast(bf16x8, wb);
#pragma unroll
    for (int d = 0; d < 4; ++d) { o[d] = o[d] * alpha; o[d] = __builtin_amdgcn_mfma_f32_16x16x32_bf16(VA.v[d], pfa, o[d], 0, 0, 0); o[d] = __builtin_amdgcn_mfma_f32_16x16x32_bf16(VB.v[d], pfb, o[d], 0, 0, 0); }
}

constexpr int TAB_LD = 48, TAB_ROWS = 15;
constexpr int CK_STRIDE = 144, CV_STRIDE = 528, RW_STRIDE = 144;
constexpr int LDS_TAB = 0, LDS_CK = 3072, LDS_CV = LDS_CK + CTXL * CK_STRIDE, LDS_RING = LDS_CV + HD * CV_STRIDE;
constexpr int ROWK_BYTES = 64 * RW_STRIDE, SLOT_BYTES = 2 * ROWK_BYTES, LDS_ATT_END = LDS_RING + 3 * SLOT_BYTES;
static_assert(TAB_ROWS * TAB_LD * 4 <= LDS_CK && LDS_ATT_END <= RING_BYTES, "attention LDS map");
__device__ __forceinline__ int rs_of(int r) { int v = r - 4; return v < 0 ? 0 : (v > 24 ? 24 : v); }
__device__ __forceinline__ void attn_phase(const bf16_t* QK, const bf16_t* VT, bf16_t* O, const float* rpb, LAS unsigned char* lds, int tid, int lane, int wave, int bid, int G) {
    LAS float* tab = (LAS float*)(lds + LDS_TAB);
    const int fr = lane & 15, fq = lane >> 4;
    const int j = wave & 3, rw = wave >> 2;
    const int kc0 = (j == 0) ? 0 : (j == 1) ? 8 : (j == 2) ? 24 : 32;
    unsigned bpk0 = 0u, bpk1 = 0u;
    { const int cq = 16 * j + fr; int cs = cq - 8; cs = cs < 0 ? 0 : (cs > 48 ? 48 : cs);
#pragma unroll
      for (int jj = 0; jj < 8; ++jj) { const int ck = kc0 + 8 * fq + jj; const bool valid = (ck >= cs) && (ck < cs + 16); const unsigned col = valid ? (unsigned)(ck - cq + 15) : 31u;
          if (jj < 4) bpk0 |= col << (8 * jj); else bpk1 |= col << (8 * (jj - 4)); } }
    LAS unsigned char* ckl = lds + LDS_CK + fr * CK_STRIDE + fq * 16;
    LAS unsigned char* cvl = lds + LDS_CV + fr * CV_STRIDE + fq * 16;
    const int klo = LDS_RING + (kc0 + 8 * (fr >> 2) + (fr & 3)) * RW_STRIDE + fq * 16;
    const int vlo = LDS_RING + ROWK_BYTES + fr * RW_STRIDE + (kc0 + 8 * fq) * 2;
    const int st_t = tid >> 3, st_ch = tid & 7;
    const int st_off = st_t * RW_STRIDE + st_ch * 16;
    for (int bh = bid; bh < NB * NH; bh += G) {
        const int b = bh >> 4, h = bh & 15;
        const int ctx_kt0 = MLAT + b * CTXL;
        const bf16_t* ksrc = QK + (size_t)(b * SEQ + st_t) * 2048 + 1024 + h * 64 + st_ch * 8;
        const bf16_t* vsrc = VT + (size_t)(h * 64 + st_t) * VT_LD + b * SEQ + st_ch * 8;
        __syncthreads();
        for (int i = tid; i < TAB_ROWS * TAB_LD; i += 512) { const int col = i % TAB_LD, dr = i / TAB_LD; tab[i] = col < 31 ? rpb[(h * TAB_ROWS + dr) * 31 + col] * LOG2E : -1e30f; }
        for (int p = tid; p < CTXL * 8; p += 512) { const int key = p >> 3, ch = p & 7, c = key >> 5, w = key & 31; const int slot = c * 32 + ((w >> 2) & 1) * 16 + (w >> 3) * 4 + (w & 3);
            *(LAS u32x4*)(lds + LDS_CK + slot * CK_STRIDE + ch * 16) = *(const u32x4*)(QK + (size_t)(ctx_kt0 + key) * 2048 + 1024 + h * 64 + ch * 8); }
        for (int p = tid; p < HD * 32; p += 512) { const int d = p >> 5, ch = p & 31;
            *(LAS u32x4*)(lds + LDS_CV + d * CV_STRIDE + ch * 16) = *(const u32x4*)(VT + (size_t)(h * 64 + d) * VT_LD + ctx_kt0 + ch * 8); }
#pragma unroll
        for (int s0 = 0; s0 < 2; ++s0) {
            *(LAS u32x4*)(lds + LDS_RING + s0 * SLOT_BYTES + st_off) = *(const u32x4*)(ksrc + (size_t)s0 * 64 * 2048);
            *(LAS u32x4*)(lds + LDS_RING + s0 * SLOT_BYTES + ROWK_BYTES + st_off) = *(const u32x4*)(vsrc + s0 * 64); }
        u32x4 kr0, vr0, kr1, vr1, kr2, vr2;
        kr2 = *(const u32x4*)(ksrc + (size_t)2 * 64 * 2048); vr2 = *(const u32x4*)(vsrc + 2 * 64);
        kr0 = *(const u32x4*)(ksrc + (size_t)3 * 64 * 2048); vr0 = *(const u32x4*)(vsrc + 3 * 64);
        kr1 = kr0; vr1 = vr0;
        asm volatile("s_waitcnt lgkmcnt(0)" ::: "memory"); __builtin_amdgcn_s_barrier(); asm volatile("" ::: "memory");
        int gslot = 0;
        int it = 0, sc = 0, n_cur = 8, rs_lo = 0;
        int r_ = rw, rsw_ = 0, tq0_ = b * SEQ + rw * 64 + j * 16;
        int itp = 0, sp = 4, np = 8, prow = 4;
        bf16x8 qf[2], qn[2]; float m = -1e30f, l = 0.f; f32x4 o[4];
        qf[0] = qf[1] = (bf16x8){0, 0, 0, 0, 0, 0, 0, 0};
#pragma unroll
        for (int ks = 0; ks < 2; ++ks) qn[ks] = *(const bf16x8*)(QK + (size_t)(b * SEQ + rw * 64 + j * 16 + fr) * 2048 + h * 64 + ks * 32 + fq * 8);
#pragma unroll
        for (int d = 0; d < 4; ++d) o[d] = (f32x4){0.f, 0.f, 0.f, 0.f};
#define ATT_STEP(KI, VI, KW, VW) do { \
            { const int row_ = itp < 16 ? prow : 0; KI = *(const u32x4*)(ksrc + (size_t)row_ * 64 * 2048); VI = *(const u32x4*)(vsrc + row_ * 64); } \
            ++prow; if (++sp >= np) { sp = 0; ++itp; prow = rs_of(2 * itp); np = 8 + rs_of(2 * itp + 1) - prow; } \
            if (it < 16) { \
                if (sc == 0) { qf[0] = qn[0]; qf[1] = qn[1]; \
                    m = -1e30f; l = 0.f; _Pragma("unroll") for (int d = 0; d < 4; ++d) o[d] = (f32x4){0.f, 0.f, 0.f, 0.f}; } \
                if (sc == n_cur - 2) { const int tqn_ = tq0_ + (it < 15 ? 128 : 0);        \
                    _Pragma("unroll") for (int ks = 0; ks < 2; ++ks) qn[ks] = *(const bf16x8*)(QK + (size_t)(tqn_ + fr) * 2048 + h * 64 + ks * 32 + fq * 8); } \
                const int c_ = rs_lo + sc - rsw_; \
                if (c_ >= 0 && c_ < 8) { \
                    KBuf kc_, kl_; VBuf vc_, vl_; \
                    const LAS unsigned char* cks = ckl + c_ * 32 * CK_STRIDE; const LAS unsigned char* cvs = cvl + c_ * 64; \
                    const LAS unsigned char* lk = lds + klo + gslot * SLOT_BYTES; const LAS unsigned char* lv = lds + vlo + gslot * SLOT_BYTES; \
                    _Pragma("unroll") for (int T = 0; T < 2; ++T) _Pragma("unroll") for (int ks = 0; ks < 2; ++ks) { \
                        kc_.k[T][ks] = *(const LAS bf16x8*)(cks + T * 16 * CK_STRIDE + ks * 64); kl_.k[T][ks] = *(const LAS bf16x8*)(lk + T * 4 * RW_STRIDE + ks * 64); } \
                    _Pragma("unroll") for (int d = 0; d < 4; ++d) { vc_.v[d] = *(const LAS bf16x8*)(cvs + d * 16 * CV_STRIDE); vl_.v[d] = *(const LAS bf16x8*)(lv + d * 16 * RW_STRIDE); } \
                    const int tb_ = (rsw_ - r_ + 7 + c_) * TAB_LD; f32x4 c0_, c1_; \
                    _Pragma("unroll") for (int e = 0; e < 4; ++e) { c0_[e] = tab[tb_ + (int)((bpk0 >> (8 * e)) & 255u)]; c1_[e] = tab[tb_ + (int)((bpk1 >> (8 * e)) & 255u)]; } \
                    attn_step2(kc_, vc_, kl_, vl_, qf, c0_, c1_, m, l, o); } \
                if (sc == n_cur - 1) { \
                    const float lt = red16_sum(l); const float rl = 1.0f / lt; \
                    bf16_t* op = O + (size_t)(tq0_ + fr) * DM + h * 64 + 4 * fq; \
                    _Pragma("unroll") for (int d = 0; d < 4; ++d) { const f32x4 v = o[d] * rl; u32x2 w; w.x = pk2(v[0], v[1]); w.y = pk2(v[2], v[3]); *(u32x2*)(op + d * 16) = w; } } \
                if (++sc >= n_cur) { sc = 0; ++it; rs_lo = rs_of(2 * it); const int rs_hi_ = rs_of(2 * it + 1); n_cur = 8 + rs_hi_ - rs_lo; \
                    r_ = 2 * it + rw; rsw_ = rw ? rs_hi_ : rs_lo; tq0_ = b * SEQ + r_ * 64 + j * 16; } } \
            { int wslot = gslot + 2; wslot = wslot >= 3 ? wslot - 3 : wslot; \
              *(LAS u32x4*)(lds + LDS_RING + wslot * SLOT_BYTES + st_off) = KW; *(LAS u32x4*)(lds + LDS_RING + wslot * SLOT_BYTES + ROWK_BYTES + st_off) = VW; } \
            asm volatile("s_waitcnt lgkmcnt(0)" ::: "memory"); __builtin_amdgcn_s_barrier(); asm volatile("" ::: "memory"); \
            gslot = gslot == 2 ? 0 : gslot + 1; } while (0)
#pragma unroll 1
        for (int g = 0; g < 141; g += 3) {
            ATT_STEP(kr1, vr1, kr2, vr2);
            ATT_STEP(kr2, vr2, kr0, vr0);
            ATT_STEP(kr0, vr0, kr1, vr1);
        }
#undef ATT_STEP
    }
}

#define XB_TMO      128
#define XB_XCNT(j)  (256  + 64 * (j))
#define XB_XSUB(j)  (1280 + 64 * (j))
#define XB_XGEN(j)  (2304 + 64 * (j))
#define XB_TOP      3328
#define XB_TOPGEN   3392
#define XCD_BAR_WORDS 3456
#define XB_SPIN_CAP (1u << 18)

__device__ __forceinline__ unsigned xb_ld(unsigned* p)              { return __hip_atomic_load(p, __ATOMIC_RELAXED, __HIP_MEMORY_SCOPE_AGENT); }
__device__ __forceinline__ unsigned xb_add(unsigned* p, unsigned v) { return __hip_atomic_fetch_add(p, v, __ATOMIC_RELAXED, __HIP_MEMORY_SCOPE_AGENT); }
__device__ __forceinline__ unsigned xb_xcc_id() { return (unsigned)__builtin_amdgcn_s_getreg((3 << 11) | 20) & 0xFu; }
#define XB_SPIN(cond, bar) do { unsigned _sp = 0; while (cond) { __builtin_amdgcn_s_sleep(1); \
    if ((++_sp & 255u) == 0u) { if (xb_ld(&(bar)[XB_TMO])) break; if (_sp > XB_SPIN_CAP) { atomicAdd(&(bar)[XB_TMO], 1u); break; } } } } while (0)

struct XcdBarrier {
    unsigned* bar; unsigned x;
    volatile LAS unsigned* st;
};

__device__ __forceinline__ XcdBarrier xcd_barrier_post(unsigned* bar, volatile LAS unsigned* st) {
    XcdBarrier b; b.bar = bar; b.x = xb_xcc_id(); b.st = st;
    if (threadIdx.x == 0) (void)xb_add(&bar[XB_XCNT(b.x)], 1u);
    return b;
}
__device__ __forceinline__ void xcd_barrier_complete(unsigned* bar, unsigned x, unsigned& nloc, unsigned& nx) {
    const unsigned G = gridDim.x * gridDim.y * gridDim.z;
    unsigned sum, cnt, mine, sp = 0u;
    for (;;) {
        sum = 0u; cnt = 0u; mine = 0u;
#pragma unroll
        for (unsigned j = 0; j < 16; ++j) { const unsigned c = xb_ld(&bar[XB_XCNT(j)]); sum += c; cnt += (c > 0u) ? 1u : 0u; mine = (j == x) ? c : mine; }
        if (sum == G) break;
        __builtin_amdgcn_s_sleep(1);
        if ((++sp & 255u) == 0u) { if (xb_ld(&bar[XB_TMO])) break; if (sp > XB_SPIN_CAP) { atomicAdd(&bar[XB_TMO], 1u); break; } }
    }
    nloc = mine > 0u ? mine : 1u; nx = cnt > 0u ? cnt : 1u;
}

__device__ __forceinline__ void xcd_barrier(const XcdBarrier& b) {
    asm volatile("s_waitcnt vmcnt(0)" ::: "memory");
    __syncthreads();
    if (threadIdx.x == 0) {
        unsigned* bar = b.bar;
        __builtin_amdgcn_s_waitcnt(0);
        unsigned nloc = b.st[0], nx = b.st[1];
        if (nloc == 0u) { xcd_barrier_complete(bar, b.x, nloc, nx); b.st[0] = nloc; b.st[1] = nx; }
        const unsigned old = xb_add(&bar[XB_XSUB(b.x)], 1u);
        const unsigned gen = old / nloc;
        if (old + 1u == (gen + 1u) * nloc) {
            __builtin_amdgcn_fence(__ATOMIC_RELEASE, "agent");
            asm volatile("s_waitcnt vmcnt(0)" ::: "memory");
            const unsigned og = xb_add(&bar[XB_TOP], 1u);
            const unsigned tg = og / nx;
            if (og + 1u == (tg + 1u) * nx) xb_add(&bar[XB_TOPGEN], 1u);
            else XB_SPIN(xb_ld(&bar[XB_TOPGEN]) == tg, bar);
            __builtin_amdgcn_fence(__ATOMIC_ACQUIRE, "agent");
            xb_add(&bar[XB_XGEN(b.x)], 1u);
            asm volatile("s_waitcnt vmcnt(0)" ::: "memory");
        } else {
            XB_SPIN(xb_ld(&bar[XB_XGEN(b.x)]) == gen, bar);
            __builtin_amdgcn_fence(__ATOMIC_ACQUIRE, "agent");
            asm volatile("s_waitcnt vmcnt(0)" ::: "memory");
        }
    }
    __syncthreads();
}


constexpr int NPHASE = 14;
__global__ void __launch_bounds__(512, 2) fwd_mega(Args args) {
    extern __shared__ __attribute__((aligned(16))) unsigned char lds_raw[];
    LAS unsigned char* lds = (LAS unsigned char*)lds_raw;
    cg::grid_group grid = cg::this_grid();
    const int G = gridDim.x, bid = blockIdx.x, NGW = G * 8;
    unsigned char* ws = args.ws;
    const float* x = args.in[0]; const float* ctx = args.in[2];
    const float* norm1_g = args.in[4]; const float* norm2_g = args.in[5];
    const float* conv_w = args.in[9]; const float* rpb = args.in[12]; const float* final_g = args.in[16];
    float* mod = (float*)(ws + WS_MOD);
    bf16_t* SHA = (bf16_t*)(ws + WS_SHA);
    bf16_t* H = (bf16_t*)(ws + WS_H); bf16_t* H2 = (bf16_t*)(ws + WS_H2); float* rss = (float*)(ws + WS_RSS); float* shw = (float*)(ws + WS_SHW);
    bf16_t* Xctx = (bf16_t*)(ws + WS_XCTX);
    bf16_t* Xlat = (bf16_t*)args.out;
    bf16_t* BIG = (bf16_t*)(ws + WS_BIG);
    bf16_t* U = BIG; bf16_t* Bg = BIG + (size_t)MALL * 1024;
    bf16_t* HID = BIG;
    bf16_t* QK = BIG; bf16_t* VT = BIG + (size_t)MALL * 2048;
    bf16_t* Wcin = (bf16_t*)(ws + WS_WCIN); bf16_t* Wcout = (bf16_t*)(ws + WS_WCOUT); bf16_t* Wqkv = (bf16_t*)(ws + WS_WQKV); bf16_t* Wao = (bf16_t*)(ws + WS_WAO);
    bf16_t* W1 = (bf16_t*)(ws + WS_W1); bf16_t* W2 = (bf16_t*)(ws + WS_W2);

#ifndef PROBE_PH
#define PROBE_PH -1
#endif
#ifndef PROBE_PH2
#define PROBE_PH2 -1
#endif
    if (threadIdx.x < 32) ((volatile LAS unsigned*)(lds + MISC_OFF))[threadIdx.x] = 0u;
    __syncthreads();
    const XcdBarrier xbar = xcd_barrier_post((unsigned*)(ws + WS_CTL), (volatile LAS unsigned*)(lds + MISC_OFF) + 8);
    if (args.ph_lo < 0) grid.sync();
    for (int ph = args.ph_lo; ph < args.ph_hi; ++ph) {
      for (int rep = 0; rep < ((ph == PROBE_PH || ph == PROBE_PH2) ? 2 : 1); ++rep) {
        if (rep) xcd_barrier(xbar);
        int tid = threadIdx.x; asm volatile("" : "+v"(tid));
        const int lane = tid & 63, wave = __builtin_amdgcn_readfirstlane(tid >> 6), gw = bid * 8 + wave;
        int kind = 0;
        bool sync_after = true;
        pg8::Gemm g{nullptr, nullptr, 0, 0, 0}; int cidx = bid;
        pg8::EpiU E{}; E.mode = 0; E.O = nullptr; E.O2 = nullptr; E.ldc = 0; E.scale_tiles = 0; E.sc = 1.f; E.rss = nullptr; E.shw = nullptr; E.shw_ld = 0; E.inLat = nullptr; E.inCtx = nullptr; E.inbLat = nullptr; E.inbCtx = nullptr; E.outLat = nullptr; E.outCtx = nullptr; E.gate = nullptr;
        E.An = nullptr; E.gn = nullptr; E.scn = nullptr; E.rssn = nullptr; E.outf5 = nullptr;
        switch (ph) {
        case 0: p0_phase(args, lds, tid, lane, wave, bid, G); break;
        case 1: norm_phase(x, ctx, MALL, norm1_g, mod, 0, 1, H, nullptr, nullptr, gw, NGW, lane);
                for (int i = bid * 512 + tid; i < 3 * 17 * 1024; i += G * 512) { const int jb = i / (17 * 1024), rr = (i / 1024) % 17, k = i & 1023;
                    const float* shp = mod + (jb == 0 ? 3 * 1024 : jb == 1 ? 17 * 6144 : 17 * 6144 + 3 * 1024) + (size_t)rr * 6144;
                    SHA[(size_t)(jb * 256 + rr) * 1024 + k] = (bf16_t)f2bf(shp[k]); }
                break;
        case 2: kind = 1; g = pg8::Gemm{H, Wcin, MALL, 3072, 1024}; E.mode = 2; E.O = U; E.O2 = Bg; break;
        case 3: convgate_phase(U, Bg, conv_w, H, gw, NGW, lane); break;
        case 4: kind = 1; g = pg8::Gemm{H, Wcout, MALL, 1024, 1024}; E.mode = 3; E.inLat = x; E.inCtx = ctx; E.outLat = Xlat; E.outCtx = Xctx; E.gate = mod + 2 * 1024;
                E.An = H2; E.gn = norm2_g; E.scn = mod + 4 * 1024; E.rssn = rss; break;
        case 5: kind = 1; g = pg8::Gemm{H2, W1, MALL, 4096, 1024}; E.mode = 1; E.O = HID; E.ldc = 4096; E.rss = rss; E.shw = shw; E.shw_ld = 4096; break;
        case 6: case 7:
                kind = 1; g = pg8::Gemm{HID, W2, MLAT, 1024, 4096}; E.mode = 3; E.inbLat = Xlat; E.inbCtx = Xctx; E.outLat = Xlat; E.outCtx = Xctx; E.gate = mod + 5 * 1024;
                E.An = H; E.gn = norm1_g + 1024; E.scn = mod + 17 * 6144 + 1 * 1024; E.rssn = rss + MALL; break;
        case 8: kind = 1; break;
        case 9: attn_phase(QK, VT, H2, rpb, lds, tid, lane, wave, bid, G); break;
        case 10: kind = 1; g = pg8::Gemm{H2, Wao, MLAT, 1024, 1024}; E.mode = 3; E.inbLat = Xlat; E.inbCtx = Xctx; E.outLat = Xlat; E.outCtx = Xctx; E.gate = mod + 17 * 6144 + 2 * 1024;
                E.An = H; E.gn = norm2_g + 1024; E.scn = mod + 17 * 6144 + 4 * 1024; E.rssn = rss + 2 * MALL; break;
        case 11: kind = 1; g = pg8::Gemm{H, W1 + (size_t)4096 * 1024, MLAT, 4096, 1024}; E.mode = 1; E.O = HID; E.ldc = 4096; E.rss = rss + 2 * MALL; E.shw = shw + 17 * 4096 + 17 * 3072; E.shw_ld = 4096; break;
        case 12: kind = 1; g = pg8::Gemm{HID, W2 + (size_t)4096 * 1024, MLAT, 1024, 4096}; E.mode = 3; E.inbLat = Xlat; E.inbCtx = Xctx; E.outLat = H2; E.outCtx = Xctx; E.gate = mod + 17 * 6144 + 5 * 1024;
                E.rssn = rss + 3 * MALL; break;
        case 13: final_phase(H2, rss + 3 * MALL, final_g, args.out, gw, NGW, lane); break;
        default: break;
        }
#ifndef NO_GEMM
        if (kind == 1) {
            const int qk_done = (G > 64) ? ((4 * (G - 64) < 1024) ? 4 * (G - 64) : 1024) : 0;
            const int nsub = (ph == 4) ? 4 : (ph == 8) ? 3 : 1;
            for (int sub = 0; sub < nsub; ++sub) {
                int Gs = G, pm0 = 0, lbeg = 0, lend = -1;
                if (ph == 4 && sub > 0) {
                    const int jb = sub - 1;
                    const int N5 = (jb == 1) ? 3072 : 4096;
                    g = pg8::Gemm{SHA + (size_t)jb * 256 * 1024, jb == 0 ? W1 : jb == 1 ? Wqkv : W1 + (size_t)4096 * 1024, 256, N5, 1024};
                    E.mode = 5; E.ldc = N5; E.outf5 = shw + (jb == 0 ? 0 : jb == 1 ? 17 * 4096 : 17 * 4096 + 17 * 3072); E.rss = nullptr; E.shw = nullptr;
                    cidx = (bid + G - ((G > 112) ? 64 + 16 * jb : 0)) % G;
                }
                const bool qk_role = (ph == 7 && G > 64 && bid >= 64) || (ph == 8 && sub < 2);
                if (ph == 7 && !qk_role) { g.M = MCTX; pm0 = MLAT / 256; Gs = (G > 64) ? 64 : G; cidx = bid; }
                if (qk_role) {
                    g = pg8::Gemm{H, Wqkv, MLAT, 2048, 1024}; E.mode = 0; E.O = QK; E.ldc = 2048; E.scale_tiles = 4; E.sc = QSCALE; E.rss = rss + MALL; E.shw = shw + 17 * 4096; E.shw_ld = 3072;
                    E.An = nullptr; E.rssn = nullptr;
                    if (ph == 7) { Gs = G - 64; cidx = bid - 64; lend = qk_done; }
                    else if (sub == 0) { lbeg = qk_done; }
                    else { g.M = MCTX; pm0 = MLAT / 256; cidx = (bid + G - G / 2) % G; }
                }
                if (ph == 8 && sub == 2) { g = pg8::Gemm{Wqkv + (size_t)2048 * 1024, H, 1024, MALL, 1024}; E.mode = 4; E.O = VT; E.ldc = VT_LD; E.rss = rss + MALL; E.shw = shw + 17 * 4096; E.shw_ld = 3072; cidx = bid; }
                pg8::StaticOrder S; S.init(g.M, g.N, Gs, cidx, pm0, lbeg, lend);
                pg8::gemm_phase<pg8::EpiU, pg8::StaticOrder, true, true>(lds, g, S, E);
            }
        } else
#endif
        {}
      }
        if (ph + 1 < args.ph_hi) xcd_barrier(xbar);
    }
}

extern "C" void kernel_launch(void* const* d_in, const int* in_sizes, int n_in, void* d_out, int out_size, void* d_ws, size_t ws_size, hipStream_t stream) {
    static int grid = 0;
    if (grid == 0) {
        if (n_in != 17 || ws_size < WS_END) { fprintf(stderr, "kernel_launch: unexpected n_in %d / ws_size %zu\n", n_in, ws_size); grid = -1; return; }
        int dev = 0, cus = 0, per_cu = 0;
        hipGetDevice(&dev); hipDeviceGetAttribute(&cus, hipDeviceAttributeMultiprocessorCount, dev);
        if (hipFuncSetAttribute((const void*)fwd_mega, hipFuncAttributeMaxDynamicSharedMemorySize, LDS_BYTES) != hipSuccess) { fprintf(stderr, "kernel_launch: hipFuncSetAttribute failed\n"); grid = -1; return; }
        if (hipOccupancyMaxActiveBlocksPerMultiprocessor(&per_cu, (const void*)fwd_mega, 512, LDS_BYTES) != hipSuccess || per_cu < 1) { fprintf(stderr, "kernel_launch: occupancy query says %d\n", per_cu); per_cu = 1; }
        (void)hipGetLastError();
        grid = cus * (per_cu > 1 ? 1 : per_cu);
        if (grid <= 0) grid = 256;
    }
    if (grid < 0) return;
    if (hipMemsetAsync((char*)d_ws + WS_CTL, 0, CTL_BYTES, stream) != hipSuccess) { fprintf(stderr, "kernel_launch: memset failed\n"); return; }
    Args a{};
    for (int i = 0; i < 17; ++i) a.in[i] = (const float*)d_in[i];
    a.out = (float*)d_out; a.ws = (unsigned char*)d_ws;
#if MK_N_LAUNCHES == 1
    a.ph_lo = 0; a.ph_hi = NPHASE;
    void* kargs[] = {&a};
    hipError_t e = hipLaunchCooperativeKernel((const void*)fwd_mega, dim3(grid), dim3(512), kargs, LDS_BYTES, stream);
    if (e != hipSuccess) fprintf(stderr, "kernel_launch: cooperative launch failed: %s (grid %d)\n", hipGetErrorString(e), grid);
#else
    for (int ph = 0; ph < NPHASE; ++ph) {
        a.ph_lo = ph; a.ph_hi = ph + 1;
        hipLaunchKernelGGL(fwd_mega, dim3(grid), dim3(512), LDS_BYTES, stream, a);
    }
#endif
}
```
